# Optimizing an MI355X kernel written in HIP

```python
import math
import jax, jax.numpy as jnp
from jax import lax
import numpy as np

D_MODEL = 2048
BATCH = 4
SEQ = 2048
DEPTH = 4

N_MIXERS = 3
N_HEADS = 16
HEAD_DIM = D_MODEL // N_HEADS
D_FF = 5632
PLE_DIM = 256
Q_BLOCK = 128
MOBA_BLOCK = 256
MOBA_TOP_K = 3
MOBA_Q_CHUNK = 16
S5_GROUP = 16
S5_GROUPS = D_MODEL // S5_GROUP
S5_STATE = 64
RMS_EPS = 1e-6
N_FOX = len(range(0, DEPTH, N_MIXERS))
N_MOBA = len(range(1, DEPTH, N_MIXERS))
N_S5 = len(range(2, DEPTH, N_MIXERS))

kernel_name = "hybrid_fox_moba_s5_macaron_ple"


def _rmsnorm(x, g):
    xf = x.astype(jnp.float32)
    y = xf * lax.rsqrt(jnp.mean(xf * xf, axis=-1, keepdims=True) + RMS_EPS)
    return (y * g.astype(jnp.float32)).astype(x.dtype)


def _swiglu(x, w_in, w_out):
    gate, up = jnp.split(x @ w_in, 2, axis=-1)
    return (jax.nn.silu(gate) * up) @ w_out


def _fox_attention(xn, w_in, b_f, w_o):
    B, S, D = xn.shape
    H, Dh = N_HEADS, HEAD_DIM
    proj = xn @ w_in
    q, k, v, f_logit = jnp.split(proj, [D, 2 * D, 3 * D], axis=-1)
    q = q.reshape(B, S, H, Dh)
    k = k.reshape(B, S, H, Dh)
    v = v.reshape(B, S, H, Dh)
    log_f = jax.nn.log_sigmoid((f_logit + b_f).astype(jnp.float32))
    c = jnp.cumsum(log_f, axis=1).transpose(0, 2, 1)
    scale = Dh ** -0.5
    kpos = jnp.arange(S)

    def q_block(i):
        t0 = i * Q_BLOCK
        qb = lax.dynamic_slice_in_dim(q, t0, Q_BLOCK, axis=1)
        cb = lax.dynamic_slice_in_dim(c, t0, Q_BLOCK, axis=2)
        logits = jnp.einsum('bqhd,bkhd->bhqk', qb, k).astype(jnp.float32) * scale
        logits = logits + cb[..., None] - c[:, :, None, :]
        qpos = t0 + jnp.arange(Q_BLOCK)
        logits = jnp.where(kpos[None, :] <= qpos[:, None], logits, -jnp.inf)
        probs = jax.nn.softmax(logits, axis=-1).astype(v.dtype)
        return jnp.einsum('bhqk,bkhd->bqhd', probs, v)

    out = lax.map(q_block, jnp.arange(S // Q_BLOCK))
    out = out.transpose(1, 0, 2, 3, 4).reshape(B, S, D)
    return out @ w_o


def _moba_attention(xn, w_qkv, w_o):
    B, S, D = xn.shape
    H, Dh, MB = N_HEADS, HEAD_DIM, MOBA_BLOCK
    n_blk = -(-S // MB)
    s_pad = n_blk * MB
    n_sel = min(MOBA_TOP_K, n_blk)
    q, k, v = jnp.split(xn @ w_qkv, 3, axis=-1)
    q = q.reshape(B, S, H, Dh).transpose(0, 2, 1, 3)
    k = k.reshape(B, S, H, Dh).transpose(0, 2, 1, 3)
    v = v.reshape(B, S, H, Dh).transpose(0, 2, 1, 3)
    pad = ((0, 0), (0, 0), (0, s_pad - S), (0, 0))
    kb = jnp.pad(k, pad).reshape(B, H, n_blk, MB, Dh)
    vb = jnp.pad(v, pad).reshape(B, H, n_blk, MB, Dh)
    k_mean = jnp.mean(kb.astype(jnp.float32), axis=3)
    slopes = 2.0 ** (-8.0 * jnp.arange(1, H + 1, dtype=jnp.float32) / H)
    scale = Dh ** -0.5
    b_idx = jnp.arange(B)[:, None, None, None]
    h_idx = jnp.arange(H)[None, :, None, None]
    blk_ids = jnp.arange(n_blk)
    in_blk = jnp.arange(MB)

    def q_chunk(i):
        t0 = i * MOBA_Q_CHUNK
        qc = lax.dynamic_slice_in_dim(q, t0, MOBA_Q_CHUNK, axis=2)
        qpos = t0 + jnp.arange(MOBA_Q_CHUNK)
        own = t0 // MB
        gate = jnp.einsum('bhqd,bhnd->bhqn', qc.astype(jnp.float32), k_mean)
        gate = jnp.where(blk_ids < own, gate, -jnp.inf)
        _, sel = lax.top_k(gate, n_sel)
        sel_ok = sel < own
        k_sel = kb[b_idx, h_idx, sel]
        v_sel = vb[b_idx, h_idx, sel]
        lg_sel = jnp.einsum('bhqd,bhqnkd->bhqnk', qc, k_sel).astype(jnp.float32) * scale
        pos_sel = sel[..., None] * MB + in_blk
        dist_sel = (qpos[None, None, :, None, None] - pos_sel).astype(jnp.float32)
        lg_sel = lg_sel - slopes[None, :, None, None, None] * dist_sel
        lg_sel = jnp.where(sel_ok[..., None], lg_sel, -jnp.inf)
        lg_sel = lg_sel.reshape(B, H, MOBA_Q_CHUNK, n_sel * MB)
        k_own = lax.dynamic_slice_in_dim(kb, own, 1, axis=2)[:, :, 0]
        v_own = lax.dynamic_slice_in_dim(vb, own, 1, axis=2)[:, :, 0]
        lg_own = jnp.einsum('bhqd,bhkd->bhqk', qc, k_own).astype(jnp.float32) * scale
        dist_own = qpos[:, None] - (own * MB + in_blk)[None, :]
        lg_own = lg_own - slopes[None, :, None, None] * dist_own.astype(jnp.float32)
        lg_own = jnp.where(dist_own >= 0, lg_own, -jnp.inf)
        probs = jax.nn.softmax(jnp.concatenate([lg_sel, lg_own], axis=-1), axis=-1).astype(v.dtype)
        p_sel = probs[..., :n_sel * MB].reshape(B, H, MOBA_Q_CHUNK, n_sel, MB)
        p_own = probs[..., n_sel * MB:]
        return (jnp.einsum('bhqnk,bhqnkd->bhqd', p_sel, v_sel)
                + jnp.einsum('bhqk,bhkd->bhqd', p_own, v_own))

    out = lax.map(q_chunk, jnp.arange(S // MOBA_Q_CHUNK))
    out = out.transpose(1, 0, 3, 2, 4).reshape(B, S, D)
    return out @ w_o


def _s5_layer(xn, w_in, a_re, a_im, log_dt, b_re, b_im, c_re, c_im, d_skip, w_glu):
    B, S, D = xn.shape
    G, P, Cg = S5_GROUPS, S5_STATE, S5_GROUP
    f32 = jnp.float32
    u = (xn @ w_in).astype(f32).reshape(B, S, G, Cg)
    A = lax.complex(a_re.astype(f32), a_im.astype(f32))
    dt = jnp.exp(log_dt.astype(f32))[:, None]
    A_bar = jnp.exp(A * dt)
    B_mat = lax.complex(b_re.astype(f32), b_im.astype(f32))
    B_bar = ((A_bar - 1.0) / A)[..., None] * B_mat
    Bu = jnp.einsum('gpc,bsgc->sbgp', B_bar, u.astype(jnp.complex64))
    a_elems = jnp.broadcast_to(A_bar, (S, 1, G, P))

    def combine(left, right):
        a_l, b_l = left
        a_r, b_r = right
        return a_l * a_r, a_r * b_l + b_r

    _, h = lax.associative_scan(combine, (a_elems, Bu), axis=0)
    C_mat = lax.complex(c_re.astype(f32), c_im.astype(f32))
    y = jnp.einsum('gcp,sbgp->bsgc', C_mat, h).real
    y = y + d_skip.astype(f32).reshape(G, Cg) * u
    y = jax.nn.gelu(y.reshape(B, S, D)).astype(xn.dtype)
    val, gate = jnp.split(y @ w_glu, 2, axis=-1)
    return val * jax.nn.sigmoid(gate)


def setup_inputs(seed: int = 0) -> dict:
    key = jax.random.key(seed)
    ks = jax.random.split(key, 24)
    D, H, F = D_MODEL, N_HEADS, D_FF
    G, P, Cg = S5_GROUPS, S5_STATE, S5_GROUP
    nrm = jax.random.normal
    x = nrm(ks[0], (BATCH, SEQ, D), jnp.float32)
    p = nrm(ks[1], (DEPTH, BATCH, SEQ, PLE_DIM), jnp.float32)
    norm_g = 1.0 + 0.05 * nrm(ks[2], (DEPTH, 4, D), jnp.float32)
    final_g = 1.0 + 0.05 * nrm(ks[3], (D,), jnp.float32)
    w_ffn_in = nrm(ks[4], (DEPTH, 2, D, 2 * F), jnp.float32) * D ** -0.5
    w_ffn_out = nrm(ks[5], (DEPTH, 2, F, D), jnp.float32) * F ** -0.5
    w_ple_gate = nrm(ks[6], (DEPTH, D, D), jnp.float32) * D ** -0.5
    w_ple_proj = nrm(ks[7], (DEPTH, PLE_DIM, D), jnp.float32) * PLE_DIM ** -0.5
    fox_w_in = nrm(ks[8], (N_FOX, D, 3 * D + H), jnp.float32) * D ** -0.5
    fox_b_f = jax.random.uniform(ks[9], (N_FOX, H), jnp.float32, 1.0, 6.0)
    fox_w_o = nrm(ks[10], (N_FOX, D, D), jnp.float32) * D ** -0.5
    moba_w_qkv = nrm(ks[11], (N_MOBA, D, 3 * D), jnp.float32) * D ** -0.5
    moba_w_o = nrm(ks[12], (N_MOBA, D, D), jnp.float32) * D ** -0.5
    s5_w_in = nrm(ks[13], (N_S5, D, D), jnp.float32) * D ** -0.5
    s5_a_re = -0.5 + 0.01 * nrm(ks[14], (N_S5, G, P), jnp.float32)
    s5_a_im = jnp.broadcast_to(math.pi * jnp.arange(P, dtype=jnp.float32), (N_S5, G, P))
    s5_log_dt = jax.random.uniform(ks[15], (N_S5, G), jnp.float32, math.log(1e-3), math.log(1e-1))
    s5_b_re = nrm(ks[16], (N_S5, G, P, Cg), jnp.float32) * (2.0 * Cg) ** -0.5
    s5_b_im = nrm(ks[17], (N_S5, G, P, Cg), jnp.float32) * (2.0 * Cg) ** -0.5
    s5_c_re = nrm(ks[18], (N_S5, G, Cg, P), jnp.float32) * (2.0 * P) ** -0.5 * 4.0
    s5_c_im = nrm(ks[19], (N_S5, G, Cg, P), jnp.float32) * (2.0 * P) ** -0.5 * 4.0
    s5_d = nrm(ks[20], (N_S5, D), jnp.float32)
    s5_w_glu = nrm(ks[21], (N_S5, D, 2 * D), jnp.float32) * D ** -0.5
    return {"x": x, "p": p, "norm_g": norm_g, "final_g": final_g,
            "w_ffn_in": w_ffn_in, "w_ffn_out": w_ffn_out,
            "w_ple_gate": w_ple_gate, "w_ple_proj": w_ple_proj,
            "fox_w_in": fox_w_in, "fox_b_f": fox_b_f, "fox_w_o": fox_w_o,
            "moba_w_qkv": moba_w_qkv, "moba_w_o": moba_w_o,
            "s5_w_in": s5_w_in, "s5_a_re": s5_a_re, "s5_a_im": s5_a_im,
            "s5_log_dt": s5_log_dt, "s5_b_re": s5_b_re, "s5_b_im": s5_b_im,
            "s5_c_re": s5_c_re, "s5_c_im": s5_c_im, "s5_d": s5_d, "s5_w_glu": s5_w_glu}


def reference(x, p, norm_g, final_g, w_ffn_in, w_ffn_out, w_ple_gate, w_ple_proj,
              fox_w_in, fox_b_f, fox_w_o, moba_w_qkv, moba_w_o,
              s5_w_in, s5_a_re, s5_a_im, s5_log_dt, s5_b_re, s5_b_im,
              s5_c_re, s5_c_im, s5_d, s5_w_glu):
    h = x
    for i in range(DEPTH):
        g = norm_g[i]
        h = h + 0.5 * _swiglu(_rmsnorm(h, g[0]), w_ffn_in[i, 0], w_ffn_out[i, 0])
        xn = _rmsnorm(h, g[1])
        kind, j = i % N_MIXERS, i // N_MIXERS
        if kind == 0:
            mix = _fox_attention(xn, fox_w_in[j], fox_b_f[j], fox_w_o[j])
        elif kind == 1:
            mix = _moba_attention(xn, moba_w_qkv[j], moba_w_o[j])
        else:
            mix = _s5_layer(xn, s5_w_in[j], s5_a_re[j], s5_a_im[j], s5_log_dt[j],
                            s5_b_re[j], s5_b_im[j], s5_c_re[j], s5_c_im[j], s5_d[j], s5_w_glu[j])
        h = h + mix
        h = h + 0.5 * _swiglu(_rmsnorm(h, g[2]), w_ffn_in[i, 1], w_ffn_out[i, 1])
        ple_gate = jax.nn.sigmoid(_rmsnorm(h, g[3]) @ w_ple_gate[i])
        h = h + ple_gate * (p[i] @ w_ple_proj[i])
    return _rmsnorm(h, final_g)
```

```cpp
#include <hip/hip_runtime.h>
#include <cstdio>
#include <cstdint>
#include <cmath>
#define MK_TID() ({ unsigned l_; asm volatile("v_mbcnt_lo_u32_b32 %0, -1, 0\n\tv_mbcnt_hi_u32_b32 %0, -1, %0" : "=v"(l_)); (int)(((unsigned)wave << 6) | l_); })
#define XB_TID ((unsigned)MK_TID())
namespace pg8 {
#define PG8_LAS __attribute__((address_space(3)))
typedef unsigned short bf16_t;
typedef short bf16x8 __attribute__((ext_vector_type(8)));
typedef float f32x4 __attribute__((ext_vector_type(4)));
typedef float f32x2 __attribute__((ext_vector_type(2)));
typedef unsigned u32x4 __attribute__((ext_vector_type(4)));
typedef unsigned u32x2 __attribute__((ext_vector_type(2)));
constexpr int BM = 256, BK = 64, HALF = 128, HTB = HALF * BK * 2  , STAGE_BYTES = 8 * HTB, NXCD = 8, WGM = 8;
constexpr int EPI_LDS_OFF = STAGE_BYTES;
constexpr float RMS_EPS = 1e-6f;

__host__ __device__ __forceinline__ int lds_byte(int r, int c) { const int st = (r >> 4) * 2 + (c >> 5), rr = r & 15, cc = c & 31, ob = rr * 64 + cc * 2; return st * 1024 + (ob ^ (((ob >> 9) & 1) << 5)); }
__host__ __device__ __forceinline__ void stage_rc(int b, int& R, int& C) { const int st = b / 1024, sb = b % 1024, swz = sb ^ (((sb >> 9) & 1) << 5); R = (st >> 1) * 16 + swz / 64; C = (st & 1) * 32 + (swz % 64) / 2; }
__host__ __device__ __forceinline__ int perm32(int rho) { const int n = rho >> 4, i = rho & 15; return 8 * (i >> 2) + 4 * n + (i & 3); }

struct Unit { int pm, pn, pb; };
struct Gemm { const bf16_t* A; const bf16_t* Bt; int lda, ldb, K; };

struct StaticOrder {
    int nM, nN, nwg, G, c;
    __device__ void init(int M, int N, int G_, int c_) { nM = M / BM; nN = N / BM; nwg = nM * nN; G = G_; c = c_; }
    __device__ bool next(int i, Unit& u) const {
        const long L = (long)i * G + c; if (L >= nwg) return false;
        int wgid = (int)L; { const int q = nwg / NXCD, r = nwg % NXCD, xcd = wgid % NXCD, off = wgid / NXCD; wgid = (xcd < r ? xcd * (q + 1) : r * (q + 1) + (xcd - r) * q) + off; }
        const int nig = WGM * nN, gid = wgid / nig, fm = gid * WGM, gsz = (nM - fm) < WGM ? (nM - fm) : WGM;
        u.pm = fm + ((wgid % nig) % gsz); u.pn = (wgid % nig) / gsz; u.pb = u.pn; return true;
    }
};
struct PpOrder {
    StaticOrder s;
    __device__ void init(int G_, int c_) { s.init(4 * 8192, 2048, G_, c_); }
    __device__ bool next(int i, Unit& u) const { if (!s.next(i, u)) return false; u.pb = (u.pm >> 5) * 8 + u.pn; return true; }
};
template <int NT> struct BatchOrder {
    int G, c;
    __device__ void init(int G_, int c_) { G = G_; c = c_; }
    __device__ bool next(int i, Unit& u) const { const int L = i * G + c; if (L >= 128 * NT) return false; u.pm = L / NT; u.pn = L % NT; u.pb = L; return true; }
};

__device__ __forceinline__ unsigned cvt_pk_bf16(float lo, float hi) { unsigned r; asm volatile("v_cvt_pk_bf16_f32 %0, %1, %2" : "=v"(r) : "v"(lo), "v"(hi)); return r; }
__device__ __forceinline__ float fast_sigmoid(float x) { return __builtin_amdgcn_rcpf(1.0f + __builtin_amdgcn_exp2f(-1.4426950408889634f * x)); }
__device__ __forceinline__ float fast_silu(float x) { return x * fast_sigmoid(x); }
__device__ __forceinline__ float gelu_tanh(float v) {
    const float z = 0.7978845608028654f * (v + 0.044715f * v * v * v); return v * fast_sigmoid(2.0f * z);
}

typedef f32x4 Acc[2][2][4][2];

__device__ __forceinline__ void row_rstd(const float* ssq, int np, const Unit& u, int wr, int fr, float (&rs)[2][4], PG8_LAS unsigned char* lds, int tid) {
    PG8_LAS float* R = (PG8_LAS float*)(lds + EPI_LDS_OFF + 4096);
    if (tid < 256) { const f32x4* sp = (const f32x4*)(ssq + ((size_t)u.pm * BM + tid) * 16);
        f32x4 a = sp[0] + sp[1]; if (np > 8) a += sp[2] + sp[3];
        R[tid] = __builtin_amdgcn_rsqf(((a[0] + a[1]) + (a[2] + a[3])) * (1.0f / 2048.0f) + RMS_EPS); }
    asm volatile("s_waitcnt lgkmcnt(0)" ::: "memory"); __builtin_amdgcn_s_barrier(); asm volatile("" ::: "memory");
#pragma unroll
    for (int ai = 0; ai < 2; ++ai)
#pragma unroll
        for (int m = 0; m < 4; ++m) rs[ai][m] = R[ai * HALF + wr * 64 + m * 16 + fr];
}

struct EpiSwiglu {
    static constexpr bool PERM = true, BAR = false;
    bf16_t* O; int ldo; const float* ssq; int np;
    __device__ __forceinline__ void operator()(const Acc& acc, const Unit& u, int wr, int wc, int fr, int fq, PG8_LAS unsigned char* lds, int tid) const {
        float rs[2][4]; row_rstd(ssq, np, u, wr, fr, rs, lds, tid);
        const int col0 = u.pn * HALF + wc * 32 + 8 * fq;
#pragma unroll
        for (int ai = 0; ai < 2; ++ai)
#pragma unroll
            for (int m = 0; m < 4; ++m) { const float s = rs[ai][m]; float o[8];
#pragma unroll
                for (int n = 0; n < 2; ++n)
#pragma unroll
                    for (int i = 0; i < 4; ++i) o[n * 4 + i] = fast_silu(acc[ai][0][m][n][i] * s) * (acc[ai][1][m][n][i] * s);
                u32x4 w; w.x = cvt_pk_bf16(o[0], o[1]); w.y = cvt_pk_bf16(o[2], o[3]); w.z = cvt_pk_bf16(o[4], o[5]); w.w = cvt_pk_bf16(o[6], o[7]);
                *(u32x4*)(O + (size_t)(u.pm * BM + ai * HALF + wr * 64 + m * 16 + fr) * ldo + col0) = w; }
    }
};
struct EpiBf16 {
    static constexpr bool PERM = true, BAR = false;
    bf16_t* O; int ldo; const float* ssq; int np;
    __device__ __forceinline__ void operator()(const Acc& acc, const Unit& u, int wr, int wc, int fr, int fq, PG8_LAS unsigned char* lds, int tid) const {
        float rs[2][4];
        if (ssq) row_rstd(ssq, np, u, wr, fr, rs, lds, tid); else {
#pragma unroll
            for (int a = 0; a < 2; ++a)
#pragma unroll
                for (int m = 0; m < 4; ++m) rs[a][m] = 1.f; }
        const int col0 = u.pn * BM + wc * 32 + 8 * fq;
#pragma unroll
        for (int ai = 0; ai < 2; ++ai)
#pragma unroll
            for (int m = 0; m < 4; ++m) { const float s = rs[ai][m]; bf16_t* rowp = O + (size_t)(u.pm * BM + ai * HALF + wr * 64 + m * 16 + fr) * ldo + col0;
#pragma unroll
                for (int bj = 0; bj < 2; ++bj) { const f32x4 v0 = acc[ai][bj][m][0] * s, v1 = acc[ai][bj][m][1] * s;
                    u32x4 w; w.x = cvt_pk_bf16(v0[0], v0[1]); w.y = cvt_pk_bf16(v0[2], v0[3]); w.z = cvt_pk_bf16(v1[0], v1[1]); w.w = cvt_pk_bf16(v1[2], v1[3]);
                    *(u32x4*)(rowp + bj * HALF) = w; } }
    }
};
struct EpiQkv {
    static constexpr bool PERM = true, BAR = false;
    bf16_t* O; const float* ssq; int np;
    __device__ __forceinline__ void operator()(const Acc& acc, const Unit& u, int wr, int wc, int fr, int fq, PG8_LAS unsigned char* lds, int tid) const {
        float rs[2][4]; row_rstd(ssq, np, u, wr, fr, rs, lds, tid);
        const int which = u.pn >> 3, hd0 = (u.pn & 7) * 2, d0 = wc * 32 + 8 * fq;
#pragma unroll
        for (int ai = 0; ai < 2; ++ai)
#pragma unroll
            for (int m = 0; m < 4; ++m) { const float s = rs[ai][m]; const int r = u.pm * BM + ai * HALF + wr * 64 + m * 16 + fr, b = r >> 11, t = r & 2047;
#pragma unroll
                for (int bj = 0; bj < 2; ++bj) { const f32x4 v0 = acc[ai][bj][m][0] * s, v1 = acc[ai][bj][m][1] * s;
                    u32x4 w; w.x = cvt_pk_bf16(v0[0], v0[1]); w.y = cvt_pk_bf16(v0[2], v0[3]); w.z = cvt_pk_bf16(v1[0], v1[1]); w.w = cvt_pk_bf16(v1[2], v1[3]);
                    *(u32x4*)(O + (size_t)which * (8192 * 2048) + ((size_t)((b * 16 + hd0 + bj) * 2048 + t)) * 128 + d0) = w; } }
    }
};
struct EpiS5U {
    static constexpr bool PERM = true, BAR = false;
    bf16_t* UH; const float* ssq; int np;
    __device__ __forceinline__ void operator()(const Acc& acc, const Unit& u, int wr, int wc, int fr, int fq, PG8_LAS unsigned char* lds, int tid) const {
        float rs[2][4]; row_rstd(ssq, np, u, wr, fr, rs, lds, tid);
#pragma unroll
        for (int ai = 0; ai < 2; ++ai)
#pragma unroll
            for (int m = 0; m < 4; ++m) { const float s = rs[ai][m]; const int r = u.pm * BM + ai * HALF + wr * 64 + m * 16 + fr;
#pragma unroll
                for (int bj = 0; bj < 2; ++bj) { const int cg = u.pn * BM + bj * HALF + wc * 32 + 8 * fq, g = cg >> 4, c0 = cg & 15;
                    const f32x4 v0 = acc[ai][bj][m][0] * s, v1 = acc[ai][bj][m][1] * s;
                    u32x4 w; w.x = cvt_pk_bf16(v0[0], v0[1]); w.y = cvt_pk_bf16(v0[2], v0[3]); w.z = cvt_pk_bf16(v1[0], v1[1]); w.w = cvt_pk_bf16(v1[2], v1[3]);
                    *(u32x4*)(UH + ((size_t)g * 256 + (r >> 5)) * 640 + (r & 31) * 16 + c0) = w; } }
    }
};
struct EpiS5H {
    static constexpr bool PERM = false, BAR = false;
    float* Hl;
    __device__ __forceinline__ void operator()(const Acc& acc, const Unit& u, int wr, int wc, int fr, int fq, PG8_LAS unsigned char* lds, int tid) const {
#pragma unroll
        for (int ai = 0; ai < 2; ++ai)
#pragma unroll
            for (int m = 0; m < 4; ++m) { float* rowp = Hl + ((size_t)u.pm * 256 + ai * HALF + wr * 64 + m * 16 + fr) * 128 + wc * 32 + 4 * fq;
#pragma unroll
                for (int n = 0; n < 2; ++n) *(f32x4*)(rowp + n * 16) = acc[ai][0][m][n]; }
    }
};
struct EpiS5Y {
    static constexpr bool PERM = true, BAR = false;
    bf16_t* Y;
    __device__ __forceinline__ void operator()(const Acc& acc, const Unit& u, int wr, int wc, int fr, int fq, PG8_LAS unsigned char* lds, int tid) const {
#pragma unroll
        for (int ai = 0; ai < 2; ++ai)
#pragma unroll
            for (int m = 0; m < 4; ++m) { const int crow = ai * HALF + wr * 64 + m * 16 + fr;
#pragma unroll
                for (int bj = 0; bj < 2; ++bj) { const int col = u.pn * BM + bj * HALF + wc * 32 + 8 * fq, j = col >> 4, c0 = col & 15;
                    float o[8];
#pragma unroll
                    for (int n = 0; n < 2; ++n)
#pragma unroll
                        for (int i = 0; i < 4; ++i) o[n * 4 + i] = gelu_tanh(acc[ai][bj][m][n][i]);
                    u32x4 w; w.x = cvt_pk_bf16(o[0], o[1]); w.y = cvt_pk_bf16(o[2], o[3]); w.z = cvt_pk_bf16(o[4], o[5]); w.w = cvt_pk_bf16(o[6], o[7]);
                    *(u32x4*)(Y + ((size_t)crow * 32 + j) * 2048 + u.pm * 16 + c0) = w; } }
    }
};
template <int MODE> struct EpiRes {
    static constexpr bool PERM = false, BAR = true;
    const float* hin; float* hout; bf16_t* hb; float* ssq_out; float alpha; const float* ssq; int np; const bf16_t* pp;
    __device__ __forceinline__ void operator()(const Acc& acc, const Unit& u, int wr, int wc, int fr, int fq, PG8_LAS unsigned char* lds, int tid) const {
        float rs[2][4];
        if (MODE == 1) row_rstd(ssq, np, u, wr, fr, rs, lds, tid);
        PG8_LAS float* P = (PG8_LAS float*)(lds + EPI_LDS_OFF);
        constexpr int NBJ = (MODE == 2) ? 1 : 2; constexpr int CW = (MODE == 2) ? HALF : BM;
#pragma unroll
        for (int ai = 0; ai < 2; ++ai)
#pragma unroll
            for (int m = 0; m < 4; ++m) { const int rl = ai * HALF + wr * 64 + m * 16 + fr; const size_t r = (size_t)u.pm * BM + rl; float sq = 0.f;
#pragma unroll
                for (int bj = 0; bj < NBJ; ++bj)
#pragma unroll
                    for (int n = 0; n < 2; ++n) { const int col = u.pn * CW + bj * HALF + wc * 32 + n * 16 + 4 * fq; const size_t off = r * 2048 + col;
                        f32x4 f;
                        if (MODE == 0) f = acc[ai][bj][m][n] * alpha;
                        else if (MODE == 1) { const u32x2 pw = *(const u32x2*)(pp + off); const float s = rs[ai][m]; const f32x4 a = acc[ai][bj][m][n] * s;
                            f[0] = fast_sigmoid(a[0]) * __uint_as_float(pw.x << 16); f[1] = fast_sigmoid(a[1]) * __uint_as_float(pw.x & 0xffff0000u);
                            f[2] = fast_sigmoid(a[2]) * __uint_as_float(pw.y << 16); f[3] = fast_sigmoid(a[3]) * __uint_as_float(pw.y & 0xffff0000u); }
                        else { const f32x4 v = acc[ai][0][m][n], g = acc[ai][1][m][n];
                            f[0] = v[0] * fast_sigmoid(g[0]); f[1] = v[1] * fast_sigmoid(g[1]); f[2] = v[2] * fast_sigmoid(g[2]); f[3] = v[3] * fast_sigmoid(g[3]); }
                        const f32x4 o = *(const f32x4*)(hin + off) + f;
                        *(f32x4*)(hout + off) = o;
                        u32x2 w; w.x = cvt_pk_bf16(o[0], o[1]); w.y = cvt_pk_bf16(o[2], o[3]); *(u32x2*)(hb + off) = w;
                        sq += (o[0] * o[0] + o[1] * o[1]) + (o[2] * o[2] + o[3] * o[3]); }
                sq += __shfl_xor(sq, 16); sq += __shfl_xor(sq, 32);
                if (fq == 0) P[rl * 4 + wc] = sq;
                if (m & 1) asm volatile("" ::: "memory"); }
        asm volatile("s_waitcnt lgkmcnt(0)" ::: "memory"); __builtin_amdgcn_s_barrier(); asm volatile("" ::: "memory");
        if (tid < 256) { const f32x4 p4 = *(const PG8_LAS f32x4*)(P + tid * 4); ssq_out[((size_t)u.pm * BM + tid) * 16 + u.pn] = (p4[0] + p4[1]) + (p4[2] + p4[3]); }
    }
};

template <class Epi, class Sched>
__device__ __forceinline__ void gemm_phase(PG8_LAS unsigned char* lds, const Gemm g, const Sched& S, const Epi& E, const int wave) {
    int tid_raw_ = MK_TID(); asm volatile("" : "+v"(tid_raw_)); const int tid = tid_raw_, wid = __builtin_amdgcn_readfirstlane(tid >> 6), lane = tid & 63, wr = wid >> 2, wc = wid & 3, fr = lane & 15, fq = lane >> 4;
    int K_ = g.K; asm volatile("" : "+s"(K_)); const int K = K_, nt = K / BK;
    unsigned voffA[2], voffB[2];
#pragma unroll
    for (int i = 0; i < 2; ++i) { int R, C; stage_rc(tid * 16 + i * 8192, R, C); const int Rb = Epi::PERM ? ((R & ~31) + perm32(R & 31)) : R;
        voffA[i] = (unsigned)(R * g.lda + C) * 2u; voffB[i] = (unsigned)(Rb * g.ldb + C) * 2u; }
    const size_t kstep = (size_t)(BK * 2);
    const size_t hstepA = (size_t)HALF * g.lda * 2, hstepB = (size_t)HALF * g.ldb * 2;
    const size_t tstepA = 2 * hstepA, tstepB = 2 * hstepB;
    const unsigned ldsw = (unsigned)wid * 1024u;
    const int aoff = lds_byte(wr * 64 + fr, fq * 8), boff = lds_byte(wc * 32 + fr, fq * 8);
#define PG8_SA(b, h) (((b) * 2 + (h)) * HTB)
#define PG8_SB(b, h) ((4 + (b) * 2 + (h)) * HTB)
#define PG8_STAGE(bufoff, gbase, voff) do { _Pragma("unroll") for (int _i = 0; _i < 2; ++_i) \
        __builtin_amdgcn_global_load_lds((const unsigned*)((const char*)(gbase) + (voff)[_i]), (PG8_LAS unsigned*)(lds + (bufoff) + ldsw + _i * 8192), 16, 0, 0); } while (0)
#define PG8_LDA(dst, b, h) do { _Pragma("unroll") for (int m = 0; m < 4; ++m) _Pragma("unroll") for (int k = 0; k < 2; ++k) dst[m][k] = *(const PG8_LAS bf16x8*)(lds + PG8_SA(b, h) + aoff + m * 2048 + k * 1024); } while (0)
#define PG8_LDB(dst, b, h) do { _Pragma("unroll") for (int n = 0; n < 2; ++n) _Pragma("unroll") for (int k = 0; k < 2; ++k) dst[n][k] = *(const PG8_LAS bf16x8*)(lds + PG8_SB(b, h) + boff + n * 2048 + k * 1024); } while (0)
#define PG8_MMA(ai, bj, At, Bt) do { __builtin_amdgcn_s_setprio(1); _Pragma("unroll") for (int m = 0; m < 4; ++m) _Pragma("unroll") for (int n = 0; n < 2; ++n) _Pragma("unroll") for (int k = 0; k < 2; ++k) \
        acc[ai][bj][m][n] = __builtin_amdgcn_mfma_f32_16x16x32_bf16(Bt[n][k], At[m][k], acc[ai][bj][m][n], 0, 0, 0); __builtin_amdgcn_s_setprio(0); } while (0)
#define PG8_WAIT_V(n) asm volatile("s_waitcnt vmcnt(" #n ")" ::: "memory")
#define PG8_WAIT_L(n) asm volatile("s_waitcnt lgkmcnt(" #n ")" ::: "memory")
#define PG8_BAR __builtin_amdgcn_s_barrier()
#define PG8_SCHED __builtin_amdgcn_sched_barrier(0)
    Unit cur, nxt; int ui = 0;
    if (!S.next(0, cur)) return;
    f32x4 acc[2][2][4][2];
#pragma unroll
    for (int a = 0; a < 2; ++a)
#pragma unroll
        for (int b = 0; b < 2; ++b)
#pragma unroll
            for (int m = 0; m < 4; ++m)
#pragma unroll
                for (int n = 0; n < 2; ++n) acc[a][b][m][n] = (f32x4){0.f, 0.f, 0.f, 0.f};
    bf16x8 At[4][2], B0[2][2], B1[2][2];
    const char* cA = (const char*)g.A + (size_t)cur.pm * tstepA; const char* cB = (const char*)g.Bt + (size_t)cur.pb * tstepB;
    PG8_STAGE(PG8_SB(0, 0), cB, voffB); PG8_STAGE(PG8_SB(0, 1), cB + hstepB, voffB); PG8_STAGE(PG8_SA(0, 0), cA, voffA); PG8_STAGE(PG8_SA(0, 1), cA + hstepA, voffA);
    if (wr == 1) PG8_BAR;
    PG8_WAIT_V(2); PG8_BAR;
    PG8_STAGE(PG8_SB(1, 0), cB + kstep, voffB); PG8_STAGE(PG8_SA(1, 0), cA + kstep, voffA); PG8_STAGE(PG8_SB(1, 1), cB + hstepB + kstep, voffB);
    PG8_WAIT_V(6); PG8_BAR;
    for (;;) {
        const bool has_next = S.next(ui + 1, nxt);
        const char* nA = has_next ? (const char*)g.A + (size_t)nxt.pm * tstepA : cA; const char* nB = has_next ? (const char*)g.Bt + (size_t)nxt.pb * tstepB : cB;
        for (int t = 0; t < nt; t += 2) {
            const bool last = (t == nt - 2);
            const char* a1 = cA + (size_t)(t + 1) * kstep;
            const char* a2 = last ? nA : cA + (size_t)(t + 2) * kstep; const char* b2 = last ? nB : cB + (size_t)(t + 2) * kstep;
            const char* a3 = a2 + kstep; const char* b3 = b2 + kstep;
            PG8_LDB(B0, 0, 0); PG8_LDB(B1, 0, 1); PG8_SCHED; PG8_LDA(At, 0, 0); PG8_STAGE(PG8_SA(1, 1), a1 + hstepA, voffA);
            PG8_WAIT_V(8); PG8_WAIT_L(0); PG8_BAR; PG8_MMA(0, 0, At, B0); PG8_MMA(0, 1, At, B1); PG8_BAR; PG8_SCHED;
            PG8_LDA(At, 0, 1); PG8_STAGE(PG8_SB(0, 0), b2, voffB); PG8_STAGE(PG8_SB(0, 1), b2 + hstepB, voffB); PG8_STAGE(PG8_SA(0, 0), a2, voffA);
            PG8_WAIT_V(8); PG8_WAIT_L(0); PG8_BAR; PG8_MMA(1, 0, At, B0); PG8_MMA(1, 1, At, B1); PG8_BAR; PG8_SCHED;
            PG8_LDB(B0, 1, 0); PG8_LDB(B1, 1, 1); PG8_SCHED; PG8_LDA(At, 1, 0); PG8_STAGE(PG8_SA(0, 1), a2 + hstepA, voffA);
            PG8_WAIT_V(8); PG8_WAIT_L(0); PG8_BAR; PG8_MMA(0, 0, At, B0); PG8_MMA(0, 1, At, B1); PG8_BAR; PG8_SCHED;
            PG8_LDA(At, 1, 1); PG8_STAGE(PG8_SB(1, 0), b3, voffB); PG8_STAGE(PG8_SB(1, 1), b3 + hstepB, voffB); PG8_STAGE(PG8_SA(1, 0), a3, voffA);
            PG8_WAIT_V(8); PG8_WAIT_L(0); PG8_BAR; PG8_MMA(1, 0, At, B0); PG8_MMA(1, 1, At, B1); PG8_BAR; PG8_SCHED;
        }
        if (wr == 0) PG8_BAR;
        { int le_ = lane; asm volatile("" : "+v"(le_));
          E(acc, cur, wr, wc, le_ & 15, le_ >> 4, lds, (wid << 6) | le_); }
        if (!has_next) break;
#pragma unroll
        for (int a = 0; a < 2; ++a)
#pragma unroll
            for (int b = 0; b < 2; ++b)
#pragma unroll
                for (int m = 0; m < 4; ++m)
#pragma unroll
                    for (int n = 0; n < 2; ++n) acc[a][b][m][n] = (f32x4){0.f, 0.f, 0.f, 0.f};
        cur = nxt; cA = nA; cB = nB; ++ui;
        if (wr == 1) PG8_BAR;
    }
    PG8_WAIT_V(0);
    PG8_BAR;
#undef PG8_SA
#undef PG8_SB
#undef PG8_STAGE
#undef PG8_LDA
#undef PG8_LDB
#undef PG8_MMA
#undef PG8_WAIT_V
#undef PG8_WAIT_L
#undef PG8_BAR
#undef PG8_SCHED
}
}
namespace att {
typedef unsigned short bf16;
typedef short bf16x8 __attribute__((ext_vector_type(8)));
typedef short s16x4 __attribute__((ext_vector_type(4)));
typedef float f32x16 __attribute__((ext_vector_type(16)));
typedef float f32x4 __attribute__((ext_vector_type(4)));
typedef unsigned u32x4 __attribute__((ext_vector_type(4)));
constexpr int D = 128, SEQ = 2048, OS = 2048;
constexpr float SCALE = 0.08838834764831845f, THR = 8.f;
constexpr int NW = 8, QBLK = 32, KVBLK = 64, QB = NW * QBLK;
constexpr int SHM_V = KVBLK * D * 2, SHM_K = KVBLK * D * 2;
constexpr int LDS_WS = 2 * SHM_V + 2 * SHM_K;
constexpr int LDS_BIAS = LDS_WS + NW * 64 * 4;
constexpr int LDS_NEG = LDS_BIAS + SEQ * 4;
constexpr int LDS_BYTES = LDS_NEG + 256;

#define KSWZ(row, colB) ((row) * 256 + ((colB) ^ (((row) & 7) << 4)))
#define SBAR() __builtin_amdgcn_sched_barrier(0)
__device__ __forceinline__ int v_st(int k, int c) { const int kk = (k & ~0xC) | ((k & 4) << 1) | ((k & 8) >> 1); return ((kk >> 3) * 4 + (c >> 5)) * 512 + ((kk & 7) * 32 + (c & 31)) * 2; }
__device__ __forceinline__ int v_rd_base(int lane) { return ((lane & 3) << 3) | (((lane >> 2) & 3) << 6) | (((lane >> 4) & 1) << 5) | (((lane >> 5) & 1) << 8); }
constexpr int v_rd_off(int d0, int ks, int half) { return d0 * 512 + ks * 4096 + half * 2048; }
__device__ __forceinline__ int crow(int r, int hi) { return (r & 3) + 8 * (r >> 2) + 4 * hi; }
__device__ __forceinline__ unsigned cvtpk(float lo, float hi) { unsigned r; asm volatile("v_cvt_pk_bf16_f32 %0, %1, %2" : "=v"(r) : "v"(lo), "v"(hi)); return r; }
__device__ __forceinline__ bf16x8 load8(const bf16* p) { return *reinterpret_cast<const bf16x8*>(p); }
__device__ __forceinline__ void mask_tile(f32x16& p0, f32x16& p1, int dq) {
    const float NEG = -__builtin_inff();
#pragma unroll
    for (int r = 0; r < 16; ++r) {
        const int c = (r & 3) + 8 * (r >> 2);
        if (dq - c < 0) p0[r] = NEG;
        if (dq - c - 32 < 0) p1[r] = NEG;
    }
}
__device__ __forceinline__ void partialSM(f32x16& p0, f32x16& p1, float& m_reg, float& mn, float& alpha) {
    float pmax = p0[0]; for (int r = 1; r < 16; ++r) pmax = fmaxf(pmax, p0[r]); for (int r = 0; r < 16; ++r) pmax = fmaxf(pmax, p1[r]);
    { auto rr = __builtin_amdgcn_permlane32_swap(__float_as_uint(pmax), __float_as_uint(pmax), false, false);
      pmax = fmaxf(__uint_as_float(rr[0]), __uint_as_float(rr[1])); }
    constexpr float C2 = 1.4426950408889634f * SCALE;
    if (__builtin_expect(__all((pmax - m_reg) * SCALE <= THR), 1)) { mn = m_reg; alpha = 1.f; }
    else { mn = fmaxf(m_reg, pmax); alpha = __builtin_amdgcn_exp2f((m_reg - mn) * C2); m_reg = mn; }
    const float mnL = -mn * C2;
    for (int r = 0; r < 16; ++r) p0[r] = fmaf(p0[r], C2, mnL); for (int r = 0; r < 16; ++r) p1[r] = fmaf(p1[r], C2, mnL);
    for (int r = 0; r < 16; ++r) p0[r] = __builtin_amdgcn_exp2f(p0[r]);
}
__device__ __forceinline__ void finishSM(f32x16& p0, f32x16& p1, float alpha, float& l_reg, bf16x8& pa0, bf16x8& pa1, bf16x8& pa2, bf16x8& pa3) {
    for (int r = 0; r < 16; ++r) p1[r] = __builtin_amdgcn_exp2f(p1[r]);
    float ps = 0; for (int r = 0; r < 16; ++r) ps += p0[r]; for (int r = 0; r < 16; ++r) ps += p1[r];
    { auto rr = __builtin_amdgcn_permlane32_swap(__float_as_uint(ps), __float_as_uint(ps), false, false);
      ps = __uint_as_float(rr[0]) + __uint_as_float(rr[1]); }
    l_reg = l_reg * alpha + ps;
#define PK4(P, B_, OUT) do { unsigned a0 = cvtpk(P[B_+0], P[B_+1]), a1 = cvtpk(P[B_+2], P[B_+3]);                          \
        unsigned b0 = cvtpk(P[B_+4], P[B_+5]), b1 = cvtpk(P[B_+6], P[B_+7]);                                             \
        auto r0 = __builtin_amdgcn_permlane32_swap(a0, b0, false, false); auto r1 = __builtin_amdgcn_permlane32_swap(a1, b1, false, false); \
        u32x4 w = {r0[0], r1[0], r0[1], r1[1]}; OUT = *reinterpret_cast<bf16x8*>(&w); } while (0)
    PK4(p0, 0, pa0); PK4(p0, 8, pa1); PK4(p1, 0, pa2); PK4(p1, 8, pa3);
#undef PK4
}
template <int KB>
__device__ __forceinline__ void qkt(f32x16& p0, f32x16& p1, const char* K_lds, int r32, int hi, const bf16x8* qr, const __attribute__((address_space(3))) char* bp) {
    { unsigned bpa = (unsigned)(uintptr_t)bp; asm volatile("" : "+v"(bpa));
      const __attribute__((address_space(3))) f32x4* b4 = (const __attribute__((address_space(3))) f32x4*)(uintptr_t)bpa;
      const f32x4 x0 = b4[0], x1 = b4[2], x2 = b4[4], x3 = b4[6], y0 = b4[8], y1 = b4[10], y2 = b4[12], y3 = b4[14];
      p0 = (f32x16){x0[0], x0[1], x0[2], x0[3], x1[0], x1[1], x1[2], x1[3], x2[0], x2[1], x2[2], x2[3], x3[0], x3[1], x3[2], x3[3]};
      p1 = (f32x16){y0[0], y0[1], y0[2], y0[3], y1[0], y1[1], y1[2], y1[3], y2[0], y2[1], y2[2], y2[3], y3[0], y3[1], y3[2], y3[3]}; }
    const char* kb[4];
#pragma unroll
    for (int dd = 0; dd < 4; ++dd) kb[dd] = K_lds + KB * SHM_K + KSWZ(r32, (dd * 16 + hi * 8) * 2);
#pragma unroll
    for (int d0 = 0; d0 < 8; ++d0) { const char* a = kb[d0 & 3] + (d0 >> 2) * 128;
        bf16x8 b0 = *reinterpret_cast<const bf16x8*>(a);
        bf16x8 b1 = *reinterpret_cast<const bf16x8*>(a + 32 * 256);
        p0 = __builtin_amdgcn_mfma_f32_32x32x16_bf16(b0, qr[d0], p0, 0, 0, 0);
        p1 = __builtin_amdgcn_mfma_f32_32x32x16_bf16(b1, qr[d0], p1, 0, 0, 0); }
}
template <int VB>
__device__ __forceinline__ void pv_tile(f32x16* o, int vb0, bf16x8 pa0, bf16x8 pa1, bf16x8 pa2, bf16x8 pa3) {
#define TRRD(dst, off) asm volatile("ds_read_b64_tr_b16 %0, %1 offset:%2" : "=&v"(dst) : "v"(vb0), "i"(off) : "memory")
#define PV_D0(d0) do { s16x4 l0, l1, l2, l3, h0, h1, h2, h3; constexpr int b_ = VB * SHM_V + v_rd_off(d0, 0, 0); \
        TRRD(l0, b_); TRRD(h0, b_ + 2048); TRRD(l1, b_ + 4096); TRRD(h1, b_ + 6144); TRRD(l2, b_ + 8192); TRRD(h2, b_ + 10240); TRRD(l3, b_ + 12288); TRRD(h3, b_ + 14336); \
        asm volatile("s_waitcnt lgkmcnt(0)" ::: "memory"); SBAR();   \
        o[d0] = __builtin_amdgcn_mfma_f32_32x32x16_bf16(pa0, (bf16x8){l0[0], l0[1], l0[2], l0[3], h0[0], h0[1], h0[2], h0[3]}, o[d0], 0, 0, 0);   \
        o[d0] = __builtin_amdgcn_mfma_f32_32x32x16_bf16(pa1, (bf16x8){l1[0], l1[1], l1[2], l1[3], h1[0], h1[1], h1[2], h1[3]}, o[d0], 0, 0, 0);   \
        o[d0] = __builtin_amdgcn_mfma_f32_32x32x16_bf16(pa2, (bf16x8){l2[0], l2[1], l2[2], l2[3], h2[0], h2[1], h2[2], h2[3]}, o[d0], 0, 0, 0);   \
        o[d0] = __builtin_amdgcn_mfma_f32_32x32x16_bf16(pa3, (bf16x8){l3[0], l3[1], l3[2], l3[3], h3[0], h3[1], h3[2], h3[3]}, o[d0], 0, 0, 0); } while (0)
    PV_D0(0); PV_D0(1); PV_D0(2); PV_D0(3);
#undef PV_D0
#undef TRRD
}

struct BlockRef { const bf16* Q; const bf16* K; const bf16* V; bf16* O; int P0; int bh; };
struct Seam { bf16x8 qr[8]; bf16x8 st_v0, st_v1, st_k0, st_k1; };
#define ROW(p, k0, rr) ((const bf16*)((const char*)((p) + (size_t)(k0) * D) + (unsigned)(((rr) * D + sc) * 2)))
#define VMW() asm volatile("s_waitcnt vmcnt(0)" ::: "memory")
#define VMWN(n) asm volatile("s_waitcnt vmcnt(%0)" :: "i"(n) : "memory")
#define SLOAD_H(Kp, Vp, k0) do { S.st_v0 = load8(ROW(Vp, k0, sr)); S.st_v1 = load8(ROW(Vp, k0, 32 + sr));              \
                         S.st_k0 = load8(ROW(Kp, k0, sr)); S.st_k1 = load8(ROW(Kp, k0, 32 + sr)); } while (0)
#define SWRITE_HK(bf) do { *(bf16x8*)(K_lds + (bf) * SHM_K + kws) = S.st_k0; *(bf16x8*)(K_lds + (bf) * SHM_K + kws + 32 * 256) = S.st_k1; } while (0)
#define SWRITE_HV(bf) do { *(bf16x8*)(V_lds + (bf) * SHM_V + vst0) = S.st_v0; *(bf16x8*)(V_lds + (bf) * SHM_V + vst1) = S.st_v1; } while (0)
#define SWRITE_H(bf) do { SWRITE_HV(bf); SWRITE_HK(bf); } while (0)
__device__ __forceinline__ void attn_prime(const BlockRef& cur, char* lds, Seam& S, const int wave) {
    int tid_raw_ = MK_TID(); asm volatile("" : "+v"(tid_raw_)); const int tid = tid_raw_, wid = __builtin_amdgcn_readfirstlane(tid >> 6), lane = tid & 63, r32 = lane & 31, hi = lane >> 5;
    const int sr = tid >> 4, sc = (tid & 15) * 8, kws = KSWZ(sr, sc * 2); char* K_lds = lds + 2 * SHM_V;
    for (int d0 = 0; d0 < 8; ++d0) S.qr[d0] = load8((const bf16*)((const char*)(cur.Q + (size_t)(wid * QBLK) * D) + (unsigned)((r32 * D + hi * 8) * 2)) + d0 * 16);
    SLOAD_H(cur.K, cur.V, 0); VMW(); SWRITE_HK(0);
    __syncthreads();
}
template <bool MOBA>
__device__ __forceinline__ void attn_block(const BlockRef& cur, const BlockRef& nxt, char* lds, Seam& S, const float* __restrict__ biasG  , const unsigned* __restrict__ selG  , const int wave) {
    int tid_raw_ = MK_TID(); asm volatile("" : "+v"(tid_raw_)); const int tid = tid_raw_, wid = __builtin_amdgcn_readfirstlane(tid >> 6), lane = tid & 63, r32 = lane & 31, hi = lane >> 5;
    const int NT = (cur.P0 + QB) / KVBLK;
    const int qlo = cur.P0 + wid * QBLK, qm = qlo + r32 - 4 * hi;
    char* V_lds = lds; char* K_lds = lds + 2 * SHM_V;
    float* ws = (float*)(lds + LDS_WS) + wid * 64; float* li_l = ws, * al_l = ws + 32;
    float* biasL = (float*)(lds + LDS_BIAS); float* negL = (float*)(lds + LDS_NEG);
    unsigned selmask = 0u; const int own = cur.P0 >> 8;
    { int te = tid; asm volatile("" : "+v"(te));
      if (te < 64) negL[te] = -__builtin_inff();
      *(f32x4*)(biasL + 4 * te) = *(const f32x4*)(biasG + (size_t)cur.bh * SEQ + 4 * te);
      if (MOBA) selmask = selG[(size_t)cur.bh * SEQ + cur.P0 + (te >> 6) * QBLK + (te & 31)]; }
    __syncthreads();
    typedef const __attribute__((address_space(3))) char* lcp; const lcp bias_b = (lcp)((const char*)biasL) + 16 * hi; const lcp neg_b = (lcp)((const char*)negL) + 16 * hi;
    float m_reg = -1e30f, l_reg = 0; f32x16 o[4] = {};
    const int sr = tid >> 4, sc = (tid & 15) * 8, vst0 = v_st(sr, sc), vst1 = v_st(32 + sr, sc), kws = KSWZ(sr, sc * 2);
    const int vb0 = (int)(uintptr_t)V_lds + v_rd_base(lane);
    const bf16* Kh = cur.K; const bf16* Vh = cur.V;
#define RESC(a) do { if (__any((a) < 1.f)) { if (hi == 0) al_l[r32] = (a); asm volatile("s_waitcnt lgkmcnt(0)" ::: "memory");              \
                     for (int d_ = 0; d_ < 4; ++d_) for (int r = 0; r < 16; ++r) o[d_][r] *= al_l[crow(r, hi)]; } } while (0)
#define KBASE(t) ((t) * KVBLK)
#define BP(t) ((!MOBA || (KBASE(t) >> 8) >= own || ((selmask >> (KBASE(t) >> 8)) & 1u)) ? (bias_b + KBASE(t) * 4) : neg_b)
#define MASKT(P0_, P1_, t) do { const int kb_ = KBASE(t); if (kb_ + KVBLK - 1 > qlo) mask_tile(P0_, P1_, qm - kb_); } while (0)
#define SEAM_K0() do { VMWN(8); SWRITE_HK(0); SBAR(); } while (0)
    f32x16 pA0, pA1, pB0, pB1; float mnA, mnB, alA, alB; bf16x8 pa0, pa1, pa2, pa3;
    SWRITE_HV(0); SBAR();
    SLOAD_H(Kh, Vh, KBASE(1));
    SBAR(); qkt<0>(pA0, pA1, K_lds, r32, hi, S.qr, BP(0));
    MASKT(pA0, pA1, 0); partialSM(pA0, pA1, m_reg, mnA, alA);
    VMW(); SWRITE_H(1);
    __syncthreads();
#define HALF_STEP(PX0, PX1, mnX, alX, PY0, PY1, alY, t, KB, VB, SB) do {                                                      \
        SBAR(); qkt<KB>(PX0, PX1, K_lds, r32, hi, S.qr, BP(t));                                                               \
        finishSM(PY0, PY1, alY, l_reg, pa0, pa1, pa2, pa3); SBAR();                                                           \
        if ((t) + 1 < NT) { SLOAD_H(Kh, Vh, KBASE((t) + 1)); SBAR(); }                                                        \
        pv_tile<VB>(o, vb0, pa0, pa1, pa2, pa3); MASKT(PX0, PX1, (t)); partialSM(PX0, PX1, m_reg, mnX, alX);                  \
        __syncthreads();                                                                                                      \
        if ((t) + 1 < NT) { VMW(); SWRITE_H(SB); }                                                                            \
        RESC(alX); __syncthreads(); } while (0)
    for (int t = 1; t + 1 < NT; t += 2) {
        HALF_STEP(pB0, pB1, mnB, alB, pA0, pA1, alA, t, 1, 0, 0);
        HALF_STEP(pA0, pA1, mnA, alA, pB0, pB1, alB, t + 1, 0, 1, 1);
    }
    { SBAR(); qkt<1>(pB0, pB1, K_lds, r32, hi, S.qr, BP(NT - 1)); SBAR(); }
    SLOAD_H(nxt.K, nxt.V, 0); SBAR();
    { int lq = lane; asm volatile("" : "+v"(lq));
#pragma unroll
    for (int d0 = 0; d0 < 8; ++d0) S.qr[d0] = load8((const bf16*)((const char*)(nxt.Q + (size_t)(wid * QBLK) * D) + (unsigned)(((lq & 31) * D + (lq >> 5) * 8) * 2)) + d0 * 16); }
    SBAR();
    finishSM(pA0, pA1, alA, l_reg, pa0, pa1, pa2, pa3); SBAR();
    pv_tile<0>(o, vb0, pa0, pa1, pa2, pa3);
    { MASKT(pB0, pB1, NT - 1); partialSM(pB0, pB1, m_reg, mnB, alB); __syncthreads(); RESC(alB);
      finishSM(pB0, pB1, alB, l_reg, pa0, pa1, pa2, pa3); SBAR(); pv_tile<1>(o, vb0, pa0, pa1, pa2, pa3); }
    SBAR(); SEAM_K0();
    { int le = lane; asm volatile("" : "+v"(le)); const int r32e = le & 31, hie = le >> 5;
    if (hie == 0) li_l[r32e] = l_reg; asm volatile("s_waitcnt lgkmcnt(0)" ::: "memory");
    float rli[16];
#pragma unroll
    for (int r = 0; r < 16; ++r) rli[r] = __builtin_amdgcn_rcpf(li_l[crow(r, hie)]);
    bf16* Ow = cur.O + (size_t)(wid * QBLK) * OS;
#pragma unroll
    for (int r = 0; r < 16; ++r) { const int orow = crow(r, hie);
#pragma unroll
        for (int d0 = 0; d0 < 4; ++d0) { const float v = o[d0][r] * rli[r];
            const float vn = __uint_as_float(__builtin_amdgcn_mov_dpp(__float_as_uint(v), 0xB1, 0xF, 0xF, true));
            if ((r32e & 1) == 0) *(unsigned*)(Ow + (size_t)orow * OS + d0 * 32 + r32e) = cvtpk(v, vn); } } }
    __syncthreads();
#undef RESC
#undef KBASE
#undef BP
#undef MASKT
#undef SEAM_K0
#undef HALF_STEP
}
#undef ROW
#undef VMW
#undef VMWN
#undef SLOAD_H
#undef SWRITE_HK
#undef SWRITE_HV
#undef SWRITE_H

template <bool MOBA>
__device__ __forceinline__ void attn_phase(char* lds, const bf16* Q, const bf16* K, const bf16* V, bf16* O, const float* biasG, const unsigned* selG, const int wave) {
    const int G = gridDim.x; int idx = blockIdx.x; if (idx >= 256) return;
    auto ref = [&](int id, int pass) { const int xcd = id & 7, k = id >> 3, bh = xcd * 8 + (k >> 2), y = k & 3, qb = pass ? 7 - y : y, b = bh >> 4, h = bh & 15;
        BlockRef r; r.Q = Q + ((size_t)bh * SEQ + (size_t)qb * QB) * D; r.K = K + (size_t)bh * SEQ * D; r.V = V + (size_t)bh * SEQ * D;
        r.O = O + ((size_t)b * SEQ + (size_t)qb * QB) * OS + h * D; r.P0 = qb * QB; r.bh = bh; return r; };
    int pass = 0; BlockRef cur = ref(idx, 0);
    Seam S;
    attn_prime(cur, lds, S, wave);
    for (;;) {
        const bool more_pass = pass == 0, more_item = idx + G < 256, last = !more_pass && !more_item;
        int idn = idx, passn = pass + 1; if (!more_pass) { passn = 0; idn = more_item ? idx + G : idx; }
        const BlockRef nxt = last ? cur : ref(idn, passn);
        attn_block<MOBA>(cur, nxt, lds, S, biasG, selG, wave);
        if (last) break;
        cur = nxt; idx = idn; pass = passn;
    }
}
}
constexpr int NWAVES = 8;
constexpr int BATCH = 4, SEQ = 2048, DM = 2048, M = BATCH * SEQ, FF = 5632, NH = 16, HD = 128, PLE = 256, DEPTH = 4;
constexpr size_t MiB = 1u << 20;
constexpr size_t WS_CTL = 0, CTL_ZERO_BYTES = 1 * MiB;
constexpr size_t WS_WFI = 1 * MiB;
constexpr size_t WS_WFO = WS_WFI + 352 * MiB;
constexpr size_t WS_WPG = WS_WFO + 176 * MiB;
constexpr size_t WS_WPP = WS_WPG + 32 * MiB;
constexpr size_t WS_WQKV = WS_WPP + 4 * MiB;
constexpr size_t WS_WO = WS_WQKV + 72 * MiB;
constexpr size_t WS_WS5I = WS_WO + 24 * MiB;
constexpr size_t WS_WGLU = WS_WS5I + 8 * MiB;
constexpr size_t WS_S5TV = WS_WGLU + 16 * MiB;
constexpr size_t WS_S5W = WS_S5TV + 80 * MiB;
constexpr size_t WS_WFT = WS_S5W + 32 * MiB;
constexpr size_t WS_H = WS_WFT + 1 * MiB;
constexpr size_t WS_HB = WS_H + 64 * MiB;
constexpr size_t WS_ACT = WS_HB + 32 * MiB;
constexpr size_t WS_QKV = WS_ACT + 88 * MiB;
constexpr size_t WS_OB = WS_QKV + 96 * MiB;
constexpr size_t WS_SSQ = WS_OB + 32 * MiB;
constexpr size_t WS_PP = WS_SSQ + 1 * MiB;
constexpr size_t WS_PBF = WS_PP + 128 * MiB;
constexpr size_t WS_LOGF = WS_PBF + 16 * MiB;
constexpr size_t WS_KMEAN = WS_LOGF + 1 * MiB;
constexpr size_t WS_UH = WS_KMEAN + 1 * MiB;
constexpr size_t WS_HLOC = WS_UH + 40 * MiB;
constexpr size_t WS_YB = WS_HLOC + 16 * MiB;
constexpr size_t WS_HB2 = WS_YB + 32 * MiB;
constexpr size_t WS_BIAS = WS_HB2 + 32 * MiB;
constexpr size_t WS_SEL = WS_BIAS + 1 * MiB;
constexpr size_t WS_END = WS_SEL + 1 * MiB;
constexpr int CW_BAR = 4096;
constexpr int RING_OFF = 0, RING_BYTES = 131072, EPI_OFF = 131072, LDSCTL_OFF = 139264, MISC_OFF = LDSCTL_OFF + 320, LDS_BYTES = 147456;
static_assert(att::LDS_BYTES <= RING_BYTES && pg8::EPI_LDS_OFF == EPI_OFF, "LDS map");

#define GAS __attribute__((address_space(1)))
#define LAS __attribute__((address_space(3)))
typedef unsigned short bf16;
typedef unsigned v4u __attribute__((ext_vector_type(4)));
typedef unsigned v2u __attribute__((ext_vector_type(2)));
typedef float f32x4 __attribute__((ext_vector_type(4)));
typedef float f32x2 __attribute__((ext_vector_type(2)));
typedef GAS unsigned gu32;
#define RLX_AGENT __ATOMIC_RELAXED, __HIP_MEMORY_SCOPE_AGENT
#define LDS_WAIT() asm volatile("s_waitcnt lgkmcnt(0)" ::: "memory")
#define VM_WAIT() asm volatile("s_waitcnt vmcnt(0)" ::: "memory")
__device__ __forceinline__ unsigned f2bf(float f) { unsigned u = __builtin_bit_cast(unsigned, f); return (u + 0x7fffu + ((u >> 16) & 1u)) >> 16; }
__device__ __forceinline__ unsigned pk2(float lo, float hi) { return f2bf(lo) | (f2bf(hi) << 16); }
__device__ __forceinline__ float wave_sum(float v) {
#pragma unroll
    for (int o = 1; o < 64; o <<= 1) v += __shfl_xor(v, o);
    return v;
}

#define XB_TMO      128
#define XB_XCNT(j)  (256  + 64 * (j))
#define XB_XSUB(j)  (1280 + 64 * (j))
#define XB_XGEN(j)  (2304 + 64 * (j))
#define XB_TOP      3328
#define XB_TOPGEN   3392
#define XCD_BAR_WORDS 3456
#define XB_SPIN_CAP (1u << 18)

__device__ __forceinline__ unsigned xb_ld(unsigned* p)              { return __hip_atomic_load(p, __ATOMIC_RELAXED, __HIP_MEMORY_SCOPE_AGENT); }
__device__ __forceinline__ unsigned xb_add(unsigned* p, unsigned v) { return __hip_atomic_fetch_add(p, v, __ATOMIC_RELAXED, __HIP_MEMORY_SCOPE_AGENT); }
__device__ __forceinline__ unsigned xb_xcc_id() { return (unsigned)__builtin_amdgcn_s_getreg((3 << 11) | 20) & 0xFu; }
#define XB_SPIN(cond, bar) do { unsigned _sp = 0; while (cond) { __builtin_amdgcn_s_sleep(1); \
    if ((++_sp & 255u) == 0u) { if (xb_ld(&(bar)[XB_TMO])) break; if (_sp > XB_SPIN_CAP) { atomicAdd(&(bar)[XB_TMO], 1u); break; } } } } while (0)

struct XcdBarrier {
    unsigned* bar; unsigned x;
    volatile LAS unsigned* st;
};

__device__ __forceinline__ XcdBarrier xcd_barrier_post(unsigned* bar, volatile LAS unsigned* st, int wave) {
    XcdBarrier b; b.bar = bar; b.x = xb_xcc_id(); b.st = st;
    if (XB_TID == 0) (void)xb_add(&bar[XB_XCNT(b.x)], 1u);
    return b;
}
__device__ __forceinline__ void xcd_barrier_complete(unsigned* bar, unsigned x, unsigned& nloc, unsigned& nx) {
    const unsigned G = gridDim.x * gridDim.y * gridDim.z;
    unsigned sum, cnt, mine, sp = 0u;
    for (;;) {
        sum = 0u; cnt = 0u; mine = 0u;
#pragma unroll
        for (unsigned j = 0; j < 16; ++j) { const unsigned c = xb_ld(&bar[XB_XCNT(j)]); sum += c; cnt += (c > 0u) ? 1u : 0u; mine = (j == x) ? c : mine; }
        if (sum == G) break;
        __builtin_amdgcn_s_sleep(1);
        if ((++sp & 255u) == 0u) { if (xb_ld(&bar[XB_TMO])) break; if (sp > XB_SPIN_CAP) { atomicAdd(&bar[XB_TMO], 1u); break; } }
    }
    nloc = mine > 0u ? mine : 1u; nx = cnt > 0u ? cnt : 1u;
}

__device__ __forceinline__ void xcd_barrier(const XcdBarrier& b, int wave) {
    asm volatile("s_waitcnt vmcnt(0)" ::: "memory");
    __syncthreads();
    if (XB_TID == 0) {
        unsigned* bar = b.bar;
        __builtin_amdgcn_s_waitcnt(0);
        unsigned nloc = b.st[0], nx = b.st[1];
        if (nloc == 0u) { xcd_barrier_complete(bar, b.x, nloc, nx); b.st[0] = nloc; b.st[1] = nx; }
        const unsigned old = xb_add(&bar[XB_XSUB(b.x)], 1u);
        const unsigned gen = old / nloc;
        if (old + 1u == (gen + 1u) * nloc) {
            __builtin_amdgcn_fence(__ATOMIC_RELEASE, "agent");
            asm volatile("s_waitcnt vmcnt(0)" ::: "memory");
            const unsigned og = xb_add(&bar[XB_TOP], 1u);
            const unsigned tg = og / nx;
            if (og + 1u == (tg + 1u) * nx) xb_add(&bar[XB_TOPGEN], 1u);
            else XB_SPIN(xb_ld(&bar[XB_TOPGEN]) == tg, bar);
            __builtin_amdgcn_fence(__ATOMIC_ACQUIRE, "agent");
            xb_add(&bar[XB_XGEN(b.x)], 1u);
            asm volatile("s_waitcnt vmcnt(0)" ::: "memory");
        } else {
            XB_SPIN(xb_ld(&bar[XB_XGEN(b.x)]) == gen, bar);
            __builtin_amdgcn_fence(__ATOMIC_ACQUIRE, "agent");
            asm volatile("s_waitcnt vmcnt(0)" ::: "memory");
        }
    }
    __syncthreads();
}

struct Args { const float* in[23]; float* out; unsigned char* ws; int ph_lo, ph_hi; };

__device__ __forceinline__ void tr_item(const float* __restrict__ src, int ld, int K, bf16* __restrict__ dst, const float* __restrict__ scale, int n0, int k0, int drow0, LAS float* scr, int lane) {
    const int kr = lane >> 4, n4 = lane & 15;
    f32x4 v[16];
#pragma unroll
    for (int i = 0; i < 16; ++i) v[i] = *(const f32x4*)(src + (size_t)(k0 + 4 * i + kr) * ld + n0 + 4 * n4);
#pragma unroll
    for (int i = 0; i < 16; ++i) { LAS float* p = scr + (4 * i + kr) * 65 + 4 * n4; p[0] = v[i][0]; p[1] = v[i][1]; p[2] = v[i][2]; p[3] = v[i][3]; }
    LDS_WAIT(); asm volatile("" ::: "memory");
    const int c = lane & 7, nn = lane >> 3;
    f32x4 s0 = (f32x4){1.f, 1.f, 1.f, 1.f}, s1 = s0;
    if (scale) { s0 = *(const f32x4*)(scale + k0 + 8 * c); s1 = *(const f32x4*)(scale + k0 + 8 * c + 4); }
#pragma unroll
    for (int j = 0; j < 8; ++j) { const int n = nn + 8 * j; const LAS float* s = scr + (8 * c) * 65 + n;
        v4u o; o.x = pk2(s[0 * 65] * s0[0], s[1 * 65] * s0[1]); o.y = pk2(s[2 * 65] * s0[2], s[3 * 65] * s0[3]); o.z = pk2(s[4 * 65] * s1[0], s[5 * 65] * s1[1]); o.w = pk2(s[6 * 65] * s1[2], s[7 * 65] * s1[3]);
        *(v4u*)(dst + (size_t)(drow0 + n) * K + k0 + 8 * c) = o; }
    LDS_WAIT(); asm volatile("" ::: "memory");
}
__device__ __forceinline__ void tr_job(const float* src, int ld, int K, int N, bf16* dst, const float* scale, int ilv, int r, LAS float* scr, int lane) {
    const int nb = N / 64, kb = r / nb, nbi = r % nb, n0 = nbi * 64;
    int drow0 = n0;
    if (ilv) { const int hsel = n0 >= ilv ? 1 : 0, nn = n0 - hsel * ilv; drow0 = (nn >> 7) * 256 + hsel * 128 + (nn & 127); }
    tr_item(src, ld, K, dst, scale, n0, kb * 64, drow0, scr, lane);
}

__device__ __forceinline__ void s5_ops_group(const Args& a, int g, LAS float* L, int tid) {
    const float* a_re = a.in[14]; const float* a_im = a.in[15]; const float* log_dt = a.in[16]; const float* b_re = a.in[17]; const float* b_im = a.in[18];
    const float* c_re = a.in[19]; const float* c_im = a.in[20]; const float* dsk = a.in[21];
    LAS float* apr = L; LAS float* api = L + 2112; LAS float* qr = L + 4224; LAS float* qi = qr + 64; LAS float* Cr = qi + 64; LAS float* Ci = Cr + 1024;
    LAS float* Br = Ci + 1024; LAS float* Bi = Br + 1024; LAS float* Kt = Bi + 1024;
    bf16* TV = (bf16*)(a.ws + WS_S5TV) + (size_t)g * 512 * 640; bf16* W = (bf16*)(a.ws + WS_S5W) + (size_t)g * 256 * 512;
    const float dt = expf(log_dt[g]);
    for (int idx = tid; idx < 33 * 64; idx += 512) { const int tau = idx >> 6, p = idx & 63; const float ar = a_re[g * 64 + p], ai = a_im[g * 64 + p];
        const float mag = expf(ar * dt * (float)tau); float sn, cs; sincosf(ai * dt * (float)tau, &sn, &cs); apr[idx] = mag * cs; api[idx] = mag * sn; }
    if (tid < 64) { const float ar = a_re[g * 64 + tid], ai = a_im[g * 64 + tid]; const float er = expf(ar * dt); float sn, cs; sincosf(ai * dt, &sn, &cs);
        const float nr = er * cs - 1.f, ni = er * sn, den = ar * ar + ai * ai; qr[tid] = (nr * ar + ni * ai) / den; qi[tid] = (ni * ar - nr * ai) / den; }
    for (int idx = tid; idx < 1024; idx += 512) { Cr[idx] = c_re[(size_t)g * 1024 + idx]; Ci[idx] = c_im[(size_t)g * 1024 + idx]; }
    __syncthreads();
    for (int idx = tid; idx < 1024; idx += 512) { const int p = idx >> 4; const float br = b_re[(size_t)g * 1024 + idx], bi = b_im[(size_t)g * 1024 + idx];
        Br[idx] = qr[p] * br - qi[p] * bi; Bi[idx] = qr[p] * bi + qi[p] * br; }
    __syncthreads();
    for (int idx = tid; idx < 32 * 256; idx += 512) { const int tau = idx >> 8, c = (idx >> 4) & 15, cp = idx & 15; float s = 0.f;
        for (int p = 0; p < 64; ++p) { const float ar_ = apr[tau * 64 + p], ai_ = api[tau * 64 + p], br = Br[p * 16 + cp], bi = Bi[p * 16 + cp];
            const float xr = ar_ * br - ai_ * bi, xi = ar_ * bi + ai_ * br; s += Cr[c * 64 + p] * xr - Ci[c * 64 + p] * xi; }
        if (tau == 0 && c == cp) s += dsk[g * 16 + c];
        Kt[idx] = s; }
    __syncthreads();
    for (int idx = tid; idx < 512 * 80; idx += 512) { const int n = idx / 80, ch = idx % 80, j = n >> 4, c = n & 15; float o[8];
        if (ch < 64) { const int jp = ch >> 1, c0 = (ch & 1) * 8;
#pragma unroll
            for (int e = 0; e < 8; ++e) o[e] = (jp <= j) ? Kt[(j - jp) * 256 + c * 16 + c0 + e] : 0.f; }
        else { const int p0 = (ch - 64) * 4;
#pragma unroll
            for (int e = 0; e < 4; ++e) { const int p = p0 + e; const float ar_ = apr[(j + 1) * 64 + p], ai_ = api[(j + 1) * 64 + p], cr = Cr[c * 64 + p], ci = Ci[c * 64 + p];
                o[2 * e] = cr * ar_ - ci * ai_; o[2 * e + 1] = -(cr * ai_ + ci * ar_); } }
        v4u w; w.x = pk2(o[0], o[1]); w.y = pk2(o[2], o[3]); w.z = pk2(o[4], o[5]); w.w = pk2(o[6], o[7]);
        *(v4u*)(TV + (size_t)n * 640 + ch * 8) = w; }
    for (int idx = tid; idx < 128 * 64; idx += 512) { const int n = idx >> 6, ch = idx & 63, p = n >> 1, ri = n & 1, jp = ch >> 1, c0 = (ch & 1) * 8; float o[8];
        const float ar_ = apr[(31 - jp) * 64 + p], ai_ = api[(31 - jp) * 64 + p];
#pragma unroll
        for (int e = 0; e < 8; ++e) { const float br = Br[p * 16 + c0 + e], bi = Bi[p * 16 + c0 + e]; o[e] = ri ? (ar_ * bi + ai_ * br) : (ar_ * br - ai_ * bi); }
        v4u w; w.x = pk2(o[0], o[1]); w.y = pk2(o[2], o[3]); w.z = pk2(o[4], o[5]); w.w = pk2(o[6], o[7]);
        *(v4u*)(W + (size_t)n * 512 + ch * 8) = w; }
    __syncthreads();
}

__device__ __forceinline__ void p0_prologue(const Args& a, LAS unsigned char* lds, int tid, int lane, int wave, int vcu, int G) {
    const float* x = a.in[0]; const float* p = a.in[1]; const float* norm_g = a.in[2];
    unsigned char* ws = a.ws;
    for (int g = vcu; g < 128; g += G) s5_ops_group(a, g, (LAS float*)lds, tid);
    LAS float* scr = (LAS float*)(lds + wave * 16640);
    const int gw = vcu * NWAVES + wave, NGW = G * NWAVES;
    constexpr int I_FI = 32 * 176, I_FO = 88 * 32, I_PG = 32 * 32, I_PPJ = 4 * 32, I_QKV = 32 * 96, I_WO = 32 * 32, I_S5I = 32 * 32, I_GLU = 32 * 64;
    constexpr int N_TR = 8 * I_FI + 8 * I_FO + 4 * I_PG + 4 * I_PPJ + 3 * I_QKV + 3 * I_WO + I_S5I + I_GLU;
    constexpr int I_X = M, I_P = 4 * M * PLE / 512, I_WF = 32;
    constexpr int NITEMS = N_TR + I_X + I_P + I_WF;
    for (int it = gw; it < NITEMS; it += NGW) {
        int r = it;
        if (r < 8 * I_FI) { const int m = r / I_FI, layer = m >> 1, half = m & 1;
            tr_job(a.in[4] + (size_t)m * DM * 2 * FF, 2 * FF, DM, 2 * FF, (bf16*)(ws + WS_WFI) + (size_t)m * 2 * FF * DM, norm_g + (layer * 4 + half * 2) * DM, FF, r % I_FI, scr, lane); continue; } r -= 8 * I_FI;
        if (r < 8 * I_FO) { const int m = r / I_FO;
            tr_job(a.in[5] + (size_t)m * FF * DM, DM, FF, DM, (bf16*)(ws + WS_WFO) + (size_t)m * DM * FF, nullptr, 0, r % I_FO, scr, lane); continue; } r -= 8 * I_FO;
        if (r < 4 * I_PG) { const int m = r / I_PG;
            tr_job(a.in[6] + (size_t)m * DM * DM, DM, DM, DM, (bf16*)(ws + WS_WPG) + (size_t)m * DM * DM, norm_g + (m * 4 + 3) * DM, 0, r % I_PG, scr, lane); continue; } r -= 4 * I_PG;
        if (r < 4 * I_PPJ) { const int m = r / I_PPJ;
            tr_job(a.in[7] + (size_t)m * PLE * DM, DM, PLE, DM, (bf16*)(ws + WS_WPP) + (size_t)m * DM * PLE, nullptr, 0, r % I_PPJ, scr, lane); continue; } r -= 4 * I_PPJ;
        if (r < 3 * I_QKV) { const int m = r / I_QKV;
            const float* src = m == 1 ? a.in[11] : a.in[8] + (size_t)(m >> 1) * DM * (3 * DM + NH); const int ld = m == 1 ? 3 * DM : 3 * DM + NH; const int layer = m == 2 ? 3 : m;
            tr_job(src, ld, DM, 3 * DM, (bf16*)(ws + WS_WQKV) + (size_t)m * 3 * DM * DM, norm_g + (layer * 4 + 1) * DM, 0, r % I_QKV, scr, lane); continue; } r -= 3 * I_QKV;
        if (r < 3 * I_WO) { const int m = r / I_WO; const float* src = m == 1 ? a.in[12] : a.in[10] + (size_t)(m >> 1) * DM * DM;
            tr_job(src, DM, DM, DM, (bf16*)(ws + WS_WO) + (size_t)m * DM * DM, nullptr, 0, r % I_WO, scr, lane); continue; } r -= 3 * I_WO;
        if (r < I_S5I) { tr_job(a.in[13], DM, DM, DM, (bf16*)(ws + WS_WS5I), norm_g + (2 * 4 + 1) * DM, 0, r, scr, lane); continue; } r -= I_S5I;
        if (r < I_GLU) { tr_job(a.in[22], 2 * DM, DM, 2 * DM, (bf16*)(ws + WS_WGLU), nullptr, DM, r, scr, lane); continue; } r -= I_GLU;
        if (r < I_X) {
            const f32x4* xr = (const f32x4*)(x + (size_t)r * DM) + lane; f32x4 v[8]; float s = 0.f;
#pragma unroll
            for (int j = 0; j < 8; ++j) { v[j] = xr[64 * j]; s += (v[j][0] * v[j][0] + v[j][1] * v[j][1]) + (v[j][2] * v[j][2] + v[j][3] * v[j][3]); }
            s = wave_sum(s);
            v2u* o = (v2u*)((bf16*)(ws + WS_HB) + (size_t)r * DM) + lane;
#pragma unroll
            for (int j = 0; j < 8; ++j) { v2u w; w.x = pk2(v[j][0], v[j][1]); w.y = pk2(v[j][2], v[j][3]); o[64 * j] = w; }
            if (lane < 4) ((f32x4*)((float*)(ws + WS_SSQ) + (size_t)r * 16))[lane] = (f32x4){lane == 0 ? s : 0.f, 0.f, 0.f, 0.f};
            continue; } r -= I_X;
        if (r < I_P) {
            const f32x4* src = (const f32x4*)(p + (size_t)r * 512) + 2 * lane; const f32x4 v0 = src[0], v1 = src[1];
            v4u w; w.x = pk2(v0[0], v0[1]); w.y = pk2(v0[2], v0[3]); w.z = pk2(v1[0], v1[1]); w.w = pk2(v1[2], v1[3]);
            ((v4u*)((bf16*)(ws + WS_PBF) + (size_t)r * 512))[lane] = w; continue; } r -= I_P;
        {
            const int j = r >> 4, hd = r & 15, layer = j ? 3 : 0; const float* src = a.in[8] + (size_t)j * DM * (3 * DM + NH) + 3 * DM + hd; const float* g1 = norm_g + (layer * 4 + 1) * DM;
            float* dst = (float*)(ws + WS_WFT) + (size_t)(j * 16 + hd) * DM;
            for (int k = lane; k < DM; k += 64) dst[k] = g1[k] * src[(size_t)k * (3 * DM + NH)];
        }
    }
}

__device__ __forceinline__ void fox_gate_phase(const float* H, const float* WfT, const float* bfv, float* logf, int lane, int gw, int NGW) {
    for (int task = gw; task < M / 4; task += NGW) {
        const int r0 = task * 4;
        f32x4 xv[4][8]; float ss[4];
#pragma unroll
        for (int rr = 0; rr < 4; ++rr) { const f32x4* xr = (const f32x4*)(H + (size_t)(r0 + rr) * DM) + lane; float s = 0.f;
#pragma unroll
            for (int j = 0; j < 8; ++j) { xv[rr][j] = xr[64 * j]; s += (xv[rr][j][0] * xv[rr][j][0] + xv[rr][j][1] * xv[rr][j][1]) + (xv[rr][j][2] * xv[rr][j][2] + xv[rr][j][3] * xv[rr][j][3]); }
            ss[rr] = wave_sum(s); }
        float res[4] = {0.f, 0.f, 0.f, 0.f};
#pragma unroll 1
        for (int hd = 0; hd < 16; ++hd) { const f32x4* wr_ = (const f32x4*)(WfT + (size_t)hd * DM) + lane; float d[4] = {0.f, 0.f, 0.f, 0.f};
#pragma unroll
            for (int j = 0; j < 8; ++j) { const f32x4 w = wr_[64 * j];
#pragma unroll
                for (int rr = 0; rr < 4; ++rr) d[rr] += (xv[rr][j][0] * w[0] + xv[rr][j][1] * w[1]) + (xv[rr][j][2] * w[2] + xv[rr][j][3] * w[3]); }
#pragma unroll
            for (int rr = 0; rr < 4; ++rr) { const float t = wave_sum(d[rr]); if (lane == hd) res[rr] = t; } }
        if (lane < 16) { const float bb = bfv[lane];
#pragma unroll
            for (int rr = 0; rr < 4; ++rr) { const int r = r0 + rr, b = r >> 11, s = r & 2047; const float rstd = 1.0f / sqrtf(ss[rr] * (1.0f / DM) + 1e-6f);
                const float xg = res[rr] * rstd + bb; logf[(size_t)(b * 16 + lane) * SEQ + s] = fminf(xg, 0.f) - log1pf(expf(-fabsf(xg))); } }
    }
}
__device__ __forceinline__ void moba_kmean_phase(const bf16* Kh, float* km, int lane, int gw, int NGW) {
    for (int task = gw; task < 512; task += NGW) {
        const int rg = lane >> 4, ch = lane & 15; const bf16* base = Kh + ((size_t)task * 256 + rg) * HD + ch * 8; float s[8] = {0.f, 0.f, 0.f, 0.f, 0.f, 0.f, 0.f, 0.f};
#pragma unroll 8
        for (int i = 0; i < 64; ++i) { const v4u w = *(const v4u*)(base + (size_t)i * 4 * HD);
            s[0] += __uint_as_float(w.x << 16); s[1] += __uint_as_float(w.x & 0xffff0000u); s[2] += __uint_as_float(w.y << 16); s[3] += __uint_as_float(w.y & 0xffff0000u);
            s[4] += __uint_as_float(w.z << 16); s[5] += __uint_as_float(w.z & 0xffff0000u); s[6] += __uint_as_float(w.w << 16); s[7] += __uint_as_float(w.w & 0xffff0000u); }
#pragma unroll
        for (int e = 0; e < 8; ++e) { s[e] += __shfl_xor(s[e], 16); s[e] += __shfl_xor(s[e], 32); }
        if (rg == 0) { float* o = km + (size_t)task * HD + ch * 8;
            *(f32x4*)o = (f32x4){s[0], s[1], s[2], s[3]} * (1.f / 256.f); *(f32x4*)(o + 4) = (f32x4){s[4], s[5], s[6], s[7]} * (1.f / 256.f); }
    }
}
__device__ __forceinline__ void fox_bias_phase(const float* logf, float* bias, int lane, int gw, int NGW) {
    for (int task = gw; task < 64; task += NGW) {
        const f32x4* src = (const f32x4*)(logf + (size_t)task * SEQ + 32 * lane); f32x4 v[8]; float run = 0.f;
#pragma unroll
        for (int j = 0; j < 8; ++j) { v[j] = src[j]; v[j][0] += run; v[j][1] += v[j][0]; v[j][2] += v[j][1]; v[j][3] += v[j][2]; run = v[j][3]; }
        float sc = run;
#pragma unroll
        for (int o = 1; o < 64; o <<= 1) { const float t = __shfl_up(sc, o); if (lane >= o) sc += t; }
        const float base = sc - run, ns = -1.0f / att::SCALE; f32x4* dst = (f32x4*)(bias + (size_t)task * SEQ + 32 * lane);
#pragma unroll
        for (int j = 0; j < 8; ++j) dst[j] = (v[j] + base) * ns;
    }
}
__device__ __forceinline__ void moba_bias_phase(float* bias, int lane, int gw, int NGW) {
    for (int task = gw; task < 64 * 8; task += NGW) { const int bh = task >> 3, s0 = (task & 7) * 256 + 4 * lane;
        const float sl = exp2f(-0.5f * (float)((bh & 15) + 1)) * (1.0f / att::SCALE);
        *(f32x4*)(bias + (size_t)bh * SEQ + s0) = (f32x4){sl * (float)s0, sl * (float)(s0 + 1), sl * (float)(s0 + 2), sl * (float)(s0 + 3)}; }
}
__device__ __forceinline__ void moba_select_phase(const bf16* Qh, const float* km, unsigned* sel, int lane, int gw, int NGW) {
    for (int task = gw; task < 64 * 32; task += NGW) {
        const int bh = task >> 5, t0 = (task & 31) * 64, own = t0 >> 8;
        const bf16* qrow = Qh + ((size_t)bh * SEQ + t0 + lane) * HD; const float* kmb = km + (size_t)bh * 8 * HD;
        float gt[8];
#pragma unroll
        for (int n = 0; n < 8; ++n) gt[n] = 0.f;
#pragma unroll 2
        for (int c = 0; c < 16; ++c) { const v4u w = *(const v4u*)(qrow + c * 8); float q[8];
            q[0] = __uint_as_float(w.x << 16); q[1] = __uint_as_float(w.x & 0xffff0000u); q[2] = __uint_as_float(w.y << 16); q[3] = __uint_as_float(w.y & 0xffff0000u);
            q[4] = __uint_as_float(w.z << 16); q[5] = __uint_as_float(w.z & 0xffff0000u); q[6] = __uint_as_float(w.w << 16); q[7] = __uint_as_float(w.w & 0xffff0000u);
#pragma unroll
            for (int n = 0; n < 7; ++n) if (n < own) { const float* kp = kmb + n * HD + c * 8;
#pragma unroll
                for (int j = 0; j < 8; ++j) gt[n] = fmaf(q[j], kp[j], gt[n]); } }
        unsigned m = 0u;
#pragma unroll
        for (int r = 0; r < 3; ++r) { int best = -1; float bv = -__builtin_inff();
#pragma unroll
            for (int n = 0; n < 7; ++n) if (n < own && !((m >> n) & 1u) && gt[n] > bv) { bv = gt[n]; best = n; }
            if (best >= 0) m |= 1u << best; }
        sel[(size_t)bh * SEQ + t0 + lane] = m;
    }
}
__device__ __forceinline__ void s5_scan_phase(const Args& a, int lane, int wave, int vcu, int G) {
    const float* a_re = a.in[14]; const float* a_im = a.in[15]; const float* log_dt = a.in[16];
    const float* Hl = (const float*)(a.ws + WS_HLOC); bf16* UH = (bf16*)(a.ws + WS_UH);
    for (int task = wave * G + vcu; task < 512; task += NWAVES * G) {
        const int g = task >> 2, b = task & 3, p = lane; const float dt = expf(log_dt[g]);
        const float mag = expf(a_re[g * 64 + p] * dt * 32.f); float sn, cs; sincosf(a_im[g * 64 + p] * dt * 32.f, &sn, &cs); const float ar = mag * cs, ai = mag * sn;
        float hr = 0.f, hi = 0.f;
#pragma unroll 8
        for (int k = 0; k < 64; ++k) { const size_t row = (size_t)g * 256 + b * 64 + k;
            *(unsigned*)(UH + row * 640 + 512 + 2 * p) = pk2(hr, hi);
            const f32x2 hl = *(const f32x2*)(Hl + row * 128 + 2 * p);
            const float nr = ar * hr - ai * hi + hl[0], ni = ar * hi + ai * hr + hl[1]; hr = nr; hi = ni; }
    }
}
__device__ __forceinline__ void final_norm_phase(const float* H, const float* ssq, const float* fg, float* out, int lane, int gw, int NGW) {
    for (int r = gw; r < M; r += NGW) {
        const f32x4* sp = (const f32x4*)(ssq + (size_t)r * 16); const f32x4 s4 = sp[0] + sp[1];
        const float rstd = 1.0f / sqrtf(((s4[0] + s4[1]) + (s4[2] + s4[3])) * (1.0f / DM) + 1e-6f);
        const f32x4* xr = (const f32x4*)(H + (size_t)r * DM) + lane; const f32x4* gr = (const f32x4*)fg + lane; f32x4* o = (f32x4*)(out + (size_t)r * DM) + lane;
#pragma unroll
        for (int j = 0; j < 8; ++j) o[64 * j] = xr[64 * j] * gr[64 * j] * rstd;
    }
}

__global__ void __launch_bounds__(NWAVES * 64, 2) mk_fwd(Args args) {
    extern __shared__ __attribute__((aligned(16))) unsigned char lds[];
    LAS unsigned char* L = (LAS unsigned char*)lds;
    volatile LAS unsigned* MISC = (volatile LAS unsigned*)(L + MISC_OFF);
    const int wave = __builtin_amdgcn_readfirstlane((int)threadIdx.x >> 6);
    const int tid = MK_TID();
#define TIDL() ({ int t_ = MK_TID(); asm volatile("" : "+v"(t_)); t_; })
    const int G = gridDim.x; const int bx = blockIdx.x; const int vcu = (G % 8 == 0) ? (bx % 8) * (G / 8) + bx / 8 : bx;
    const int gw = vcu * NWAVES + wave, NGW = G * NWAVES;
    unsigned char* ws = args.ws;
    unsigned* ctl = (unsigned*)(ws + WS_CTL);
    for (int u = tid; u < (LDS_BYTES - LDSCTL_OFF) / 4; u += NWAVES * 64) ((LAS unsigned*)(L + LDSCTL_OFF))[u] = 0u;
    __syncthreads();
    const int lo = args.ph_lo, hi = args.ph_hi;
    const bool single = (hi - lo) > 1;
    XcdBarrier bar; bar.bar = ctl + CW_BAR; bar.x = 0; bar.st = nullptr;
    if (single) bar = xcd_barrier_post(ctl + CW_BAR, MISC + 8, wave);
    int pc = 0;
#ifndef MK_SITES
#define MK_SITES 0xffffffu
#endif
#define SITE(n) (((MK_SITES >> (n)) & 1u) != 0u)
#define RUN() (pc >= lo && pc < hi)
#define SEAM() do { if (pc >= lo && pc + 1 < hi) xcd_barrier(bar, wave); ++pc; } while (0)
#define H ((float*)(ws + WS_H))
#define ACT ((bf16*)(ws + WS_ACT))
#define QKV ((bf16*)(ws + WS_QKV))
#define OB ((bf16*)(ws + WS_OB))
#define PP ((bf16*)(ws + WS_PP))
#define LOGF ((float*)(ws + WS_LOGF))
#define KMEAN ((float*)(ws + WS_KMEAN))
#define UH ((bf16*)(ws + WS_UH))
#define HLOC ((float*)(ws + WS_HLOC))
#define YB ((bf16*)(ws + WS_YB))

    if (SITE(0) && RUN()) { const int t = TIDL(); p0_prologue(args, L, t, t & 63, wave, vcu, G); }
    SEAM();
    if (SITE(1) && RUN()) { pg8::Gemm g{(const bf16*)(ws + WS_PBF), (const bf16*)(ws + WS_WPP), PLE, PLE, PLE}; pg8::PpOrder S; S.init(G, bx);
        pg8::EpiBf16 E{PP, DM, nullptr, 0}; pg8::gemm_phase(L + RING_OFF, g, S, E, wave); }
    SEAM();
    int np = 8, sel = 0;
#define HBR ((const bf16*)(ws + (sel ? WS_HB2 : WS_HB)))
#define HBW ((bf16*)(ws + (sel ? WS_HB : WS_HB2)))
#define SSQR ((const float*)(ws + WS_SSQ) + (sel ? M * 16 : 0))
#define SSQW ((float*)(ws + WS_SSQ) + (sel ? 0 : M * 16))
    for (int layer = 0; layer < DEPTH; ++layer) {
        const int kind = layer % 3;
        for (int half = 0; half < 2; ++half) {
            if (SITE(2) && RUN()) { pg8::Gemm g{HBR, (const bf16*)(ws + WS_WFI) + (size_t)(layer * 2 + half) * 2 * FF * DM, DM, DM, DM}; pg8::StaticOrder S; S.init(M, 2 * FF, G, bx);
                pg8::EpiSwiglu E{ACT, FF, SSQR, np}; pg8::gemm_phase(L + RING_OFF, g, S, E, wave); }
            SEAM();
            if (SITE(3) && RUN()) { pg8::Gemm g{ACT, (const bf16*)(ws + WS_WFO) + (size_t)(layer * 2 + half) * DM * FF, FF, FF, FF}; pg8::StaticOrder S; S.init(M, DM, G, bx);
                pg8::EpiRes<0> E{(layer == 0 && half == 0) ? args.in[0] : H, H, HBW, SSQW, 0.5f, nullptr, 0, nullptr}; pg8::gemm_phase(L + RING_OFF, g, S, E, wave); }
            SEAM(); np = 8; sel ^= 1;
            if (half == 0) {
                if (kind < 2) {
                    const int wslot = layer == 0 ? 0 : (layer == 1 ? 1 : 2);
                    if (kind == 0) { if (SITE(4) && RUN()) fox_gate_phase(H, (const float*)(ws + WS_WFT) + (size_t)(layer / 3) * 16 * DM, args.in[9] + (layer / 3) * 16, LOGF, TIDL() & 63, gw, NGW); SEAM(); }
                    if (RUN()) {
                        if (SITE(4) && kind == 0) fox_bias_phase(LOGF, (float*)(ws + WS_BIAS), TIDL() & 63, wave * G + vcu, NGW);
                        if (SITE(5)) { pg8::Gemm g{HBR, (const bf16*)(ws + WS_WQKV) + (size_t)wslot * 3 * DM * DM, DM, DM, DM}; pg8::StaticOrder S; S.init(M, 3 * DM, G, bx);
                        pg8::EpiQkv E{QKV, SSQR, np}; pg8::gemm_phase(L + RING_OFF, g, S, E, wave); } }
                    SEAM();
                    if (kind == 1) {
                        if (SITE(6) && RUN()) { moba_kmean_phase(QKV + (size_t)M * DM, KMEAN, TIDL() & 63, gw, NGW); moba_bias_phase((float*)(ws + WS_BIAS), TIDL() & 63, gw, NGW); }
                        SEAM();
                        if (SITE(6) && RUN()) moba_select_phase(QKV, KMEAN, (unsigned*)(ws + WS_SEL), TIDL() & 63, gw, NGW);
                        SEAM(); }
                    if (RUN()) {
                        if (kind == 0) { if (SITE(7)) att::attn_phase<false>((char*)lds + RING_OFF, QKV, QKV + (size_t)M * DM, QKV + (size_t)2 * M * DM, OB, (const float*)(ws + WS_BIAS), nullptr, wave); }
                        else if (SITE(8)) att::attn_phase<true>((char*)lds + RING_OFF, QKV, QKV + (size_t)M * DM, QKV + (size_t)2 * M * DM, OB, (const float*)(ws + WS_BIAS), (const unsigned*)(ws + WS_SEL), wave); }
                    SEAM();
                    if (SITE(9) && RUN()) { pg8::Gemm g{OB, (const bf16*)(ws + WS_WO) + (size_t)wslot * DM * DM, DM, DM, DM}; pg8::StaticOrder S; S.init(M, DM, G, bx);
                        pg8::EpiRes<0> E{H, H, HBW, SSQW, 1.0f, nullptr, 0, nullptr}; pg8::gemm_phase(L + RING_OFF, g, S, E, wave); }
                    SEAM(); sel ^= 1;
                } else {
                    if (SITE(10) && RUN()) { pg8::Gemm g{HBR, (const bf16*)(ws + WS_WS5I), DM, DM, DM}; pg8::StaticOrder S; S.init(M, DM, G, bx);
                        pg8::EpiS5U E{UH, SSQR, np}; pg8::gemm_phase(L + RING_OFF, g, S, E, wave); }
                    SEAM();
                    if (SITE(11) && RUN()) { pg8::Gemm g{UH, (const bf16*)(ws + WS_S5W), 640, 512, 512}; pg8::BatchOrder<1> S; S.init(G, bx);
                        pg8::EpiS5H E{HLOC}; pg8::gemm_phase(L + RING_OFF, g, S, E, wave); }
                    SEAM();
                    if (SITE(12) && RUN()) s5_scan_phase(args, TIDL() & 63, wave, vcu, G);
                    SEAM();
                    if (SITE(13) && RUN()) { pg8::Gemm g{UH, (const bf16*)(ws + WS_S5TV), 640, 640, 640}; pg8::BatchOrder<2> S; S.init(G, bx);
                        pg8::EpiS5Y E{YB}; pg8::gemm_phase(L + RING_OFF, g, S, E, wave); }
                    SEAM();
                    if (SITE(14) && RUN()) { pg8::Gemm g{YB, (const bf16*)(ws + WS_WGLU), DM, DM, DM}; pg8::StaticOrder S; S.init(M, 2 * DM, G, bx);
                        pg8::EpiRes<2> E{H, H, HBW, SSQW, 1.0f, nullptr, 0, nullptr}; pg8::gemm_phase(L + RING_OFF, g, S, E, wave); }
                    SEAM(); np = 16; sel ^= 1;
                }
            } else {
                if (SITE(15) && RUN()) { pg8::Gemm g{HBR, (const bf16*)(ws + WS_WPG) + (size_t)layer * DM * DM, DM, DM, DM}; pg8::StaticOrder S; S.init(M, DM, G, bx);
                    pg8::EpiRes<1> E{H, H, HBW, SSQW, 1.0f, SSQR, np, PP + (size_t)layer * M * DM}; pg8::gemm_phase(L + RING_OFF, g, S, E, wave); }
                SEAM(); sel ^= 1;
            }
        }
    }
    if (SITE(16) && RUN()) final_norm_phase(H, SSQR, args.in[3], args.out, TIDL() & 63, gw, NGW);
#undef RUN
#undef SEAM
}
constexpr int N_PHASES = 2 + 4 * 5 + (4 + 5 + 4 + 5) + 1;

#ifndef MK_PER_PHASE
#define MK_PER_PHASE 0
#endif
static void mk_launch(void* const* d_in, float* d_out, void* d_ws, hipStream_t stream) {
    static int grid = 0;
    if (grid == 0) {
        int dev = 0, cus = 0, per_cu = 0;
        if (hipGetDevice(&dev) != hipSuccess || hipDeviceGetAttribute(&cus, hipDeviceAttributeMultiprocessorCount, dev) != hipSuccess) { fprintf(stderr, "mk_launch: device query failed\n"); grid = -1; return; }
        if (hipFuncSetAttribute((const void*)mk_fwd, hipFuncAttributeMaxDynamicSharedMemorySize, LDS_BYTES) != hipSuccess) { fprintf(stderr, "mk_launch: hipFuncSetAttribute failed\n"); grid = -1; return; }
        if (hipOccupancyMaxActiveBlocksPerMultiprocessor(&per_cu, (const void*)mk_fwd, NWAVES * 64, LDS_BYTES) != hipSuccess || per_cu < 1) fprintf(stderr, "mk_launch: occupancy query reports %d\n", per_cu);
        (void)hipGetLastError();
        grid = cus;
    }
    if (grid < 0) return;
    if (hipMemsetAsync((char*)d_ws + WS_CTL, 0, CTL_ZERO_BYTES, stream) != hipSuccess) { fprintf(stderr, "mk_launch: memset failed\n"); return; }
    Args a{};
    for (int i = 0; i < 23; ++i) a.in[i] = (const float*)d_in[i];
    a.out = d_out; a.ws = (unsigned char*)d_ws;
#if MK_PER_PHASE
    for (int ph = 0; ph < N_PHASES; ++ph) { a.ph_lo = ph; a.ph_hi = ph + 1; hipLaunchKernelGGL(mk_fwd, dim3(grid), dim3(NWAVES * 64), LDS_BYTES, stream, a); }
#else
    a.ph_lo = 0; a.ph_hi = 1 << 20;
    hipLaunchKernelGGL(mk_fwd, dim3(grid), dim3(NWAVES * 64), LDS_BYTES, stream, a);
#endif
    const hipError_t le = hipPeekAtLastError();
    if (le != hipSuccess) fprintf(stderr, "mk_launch: launch failed: %s\n", hipGetErrorName(le));
}

extern "C" void kernel_launch(void* const* d_in, const int* in_sizes, int n_in, void* d_out, int out_size, void* d_ws, size_t ws_size, hipStream_t stream) {
    if (n_in != 23 || out_size != M * DM || in_sizes[0] != M * DM || ws_size < WS_END) { fprintf(stderr, "kernel_launch: unexpected shapes n_in=%d out=%d ws=%zu\n", n_in, out_size, ws_size); return; }
    mk_launch(d_in, (float*)d_out, d_ws, stream);
}
```

```cpp
#include <hip/hip_runtime.h>
#include <cstdio>
#include <cstdint>
#include <cmath>
#define MK_TID() ({ unsigned l_; asm volatile("v_mbcnt_lo_u32_b32 %0, -1, 0\n\tv_mbcnt_hi_u32_b32 %0, -1, %0" : "=v"(l_)); (int)(((unsigned)wave << 6) | l_); })
#define XB_TID ((unsigned)MK_TID())
namespace pg8 {
#define PG8_LAS __attribute__((address_space(3)))
typedef unsigned short bf16_t;
typedef short bf16x8 __attribute__((ext_vector_type(8)));
typedef float f32x4 __attribute__((ext_vector_type(4)));
typedef float f32x2 __attribute__((ext_vector_type(2)));
typedef unsigned u32x4 __attribute__((ext_vector_type(4)));
typedef unsigned u32x2 __attribute__((ext_vector_type(2)));
constexpr int BM = 256, BK = 64, HALF = 128, HTB = HALF * BK * 2  , STAGE_BYTES = 8 * HTB, NXCD = 8, WGM = 8;
constexpr int EPI_LDS_OFF = STAGE_BYTES;
constexpr float RMS_EPS = 1e-6f;

__host__ __device__ __forceinline__ int lds_byte(int r, int c) { const int st = (r >> 4) * 2 + (c >> 5), rr = r & 15, cc = c & 31, ob = rr * 64 + cc * 2; return st * 1024 + (ob ^ (((ob >> 9) & 1) << 5)); }
__host__ __device__ __forceinline__ void stage_rc(int b, int& R, int& C) { const int st = b / 1024, sb = b % 1024, swz = sb ^ (((sb >> 9) & 1) << 5); R = (st >> 1) * 16 + swz / 64; C = (st & 1) * 32 + (swz % 64) / 2; }
__host__ __device__ __forceinline__ int perm32(int rho) { const int n = rho >> 4, i = rho & 15; return 8 * (i >> 2) + 4 * n + (i & 3); }

struct Unit { int pm, pn, pb; };
struct Gemm { const bf16_t* A; const bf16_t* Bt; int lda, ldb, K; };

struct StaticOrder {
    int nM, nN, nwg, G, c;
    __device__ void init(int M, int N, int G_, int c_) { nM = M / BM; nN = N / BM; nwg = nM * nN; G = G_; c = c_; }
    __device__ bool next(int i, Unit& u) const {
        const long L = (long)i * G + c; if (L >= nwg) return false;
        int wgid = (int)L; { const int q = nwg / NXCD, r = nwg % NXCD, xcd = wgid % NXCD, off = wgid / NXCD; wgid = (xcd < r ? xcd * (q + 1) : r * (q + 1) + (xcd - r) * q) + off; }
        const int nig = WGM * nN, gid = wgid / nig, fm = gid * WGM, gsz = (nM - fm) < WGM ? (nM - fm) : WGM;
        u.pm = fm + ((wgid % nig) % gsz); u.pn = (wgid % nig) / gsz; u.pb = u.pn; return true;
    }
};
struct PpOrder {
    StaticOrder s;
    __device__ void init(int G_, int c_) { s.init(4 * 8192, 2048, G_, c_); }
    __device__ bool next(int i, Unit& u) const { if (!s.next(i, u)) return false; u.pb = (u.pm >> 5) * 8 + u.pn; return true; }
};
template <int NT> struct BatchOrder {
    int G, c;
    __device__ void init(int G_, int c_) { G = G_; c = c_; }
    __device__ bool next(int i, Unit& u) const { const int L = i * G + c; if (L >= 128 * NT) return false; u.pm = L / NT; u.pn = L % NT; u.pb = L; return true; }
};

__device__ __forceinline__ unsigned cvt_pk_bf16(float lo, float hi) { unsigned r; asm volatile("v_cvt_pk_bf16_f32 %0, %1, %2" : "=v"(r) : "v"(lo), "v"(hi)); return r; }
__device__ __forceinline__ float fast_sigmoid(float x) { return __builtin_amdgcn_rcpf(1.0f + __builtin_amdgcn_exp2f(-1.4426950408889634f * x)); }
__device__ __forceinline__ float fast_silu(float x) { return x * fast_sigmoid(x); }
__device__ __forceinline__ float gelu_tanh(float v) {
    const float z = 0.7978845608028654f * (v + 0.044715f * v * v * v); return v * fast_sigmoid(2.0f * z);
}

typedef f32x4 Acc[2][2][4][2];

__device__ __forceinline__ void row_rstd(const float* ssq, int np, const Unit& u, int wr, int fr, float (&rs)[2][4], PG8_LAS unsigned char* lds, int tid) {
    PG8_LAS float* R = (PG8_LAS float*)(lds + EPI_LDS_OFF + 4096);
    if (tid < 256) { const f32x4* sp = (const f32x4*)(ssq + ((size_t)u.pm * BM + tid) * 16);
        f32x4 a = sp[0] + sp[1]; if (np > 8) a += sp[2] + sp[3];
        R[tid] = __builtin_amdgcn_rsqf(((a[0] + a[1]) + (a[2] + a[3])) * (1.0f / 2048.0f) + RMS_EPS); }
    asm volatile("s_waitcnt lgkmcnt(0)" ::: "memory"); __builtin_amdgcn_s_barrier(); asm volatile("" ::: "memory");
#pragma unroll
    for (int ai = 0; ai < 2; ++ai)
#pragma unroll
        for (int m = 0; m < 4; ++m) rs[ai][m] = R[ai * HALF + wr * 64 + m * 16 + fr];
}

struct EpiSwiglu {
    static constexpr bool PERM = true, BAR = false;
    bf16_t* O; int ldo; const float* ssq; int np;
    __device__ __forceinline__ void operator()(const Acc& acc, const Unit& u, int wr, int wc, int fr, int fq, PG8_LAS unsigned char* lds, int tid) const {
        float rs[2][4]; row_rstd(ssq, np, u, wr, fr, rs, lds, tid);
        const int col0 = u.pn * HALF + wc * 32 + 8 * fq;
#pragma unroll
        for (int ai = 0; ai < 2; ++ai)
#pragma unroll
            for (int m = 0; m < 4; ++m) { const float s = rs[ai][m]; float o[8];
#pragma unroll
                for (int n = 0; n < 2; ++n)
#pragma unroll
                    for (int i = 0; i < 4; ++i) o[n * 4 + i] = fast_silu(acc[ai][0][m][n][i] * s) * (acc[ai][1][m][n][i] * s);
                u32x4 w; w.x = cvt_pk_bf16(o[0], o[1]); w.y = cvt_pk_bf16(o[2], o[3]); w.z = cvt_pk_bf16(o[4], o[5]); w.w = cvt_pk_bf16(o[6], o[7]);
                *(u32x4*)(O + (size_t)(u.pm * BM + ai * HALF + wr * 64 + m * 16 + fr) * ldo + col0) = w; }
    }
};
struct EpiBf16 {
    static constexpr bool PERM = true, BAR = false;
    bf16_t* O; int ldo; const float* ssq; int np;
    __device__ __forceinline__ void operator()(const Acc& acc, const Unit& u, int wr, int wc, int fr, int fq, PG8_LAS unsigned char* lds, int tid) const {
        float rs[2][4];
        if (ssq) row_rstd(ssq, np, u, wr, fr, rs, lds, tid); else {
#pragma unroll
            for (int a = 0; a < 2; ++a)
#pragma unroll
                for (int m = 0; m < 4; ++m) rs[a][m] = 1.f; }
        const int col0 = u.pn * BM + wc * 32 + 8 * fq;
#pragma unroll
        for (int ai = 0; ai < 2; ++ai)
#pragma unroll
            for (int m = 0; m < 4; ++m) { const float s = rs[ai][m]; bf16_t* rowp = O + (size_t)(u.pm * BM + ai * HALF + wr * 64 + m * 16 + fr) * ldo + col0;
#pragma unroll
                for (int bj = 0; bj < 2; ++bj) { const f32x4 v0 = acc[ai][bj][m][0] * s, v1 = acc[ai][bj][m][1] * s;
                    u32x4 w; w.x = cvt_pk_bf16(v0[0], v0[1]); w.y = cvt_pk_bf16(v0[2], v0[3]); w.z = cvt_pk_bf16(v1[0], v1[1]); w.w = cvt_pk_bf16(v1[2], v1[3]);
                    *(u32x4*)(rowp + bj * HALF) = w; } }
    }
};
struct EpiQkv {
    static constexpr bool PERM = true, BAR = false;
    bf16_t* O; const float* ssq; int np;
    __device__ __forceinline__ void operator()(const Acc& acc, const Unit& u, int wr, int wc, int fr, int fq, PG8_LAS unsigned char* lds, int tid) const {
        float rs[2][4]; row_rstd(ssq, np, u, wr, fr, rs, lds, tid);
        const int which = u.pn >> 3, hd0 = (u.pn & 7) * 2, d0 = wc * 32 + 8 * fq;
#pragma unroll
        for (int ai = 0; ai < 2; ++ai)
#pragma unroll
            for (int m = 0; m < 4; ++m) { const float s = rs[ai][m]; const int r = u.pm * BM + ai * HALF + wr * 64 + m * 16 + fr, b = r >> 11, t = r & 2047;
#pragma unroll
                for (int bj = 0; bj < 2; ++bj) { const f32x4 v0 = acc[ai][bj][m][0] * s, v1 = acc[ai][bj][m][1] * s;
                    u32x4 w; w.x = cvt_pk_bf16(v0[0], v0[1]); w.y = cvt_pk_bf16(v0[2], v0[3]); w.z = cvt_pk_bf16(v1[0], v1[1]); w.w = cvt_pk_bf16(v1[2], v1[3]);
                    *(u32x4*)(O + (size_t)which * (8192 * 2048) + ((size_t)((b * 16 + hd0 + bj) * 2048 + t)) * 128 + d0) = w; } }
    }
};
struct EpiS5U {
    static constexpr bool PERM = true, BAR = false;
    bf16_t* UH; const float* ssq; int np;
    __device__ __forceinline__ void operator()(const Acc& acc, const Unit& u, int wr, int wc, int fr, int fq, PG8_LAS unsigned char* lds, int tid) const {
        float rs[2][4]; row_rstd(ssq, np, u, wr, fr, rs, lds, tid);
#pragma unroll
        for (int ai = 0; ai < 2; ++ai)
#pragma unroll
            for (int m = 0; m < 4; ++m) { const float s = rs[ai][m]; const int r = u.pm * BM + ai * HALF + wr * 64 + m * 16 + fr;
#pragma unroll
                for (int bj = 0; bj < 2; ++bj) { const int cg = u.pn * BM + bj * HALF + wc * 32 + 8 * fq, g = cg >> 4, c0 = cg & 15;
                    const f32x4 v0 = acc[ai][bj][m][0] * s, v1 = acc[ai][bj][m][1] * s;
                    u32x4 w; w.x = cvt_pk_bf16(v0[0], v0[1]); w.y = cvt_pk_bf16(v0[2], v0[3]); w.z = cvt_pk_bf16(v1[0], v1[1]); w.w = cvt_pk_bf16(v1[2], v1[3]);
                    *(u32x4*)(UH + ((size_t)g * 256 + (r >> 5)) * 640 + (r & 31) * 16 + c0) = w; } }
    }
};
struct EpiS5H {
    static constexpr bool PERM = false, BAR = false;
    float* Hl;
    __device__ __forceinline__ void operator()(const Acc& acc, const Unit& u, int wr, int wc, int fr, int fq, PG8_LAS unsigned char* lds, int tid) const {
#pragma unroll
        for (int ai = 0; ai < 2; ++ai)
#pragma unroll
            for (int m = 0; m < 4; ++m) { float* rowp = Hl + ((size_t)u.pm * 256 + ai * HALF + wr * 64 + m * 16 + fr) * 128 + wc * 32 + 4 * fq;
#pragma unroll
                for (int n = 0; n < 2; ++n) *(f32x4*)(rowp + n * 16) = acc[ai][0][m][n]; }
    }
};
struct EpiS5Y {
    static constexpr bool PERM = true, BAR = false;
    bf16_t* Y;
    __device__ __forceinline__ void operator()(const Acc& acc, const Unit& u, int wr, int wc, int fr, int fq, PG8_LAS unsigned char* lds, int tid) const {
#pragma unroll
        for (int ai = 0; ai < 2; ++ai)
#pragma unroll
            for (int m = 0; m < 4; ++m) { const int crow = ai * HALF + wr * 64 + m * 16 + fr;
#pragma unroll
                for (int bj = 0; bj < 2; ++bj) { const int col = u.pn * BM + bj * HALF + wc * 32 + 8 * fq, j = col >> 4, c0 = col & 15;
                    float o[8];
#pragma unroll
                    for (int n = 0; n < 2; ++n)
#pragma unroll
                        for (int i = 0; i < 4; ++i) o[n * 4 + i] = gelu_tanh(acc[ai][bj][m][n][i]);
                    u32x4 w; w.x = cvt_pk_bf16(o[0], o[1]); w.y = cvt_pk_bf16(o[2], o[3]); w.z = cvt_pk_bf16(o[4], o[5]); w.w = cvt_pk_bf16(o[6], o[7]);
                    *(u32x4*)(Y + ((size_t)crow * 32 + j) * 2048 + u.pm * 16 + c0) = w; } }
    }
};
template <int MODE> struct EpiRes {
    static constexpr bool PERM = true, BAR = true;
    const bf16_t* hin; const float* hin32; bf16_t* hout; float* ssq_out; float alpha; const float* ssq; int np; const bf16_t* pp;
    __device__ __forceinline__ void operator()(const Acc& acc, const Unit& u, int wr, int wc, int fr, int fq, PG8_LAS unsigned char* lds, int tid) const {
        float rs[2][4];
        if (MODE == 1) row_rstd(ssq, np, u, wr, fr, rs, lds, tid);
        PG8_LAS float* P = (PG8_LAS float*)(lds + EPI_LDS_OFF);
        constexpr int NBJ = (MODE == 2) ? 1 : 2; constexpr int CW = (MODE == 2) ? HALF : BM;
#pragma unroll
        for (int ai = 0; ai < 2; ++ai)
#pragma unroll
            for (int m = 0; m < 4; ++m) { const int rl = ai * HALF + wr * 64 + m * 16 + fr; const size_t r = (size_t)u.pm * BM + rl; float sq = 0.f;
#pragma unroll
                for (int bj = 0; bj < NBJ; ++bj) { const int col = u.pn * CW + bj * HALF + wc * 32 + 8 * fq; const size_t off = r * 2048 + col;
                    float f[8], h[8];
                    if (MODE == 0) {
#pragma unroll
                        for (int e = 0; e < 8; ++e) f[e] = acc[ai][bj][m][e >> 2][e & 3] * alpha; }
                    else if (MODE == 1) { const u32x4 pw = *(const u32x4*)(pp + off); const float s = rs[ai][m];
#pragma unroll
                        for (int e = 0; e < 8; ++e) { const unsigned w = pw[e >> 1]; const float pv = __uint_as_float((e & 1) ? (w & 0xffff0000u) : (w << 16)); f[e] = fast_sigmoid(acc[ai][bj][m][e >> 2][e & 3] * s) * pv; } }
                    else {
#pragma unroll
                        for (int e = 0; e < 8; ++e) f[e] = acc[ai][0][m][e >> 2][e & 3] * fast_sigmoid(acc[ai][1][m][e >> 2][e & 3]); }
                    if (hin32) { const f32x4 a = *(const f32x4*)(hin32 + off), b = *(const f32x4*)(hin32 + off + 4);
#pragma unroll
                        for (int e = 0; e < 4; ++e) { h[e] = a[e]; h[4 + e] = b[e]; } }
                    else { const u32x4 hw = *(const u32x4*)(hin + off);
#pragma unroll
                        for (int e = 0; e < 8; ++e) { const unsigned w = hw[e >> 1]; h[e] = __uint_as_float((e & 1) ? (w & 0xffff0000u) : (w << 16)); } }
                    float o[8];
#pragma unroll
                    for (int e = 0; e < 8; ++e) { o[e] = h[e] + f[e]; sq = fmaf(o[e], o[e], sq); }
                    u32x4 w; w.x = cvt_pk_bf16(o[0], o[1]); w.y = cvt_pk_bf16(o[2], o[3]); w.z = cvt_pk_bf16(o[4], o[5]); w.w = cvt_pk_bf16(o[6], o[7]);
                    *(u32x4*)(hout + off) = w; }
                sq += __shfl_xor(sq, 16); sq += __shfl_xor(sq, 32);
                if (fq == 0) P[rl * 4 + wc] = sq;
                if (m & 1) asm volatile("" ::: "memory"); }
        asm volatile("s_waitcnt lgkmcnt(0)" ::: "memory"); __builtin_amdgcn_s_barrier(); asm volatile("" ::: "memory");
        if (tid < 256) { const f32x4 p4 = *(const PG8_LAS f32x4*)(P + tid * 4); ssq_out[((size_t)u.pm * BM + tid) * 16 + u.pn] = (p4[0] + p4[1]) + (p4[2] + p4[3]); }
    }
};

template <class Epi, class Sched>
__device__ __forceinline__ void gemm_phase(PG8_LAS unsigned char* lds, const Gemm g, const Sched& S, const Epi& E, const int wave) {
    int tid_raw_ = MK_TID(); asm volatile("" : "+v"(tid_raw_)); const int tid = tid_raw_, wid = __builtin_amdgcn_readfirstlane(tid >> 6), lane = tid & 63, wr = wid >> 2, wc = wid & 3, fr = lane & 15, fq = lane >> 4;
    int K_ = g.K; asm volatile("" : "+s"(K_)); const int K = K_, nt = K / BK;
    unsigned voffA[2], voffB[2];
#pragma unroll
    for (int i = 0; i < 2; ++i) { int R, C; stage_rc(tid * 16 + i * 8192, R, C); const int Rb = Epi::PERM ? ((R & ~31) + perm32(R & 31)) : R;
        voffA[i] = (unsigned)(R * g.lda + C) * 2u; voffB[i] = (unsigned)(Rb * g.ldb + C) * 2u; }
    const size_t kstep = (size_t)(BK * 2);
    const size_t hstepA = (size_t)HALF * g.lda * 2, hstepB = (size_t)HALF * g.ldb * 2;
    const size_t tstepA = 2 * hstepA, tstepB = 2 * hstepB;
    const unsigned ldsw = (unsigned)wid * 1024u;
    const int aoff = lds_byte(wr * 64 + fr, fq * 8), boff = lds_byte(wc * 32 + fr, fq * 8);
#define PG8_SA(b, h) (((b) * 2 + (h)) * HTB)
#define PG8_SB(b, h) ((4 + (b) * 2 + (h)) * HTB)
#define PG8_STAGE(bufoff, gbase, voff) do { _Pragma("unroll") for (int _i = 0; _i < 2; ++_i) \
        __builtin_amdgcn_global_load_lds((const unsigned*)((const char*)(gbase) + (voff)[_i]), (PG8_LAS unsigned*)(lds + (bufoff) + ldsw + _i * 8192), 16, 0, 0); } while (0)
#define PG8_LDA(dst, b, h) do { _Pragma("unroll") for (int m = 0; m < 4; ++m) _Pragma("unroll") for (int k = 0; k < 2; ++k) dst[m][k] = *(const PG8_LAS bf16x8*)(lds + PG8_SA(b, h) + aoff + m * 2048 + k * 1024); } while (0)
#define PG8_LDB(dst, b, h) do { _Pragma("unroll") for (int n = 0; n < 2; ++n) _Pragma("unroll") for (int k = 0; k < 2; ++k) dst[n][k] = *(const PG8_LAS bf16x8*)(lds + PG8_SB(b, h) + boff + n * 2048 + k * 1024); } while (0)
#define PG8_MMA(ai, bj, At, Bt) do { __builtin_amdgcn_s_setprio(1); _Pragma("unroll") for (int m = 0; m < 4; ++m) _Pragma("unroll") for (int n = 0; n < 2; ++n) _Pragma("unroll") for (int k = 0; k < 2; ++k) \
        acc[ai][bj][m][n] = __builtin_amdgcn_mfma_f32_16x16x32_bf16(Bt[n][k], At[m][k], acc[ai][bj][m][n], 0, 0, 0); __builtin_amdgcn_s_setprio(0); } while (0)
#define PG8_WAIT_V(n) asm volatile("s_waitcnt vmcnt(" #n ")" ::: "memory")
#define PG8_WAIT_L(n) asm volatile("s_waitcnt lgkmcnt(" #n ")" ::: "memory")
#define PG8_BAR __builtin_amdgcn_s_barrier()
#define PG8_SCHED __builtin_amdgcn_sched_barrier(0)
    Unit cur, nxt; int ui = 0;
    if (!S.next(0, cur)) return;
    f32x4 acc[2][2][4][2];
#pragma unroll
    for (int a = 0; a < 2; ++a)
#pragma unroll
        for (int b = 0; b < 2; ++b)
#pragma unroll
            for (int m = 0; m < 4; ++m)
#pragma unroll
                for (int n = 0; n < 2; ++n) acc[a][b][m][n] = (f32x4){0.f, 0.f, 0.f, 0.f};
    bf16x8 At[4][2], B0[2][2], B1[2][2];
    const char* cA = (const char*)g.A + (size_t)cur.pm * tstepA; const char* cB = (const char*)g.Bt + (size_t)cur.pb * tstepB;
    PG8_STAGE(PG8_SB(0, 0), cB, voffB); PG8_STAGE(PG8_SB(0, 1), cB + hstepB, voffB); PG8_STAGE(PG8_SA(0, 0), cA, voffA); PG8_STAGE(PG8_SA(0, 1), cA + hstepA, voffA);
    if (wr == 1) PG8_BAR;
    PG8_WAIT_V(2); PG8_BAR;
    PG8_STAGE(PG8_SB(1, 0), cB + kstep, voffB); PG8_STAGE(PG8_SA(1, 0), cA + kstep, voffA); PG8_STAGE(PG8_SB(1, 1), cB + hstepB + kstep, voffB);
    PG8_WAIT_V(6); PG8_BAR;
    for (;;) {
        const bool has_next = S.next(ui + 1, nxt);
        const char* nA = has_next ? (const char*)g.A + (size_t)nxt.pm * tstepA : cA; const char* nB = has_next ? (const char*)g.Bt + (size_t)nxt.pb * tstepB : cB;
        for (int t = 0; t < nt; t += 2) {
            const bool last = (t == nt - 2);
            const char* a1 = cA + (size_t)(t + 1) * kstep;
            const char* a2 = last ? nA : cA + (size_t)(t + 2) * kstep; const char* b2 = last ? nB : cB + (size_t)(t + 2) * kstep;
            const char* a3 = a2 + kstep; const char* b3 = b2 + kstep;
            PG8_LDB(B0, 0, 0); PG8_LDB(B1, 0, 1); PG8_SCHED; PG8_LDA(At, 0, 0); PG8_STAGE(PG8_SA(1, 1), a1 + hstepA, voffA);
            PG8_WAIT_V(8); PG8_WAIT_L(0); PG8_BAR; PG8_MMA(0, 0, At, B0); PG8_MMA(0, 1, At, B1); PG8_BAR; PG8_SCHED;
            PG8_LDA(At, 0, 1); PG8_STAGE(PG8_SB(0, 0), b2, voffB); PG8_STAGE(PG8_SB(0, 1), b2 + hstepB, voffB); PG8_STAGE(PG8_SA(0, 0), a2, voffA);
            PG8_WAIT_V(8); PG8_WAIT_L(0); PG8_BAR; PG8_MMA(1, 0, At, B0); PG8_MMA(1, 1, At, B1); PG8_BAR; PG8_SCHED;
            PG8_LDB(B0, 1, 0); PG8_LDB(B1, 1, 1); PG8_SCHED; PG8_LDA(At, 1, 0); PG8_STAGE(PG8_SA(0, 1), a2 + hstepA, voffA);
            PG8_WAIT_V(8); PG8_WAIT_L(0); PG8_BAR; PG8_MMA(0, 0, At, B0); PG8_MMA(0, 1, At, B1); PG8_BAR; PG8_SCHED;
            PG8_LDA(At, 1, 1); PG8_STAGE(PG8_SB(1, 0), b3, voffB); PG8_STAGE(PG8_SB(1, 1), b3 + hstepB, voffB); PG8_STAGE(PG8_SA(1, 0), a3, voffA);
            PG8_WAIT_V(8); PG8_WAIT_L(0); PG8_BAR; PG8_MMA(1, 0, At, B0); PG8_MMA(1, 1, At, B1); PG8_BAR; PG8_SCHED;
        }
        if (wr == 0) PG8_BAR;
        { int le_ = lane; asm volatile("" : "+v"(le_));
          E(acc, cur, wr, wc, le_ & 15, le_ >> 4, lds, (wid << 6) | le_); }
        if (!has_next) break;
#pragma unroll
        for (int a = 0; a < 2; ++a)
#pragma unroll
            for (int b = 0; b < 2; ++b)
#pragma unroll
                for (int m = 0; m < 4; ++m)
#pragma unroll
                    for (int n = 0; n < 2; ++n) acc[a][b][m][n] = (f32x4){0.f, 0.f, 0.f, 0.f};
        cur = nxt; cA = nA; cB = nB; ++ui;
        if (wr == 1) PG8_BAR;
    }
    PG8_WAIT_V(0);
    PG8_BAR;
#undef PG8_SA
#undef PG8_SB
#undef PG8_STAGE
#undef PG8_LDA
#undef PG8_LDB
#undef PG8_MMA
#undef PG8_WAIT_V
#undef PG8_WAIT_L
#undef PG8_BAR
#undef PG8_SCHED
}
}
namespace att {
typedef unsigned short bf16;
typedef short bf16x8 __attribute__((ext_vector_type(8)));
typedef short s16x4 __attribute__((ext_vector_type(4)));
typedef float f32x16 __attribute__((ext_vector_type(16)));
typedef float f32x4 __attribute__((ext_vector_type(4)));
typedef unsigned u32x4 __attribute__((ext_vector_type(4)));
constexpr int D = 128, SEQ = 2048, OS = 2048;
constexpr float SCALE = 0.08838834764831845f, THR = 8.f;
constexpr int NW = 8, QBLK = 32, KVBLK = 64, QB = NW * QBLK;
constexpr int SHM_V = KVBLK * D * 2, SHM_K = KVBLK * D * 2;
constexpr int LDS_WS = 2 * SHM_V + 2 * SHM_K;
constexpr int LDS_BIAS = LDS_WS + NW * 64 * 4;
constexpr int LDS_NEG = LDS_BIAS + SEQ * 4;
constexpr int LDS_BYTES = LDS_NEG + 256;

#define KSWZ(row, colB) ((row) * 256 + ((colB) ^ (((row) & 7) << 4)))
#define SBAR() __builtin_amdgcn_sched_barrier(0)
__device__ __forceinline__ int v_st(int k, int c) { const int kk = (k & ~0xC) | ((k & 4) << 1) | ((k & 8) >> 1); return ((kk >> 3) * 4 + (c >> 5)) * 512 + ((kk & 7) * 32 + (c & 31)) * 2; }
__device__ __forceinline__ int v_rd_base(int lane) { return ((lane & 3) << 3) | (((lane >> 2) & 3) << 6) | (((lane >> 4) & 1) << 5) | (((lane >> 5) & 1) << 8); }
constexpr int v_rd_off(int d0, int ks, int half) { return d0 * 512 + ks * 4096 + half * 2048; }
__device__ __forceinline__ int crow(int r, int hi) { return (r & 3) + 8 * (r >> 2) + 4 * hi; }
__device__ __forceinline__ unsigned cvtpk(float lo, float hi) { unsigned r; asm volatile("v_cvt_pk_bf16_f32 %0, %1, %2" : "=v"(r) : "v"(lo), "v"(hi)); return r; }
__device__ __forceinline__ bf16x8 load8(const bf16* p) { return *reinterpret_cast<const bf16x8*>(p); }
__device__ __forceinline__ void mask_tile(f32x16& p0, f32x16& p1, int dq) {
    const float NEG = -__builtin_inff();
#pragma unroll
    for (int r = 0; r < 16; ++r) {
        const int c = (r & 3) + 8 * (r >> 2);
        if (dq - c < 0) p0[r] = NEG;
        if (dq - c - 32 < 0) p1[r] = NEG;
    }
}
__device__ __forceinline__ void partialSM(f32x16& p0, f32x16& p1, float& m_reg, float& mn, float& alpha) {
    float pmax = p0[0]; for (int r = 1; r < 16; ++r) pmax = fmaxf(pmax, p0[r]); for (int r = 0; r < 16; ++r) pmax = fmaxf(pmax, p1[r]);
    { auto rr = __builtin_amdgcn_permlane32_swap(__float_as_uint(pmax), __float_as_uint(pmax), false, false);
      pmax = fmaxf(__uint_as_float(rr[0]), __uint_as_float(rr[1])); }
    constexpr float C2 = 1.4426950408889634f * SCALE;
    if (__builtin_expect(__all((pmax - m_reg) * SCALE <= THR), 1)) { mn = m_reg; alpha = 1.f; }
    else { mn = fmaxf(m_reg, pmax); alpha = __builtin_amdgcn_exp2f((m_reg - mn) * C2); m_reg = mn; }
    const float mnL = -mn * C2;
    for (int r = 0; r < 16; ++r) p0[r] = fmaf(p0[r], C2, mnL); for (int r = 0; r < 16; ++r) p1[r] = fmaf(p1[r], C2, mnL);
    for (int r = 0; r < 16; ++r) p0[r] = __builtin_amdgcn_exp2f(p0[r]);
}
__device__ __forceinline__ void finishSM(f32x16& p0, f32x16& p1, float alpha, float& l_reg, bf16x8& pa0, bf16x8& pa1, bf16x8& pa2, bf16x8& pa3) {
    for (int r = 0; r < 16; ++r) p1[r] = __builtin_amdgcn_exp2f(p1[r]);
    float ps = 0; for (int r = 0; r < 16; ++r) ps += p0[r]; for (int r = 0; r < 16; ++r) ps += p1[r];
    { auto rr = __builtin_amdgcn_permlane32_swap(__float_as_uint(ps), __float_as_uint(ps), false, false);
      ps = __uint_as_float(rr[0]) + __uint_as_float(rr[1]); }
    l_reg = l_reg * alpha + ps;
#define PK4(P, B_, OUT) do { unsigned a0 = cvtpk(P[B_+0], P[B_+1]), a1 = cvtpk(P[B_+2], P[B_+3]);                          \
        unsigned b0 = cvtpk(P[B_+4], P[B_+5]), b1 = cvtpk(P[B_+6], P[B_+7]);                                             \
        auto r0 = __builtin_amdgcn_permlane32_swap(a0, b0, false, false); auto r1 = __builtin_amdgcn_permlane32_swap(a1, b1, false, false); \
        u32x4 w = {r0[0], r1[0], r0[1], r1[1]}; OUT = *reinterpret_cast<bf16x8*>(&w); } while (0)
    PK4(p0, 0, pa0); PK4(p0, 8, pa1); PK4(p1, 0, pa2); PK4(p1, 8, pa3);
#undef PK4
}
template <int KB>
__device__ __forceinline__ void qkt(f32x16& p0, f32x16& p1, const char* K_lds, int r32, int hi, const bf16x8* qr, const __attribute__((address_space(3))) char* bp) {
    { unsigned bpa = (unsigned)(uintptr_t)bp; asm volatile("" : "+v"(bpa));
      const __attribute__((address_space(3))) f32x4* b4 = (const __attribute__((address_space(3))) f32x4*)(uintptr_t)bpa;
      const f32x4 x0 = b4[0], x1 = b4[2], x2 = b4[4], x3 = b4[6], y0 = b4[8], y1 = b4[10], y2 = b4[12], y3 = b4[14];
      p0 = (f32x16){x0[0], x0[1], x0[2], x0[3], x1[0], x1[1], x1[2], x1[3], x2[0], x2[1], x2[2], x2[3], x3[0], x3[1], x3[2], x3[3]};
      p1 = (f32x16){y0[0], y0[1], y0[2], y0[3], y1[0], y1[1], y1[2], y1[3], y2[0], y2[1], y2[2], y2[3], y3[0], y3[1], y3[2], y3[3]}; }
    const char* kb[4];
#pragma unroll
    for (int dd = 0; dd < 4; ++dd) kb[dd] = K_lds + KB * SHM_K + KSWZ(r32, (dd * 16 + hi * 8) * 2);
#pragma unroll
    for (int d0 = 0; d0 < 8; ++d0) { const char* a = kb[d0 & 3] + (d0 >> 2) * 128;
        bf16x8 b0 = *reinterpret_cast<const bf16x8*>(a);
        bf16x8 b1 = *reinterpret_cast<const bf16x8*>(a + 32 * 256);
        p0 = __builtin_amdgcn_mfma_f32_32x32x16_bf16(b0, qr[d0], p0, 0, 0, 0);
        p1 = __builtin_amdgcn_mfma_f32_32x32x16_bf16(b1, qr[d0], p1, 0, 0, 0); }
}
template <int VB>
__device__ __forceinline__ void pv_tile(f32x16* o, int vb0, bf16x8 pa0, bf16x8 pa1, bf16x8 pa2, bf16x8 pa3) {
#define TRRD(dst, off) asm volatile("ds_read_b64_tr_b16 %0, %1 offset:%2" : "=&v"(dst) : "v"(vb0), "i"(off) : "memory")
#define PV_D0(d0) do { s16x4 l0, l1, l2, l3, h0, h1, h2, h3; constexpr int b_ = VB * SHM_V + v_rd_off(d0, 0, 0); \
        TRRD(l0, b_); TRRD(h0, b_ + 2048); TRRD(l1, b_ + 4096); TRRD(h1, b_ + 6144); TRRD(l2, b_ + 8192); TRRD(h2, b_ + 10240); TRRD(l3, b_ + 12288); TRRD(h3, b_ + 14336); \
        asm volatile("s_waitcnt lgkmcnt(0)" ::: "memory"); SBAR();   \
        o[d0] = __builtin_amdgcn_mfma_f32_32x32x16_bf16(pa0, (bf16x8){l0[0], l0[1], l0[2], l0[3], h0[0], h0[1], h0[2], h0[3]}, o[d0], 0, 0, 0);   \
        o[d0] = __builtin_amdgcn_mfma_f32_32x32x16_bf16(pa1, (bf16x8){l1[0], l1[1], l1[2], l1[3], h1[0], h1[1], h1[2], h1[3]}, o[d0], 0, 0, 0);   \
        o[d0] = __builtin_amdgcn_mfma_f32_32x32x16_bf16(pa2, (bf16x8){l2[0], l2[1], l2[2], l2[3], h2[0], h2[1], h2[2], h2[3]}, o[d0], 0, 0, 0);   \
        o[d0] = __builtin_amdgcn_mfma_f32_32x32x16_bf16(pa3, (bf16x8){l3[0], l3[1], l3[2], l3[3], h3[0], h3[1], h3[2], h3[3]}, o[d0], 0, 0, 0); } while (0)
    PV_D0(0); PV_D0(1); PV_D0(2); PV_D0(3);
#undef PV_D0
#undef TRRD
}

struct BlockRef { const bf16* Q; const bf16* K; const bf16* V; bf16* O; int P0; int bh; };
struct Seam { bf16x8 qr[8]; bf16x8 st_v0, st_v1, st_k0, st_k1; };
#define ROW(p, k0, rr) ((const bf16*)((const char*)((p) + (size_t)(k0) * D) + (unsigned)(((rr) * D + sc) * 2)))
#define VMW() asm volatile("s_waitcnt vmcnt(0)" ::: "memory")
#define VMWN(n) asm volatile("s_waitcnt vmcnt(%0)" :: "i"(n) : "memory")
#define SLOAD_H(Kp, Vp, k0) do { S.st_v0 = load8(ROW(Vp, k0, sr)); S.st_v1 = load8(ROW(Vp, k0, 32 + sr));              \
                         S.st_k0 = load8(ROW(Kp, k0, sr)); S.st_k1 = load8(ROW(Kp, k0, 32 + sr)); } while (0)
#define SWRITE_HK(bf) do { *(bf16x8*)(K_lds + (bf) * SHM_K + kws) = S.st_k0; *(bf16x8*)(K_lds + (bf) * SHM_K + kws + 32 * 256) = S.st_k1; } while (0)
#define SWRITE_HV(bf) do { *(bf16x8*)(V_lds + (bf) * SHM_V + vst0) = S.st_v0; *(bf16x8*)(V_lds + (bf) * SHM_V + vst1) = S.st_v1; } while (0)
#define SWRITE_H(bf) do { SWRITE_HV(bf); SWRITE_HK(bf); } while (0)
__device__ __forceinline__ void attn_prime(const BlockRef& cur, char* lds, Seam& S, const int wave) {
    int tid_raw_ = MK_TID(); asm volatile("" : "+v"(tid_raw_)); const int tid = tid_raw_, wid = __builtin_amdgcn_readfirstlane(tid >> 6), lane = tid & 63, r32 = lane & 31, hi = lane >> 5;
    const int sr = tid >> 4, sc = (tid & 15) * 8, kws = KSWZ(sr, sc * 2); char* K_lds = lds + 2 * SHM_V;
    for (int d0 = 0; d0 < 8; ++d0) S.qr[d0] = load8((const bf16*)((const char*)(cur.Q + (size_t)(wid * QBLK) * D) + (unsigned)((r32 * D + hi * 8) * 2)) + d0 * 16);
    SLOAD_H(cur.K, cur.V, 0); VMW(); SWRITE_HK(0);
    __syncthreads();
}
template <bool MOBA>
__device__ __forceinline__ void attn_block(const BlockRef& cur, const BlockRef& nxt, char* lds, Seam& S, const float* __restrict__ biasG  , const unsigned* __restrict__ selG  , const int wave) {
    int tid_raw_ = MK_TID(); asm volatile("" : "+v"(tid_raw_)); const int tid = tid_raw_, wid = __builtin_amdgcn_readfirstlane(tid >> 6), lane = tid & 63, r32 = lane & 31, hi = lane >> 5;
    const int NT = (cur.P0 + QB) / KVBLK;
    const int qlo = cur.P0 + wid * QBLK, qm = qlo + r32 - 4 * hi;
    char* V_lds = lds; char* K_lds = lds + 2 * SHM_V;
    float* ws = (float*)(lds + LDS_WS) + wid * 64; float* li_l = ws, * al_l = ws + 32;
    float* biasL = (float*)(lds + LDS_BIAS); float* negL = (float*)(lds + LDS_NEG);
    unsigned selmask = 0u; const int own = cur.P0 >> 8;
    { int te = tid; asm volatile("" : "+v"(te));
      if (te < 64) negL[te] = -__builtin_inff();
      *(f32x4*)(biasL + 4 * te) = *(const f32x4*)(biasG + (size_t)cur.bh * SEQ + 4 * te);
      if (MOBA) selmask = selG[(size_t)cur.bh * SEQ + cur.P0 + (te >> 6) * QBLK + (te & 31)]; }
    __syncthreads();
    typedef const __attribute__((address_space(3))) char* lcp; const lcp bias_b = (lcp)((const char*)biasL) + 16 * hi; const lcp neg_b = (lcp)((const char*)negL) + 16 * hi;
    float m_reg = -1e30f, l_reg = 0; f32x16 o[4] = {};
    const int sr = tid >> 4, sc = (tid & 15) * 8, vst0 = v_st(sr, sc), vst1 = v_st(32 + sr, sc), kws = KSWZ(sr, sc * 2);
    const int vb0 = (int)(uintptr_t)V_lds + v_rd_base(lane);
    const bf16* Kh = cur.K; const bf16* Vh = cur.V;
#define RESC(a) do { if (__any((a) < 1.f)) { if (hi == 0) al_l[r32] = (a); asm volatile("s_waitcnt lgkmcnt(0)" ::: "memory");              \
                     for (int d_ = 0; d_ < 4; ++d_) for (int r = 0; r < 16; ++r) o[d_][r] *= al_l[crow(r, hi)]; } } while (0)
#define KBASE(t) ((t) * KVBLK)
#define BP(t) ((!MOBA || (KBASE(t) >> 8) >= own || ((selmask >> (KBASE(t) >> 8)) & 1u)) ? (bias_b + KBASE(t) * 4) : neg_b)
#define MASKT(P0_, P1_, t) do { const int kb_ = KBASE(t); if (kb_ + KVBLK - 1 > qlo) mask_tile(P0_, P1_, qm - kb_); } while (0)
#define SEAM_K0() do { VMWN(8); SWRITE_HK(0); SBAR(); } while (0)
    f32x16 pA0, pA1, pB0, pB1; float mnA, mnB, alA, alB; bf16x8 pa0, pa1, pa2, pa3;
    SWRITE_HV(0); SBAR();
    SLOAD_H(Kh, Vh, KBASE(1));
    SBAR(); qkt<0>(pA0, pA1, K_lds, r32, hi, S.qr, BP(0));
    MASKT(pA0, pA1, 0); partialSM(pA0, pA1, m_reg, mnA, alA);
    VMW(); SWRITE_H(1);
    __syncthreads();
#define HALF_STEP(PX0, PX1, mnX, alX, PY0, PY1, alY, t, KB, VB, SB) do {                                                      \
        SBAR(); qkt<KB>(PX0, PX1, K_lds, r32, hi, S.qr, BP(t));                                                               \
        finishSM(PY0, PY1, alY, l_reg, pa0, pa1, pa2, pa3); SBAR();                                                           \
        if ((t) + 1 < NT) { SLOAD_H(Kh, Vh, KBASE((t) + 1)); SBAR(); }                                                        \
        pv_tile<VB>(o, vb0, pa0, pa1, pa2, pa3); MASKT(PX0, PX1, (t)); partialSM(PX0, PX1, m_reg, mnX, alX);                  \
        __syncthreads();                                                                                                      \
        if ((t) + 1 < NT) { VMW(); SWRITE_H(SB); }                                                                            \
        RESC(alX); __syncthreads(); } while (0)
    for (int t = 1; t + 1 < NT; t += 2) {
        HALF_STEP(pB0, pB1, mnB, alB, pA0, pA1, alA, t, 1, 0, 0);
        HALF_STEP(pA0, pA1, mnA, alA, pB0, pB1, alB, t + 1, 0, 1, 1);
    }
    { SBAR(); qkt<1>(pB0, pB1, K_lds, r32, hi, S.qr, BP(NT - 1)); SBAR(); }
    SLOAD_H(nxt.K, nxt.V, 0); SBAR();
    { int lq = lane; asm volatile("" : "+v"(lq));
#pragma unroll
    for (int d0 = 0; d0 < 8; ++d0) S.qr[d0] = load8((const bf16*)((const char*)(nxt.Q + (size_t)(wid * QBLK) * D) + (unsigned)(((lq & 31) * D + (lq >> 5) * 8) * 2)) + d0 * 16); }
    SBAR();
    finishSM(pA0, pA1, alA, l_reg, pa0, pa1, pa2, pa3); SBAR();
    pv_tile<0>(o, vb0, pa0, pa1, pa2, pa3);
    { MASKT(pB0, pB1, NT - 1); partialSM(pB0, pB1, m_reg, mnB, alB); __syncthreads(); RESC(alB);
      finishSM(pB0, pB1, alB, l_reg, pa0, pa1, pa2, pa3); SBAR(); pv_tile<1>(o, vb0, pa0, pa1, pa2, pa3); }
    SBAR(); SEAM_K0();
    { int le = lane; asm volatile("" : "+v"(le)); const int r32e = le & 31, hie = le >> 5;
    if (hie == 0) li_l[r32e] = l_reg; asm volatile("s_waitcnt lgkmcnt(0)" ::: "memory");
    float rli[16];
#pragma unroll
    for (int r = 0; r < 16; ++r) rli[r] = __builtin_amdgcn_rcpf(li_l[crow(r, hie)]);
    bf16* Ow = cur.O + (size_t)(wid * QBLK) * OS;
#pragma unroll
    for (int r = 0; r < 16; ++r) { const int orow = crow(r, hie);
#pragma unroll
        for (int d0 = 0; d0 < 4; ++d0) { const float v = o[d0][r] * rli[r];
            const float vn = __uint_as_float(__builtin_amdgcn_mov_dpp(__float_as_uint(v), 0xB1, 0xF, 0xF, true));
            if ((r32e & 1) == 0) *(unsigned*)(Ow + (size_t)orow * OS + d0 * 32 + r32e) = cvtpk(v, vn); } } }
    __syncthreads();
#undef RESC
#undef KBASE
#undef BP
#undef MASKT
#undef SEAM_K0
#undef HALF_STEP
}
#undef ROW
#undef VMW
#undef VMWN
#undef SLOAD_H
#undef SWRITE_HK
#undef SWRITE_HV
#undef SWRITE_H

template <bool MOBA>
__device__ __forceinline__ void attn_phase(char* lds, const bf16* Q, const bf16* K, const bf16* V, bf16* O, const float* biasG, const unsigned* selG, const int wave) {
    const int G = gridDim.x; int idx = blockIdx.x; if (idx >= 256) return;
    auto ref = [&](int id, int pass) { const int xcd = id & 7, k = id >> 3, bh = xcd * 8 + (k >> 2), y = k & 3, qb = pass ? 7 - y : y, b = bh >> 4, h = bh & 15;
        BlockRef r; r.Q = Q + ((size_t)bh * SEQ + (size_t)qb * QB) * D; r.K = K + (size_t)bh * SEQ * D; r.V = V + (size_t)bh * SEQ * D;
        r.O = O + ((size_t)b * SEQ + (size_t)qb * QB) * OS + h * D; r.P0 = qb * QB; r.bh = bh; return r; };
    int pass = 0; BlockRef cur = ref(idx, 0);
    Seam S;
    attn_prime(cur, lds, S, wave);
    for (;;) {
        const bool more_pass = pass == 0, more_item = idx + G < 256, last = !more_pass && !more_item;
        int idn = idx, passn = pass + 1; if (!more_pass) { passn = 0; idn = more_item ? idx + G : idx; }
        const BlockRef nxt = last ? cur : ref(idn, passn);
        attn_block<MOBA>(cur, nxt, lds, S, biasG, selG, wave);
        if (last) break;
        cur = nxt; idx = idn; pass = passn;
    }
}
}
constexpr int NWAVES = 8;
constexpr int BATCH = 4, SEQ = 2048, DM = 2048, M = BATCH * SEQ, FF = 5632, NH = 16, HD = 128, PLE = 256, DEPTH = 4;
constexpr size_t MiB = 1u << 20;
constexpr size_t WS_CTL = 0, CTL_ZERO_BYTES = 1 * MiB;
constexpr size_t WS_WFI = 1 * MiB;
constexpr size_t WS_WFO = WS_WFI + 352 * MiB;
constexpr size_t WS_WPG = WS_WFO + 176 * MiB;
constexpr size_t WS_WPP = WS_WPG + 32 * MiB;
constexpr size_t WS_WQKV = WS_WPP + 4 * MiB;
constexpr size_t WS_WO = WS_WQKV + 72 * MiB;
constexpr size_t WS_WS5I = WS_WO + 24 * MiB;
constexpr size_t WS_WGLU = WS_WS5I + 8 * MiB;
constexpr size_t WS_S5TV = WS_WGLU + 16 * MiB;
constexpr size_t WS_S5W = WS_S5TV + 80 * MiB;
constexpr size_t WS_WFT = WS_S5W + 32 * MiB;
constexpr size_t WS_H = WS_WFT + 1 * MiB;
constexpr size_t WS_HB = WS_H + 64 * MiB;
constexpr size_t WS_ACT = WS_HB + 32 * MiB;
constexpr size_t WS_QKV = WS_ACT + 88 * MiB;
constexpr size_t WS_OB = WS_QKV + 96 * MiB;
constexpr size_t WS_SSQ = WS_OB + 32 * MiB;
constexpr size_t WS_PP = WS_SSQ + 1 * MiB;
constexpr size_t WS_PBF = WS_PP + 128 * MiB;
constexpr size_t WS_LOGF = WS_PBF + 16 * MiB;
constexpr size_t WS_KMEAN = WS_LOGF + 1 * MiB;
constexpr size_t WS_UH = WS_KMEAN + 1 * MiB;
constexpr size_t WS_HLOC = WS_UH + 40 * MiB;
constexpr size_t WS_YB = WS_HLOC + 16 * MiB;
constexpr size_t WS_HB2 = WS_YB + 32 * MiB;
constexpr size_t WS_H2 = WS_HB2 + 32 * MiB;
constexpr size_t WS_BIAS = WS_H2 + 64 * MiB;
constexpr size_t WS_SEL = WS_BIAS + 1 * MiB;
constexpr size_t WS_END = WS_SEL + 1 * MiB;
constexpr int CW_BAR = 4096;
constexpr int RING_OFF = 0, RING_BYTES = 131072, EPI_OFF = 131072, LDSCTL_OFF = 139264, MISC_OFF = LDSCTL_OFF + 320, LDS_BYTES = 147456;
static_assert(att::LDS_BYTES <= RING_BYTES && pg8::EPI_LDS_OFF == EPI_OFF, "LDS map");

#define GAS __attribute__((address_space(1)))
#define LAS __attribute__((address_space(3)))
typedef unsigned short bf16;
typedef unsigned v4u __attribute__((ext_vector_type(4)));
typedef unsigned v2u __attribute__((ext_vector_type(2)));
typedef float f32x4 __attribute__((ext_vector_type(4)));
typedef float f32x2 __attribute__((ext_vector_type(2)));
typedef GAS unsigned gu32;
#define RLX_AGENT __ATOMIC_RELAXED, __HIP_MEMORY_SCOPE_AGENT
#define LDS_WAIT() asm volatile("s_waitcnt lgkmcnt(0)" ::: "memory")
#define VM_WAIT() asm volatile("s_waitcnt vmcnt(0)" ::: "memory")
__device__ __forceinline__ unsigned f2bf(float f) { unsigned u = __builtin_bit_cast(unsigned, f); return (u + 0x7fffu + ((u >> 16) & 1u)) >> 16; }
__device__ __forceinline__ unsigned pk2(float lo, float hi) { return f2bf(lo) | (f2bf(hi) << 16); }
__device__ __forceinline__ float wave_sum(float v) {
#pragma unroll
    for (int o = 1; o < 64; o <<= 1) v += __shfl_xor(v, o);
    return v;
}

#define XB_TMO      128
#define XB_XCNT(j)  (256  + 64 * (j))
#define XB_XSUB(j)  (1280 + 64 * (j))
#define XB_XGEN(j)  (2304 + 64 * (j))
#define XB_TOP      3328
#define XB_TOPGEN   3392
#define XCD_BAR_WORDS 3456
#define XB_SPIN_CAP (1u << 18)

__device__ __forceinline__ unsigned xb_ld(unsigned* p)              { return __hip_atomic_load(p, __ATOMIC_RELAXED, __HIP_MEMORY_SCOPE_AGENT); }
__device__ __forceinline__ unsigned xb_add(unsigned* p, unsigned v) { return __hip_atomic_fetch_add(p, v, __ATOMIC_RELAXED, __HIP_MEMORY_SCOPE_AGENT); }
__device__ __forceinline__ unsigned xb_xcc_id() { return (unsigned)__builtin_amdgcn_s_getreg((3 << 11) | 20) & 0xFu; }
#define XB_SPIN(cond, bar) do { unsigned _sp = 0; while (cond) { __builtin_amdgcn_s_sleep(1); \
    if ((++_sp & 255u) == 0u) { if (xb_ld(&(bar)[XB_TMO])) break; if (_sp > XB_SPIN_CAP) { atomicAdd(&(bar)[XB_TMO], 1u); break; } } } } while (0)

struct XcdBarrier {
    unsigned* bar; unsigned x;
    volatile LAS unsigned* st;
};

__device__ __forceinline__ XcdBarrier xcd_barrier_post(unsigned* bar, volatile LAS unsigned* st, int wave) {
    XcdBarrier b; b.bar = bar; b.x = xb_xcc_id(); b.st = st;
    if (XB_TID == 0) (void)xb_add(&bar[XB_XCNT(b.x)], 1u);
    return b;
}
__device__ __forceinline__ void xcd_barrier_complete(unsigned* bar, unsigned x, unsigned& nloc, unsigned& nx) {
    const unsigned G = gridDim.x * gridDim.y * gridDim.z;
    unsigned sum, cnt, mine, sp = 0u;
    for (;;) {
        sum = 0u; cnt = 0u; mine = 0u;
#pragma unroll
        for (unsigned j = 0; j < 16; ++j) { const unsigned c = xb_ld(&bar[XB_XCNT(j)]); sum += c; cnt += (c > 0u) ? 1u : 0u; mine = (j == x) ? c : mine; }
        if (sum == G) break;
        __builtin_amdgcn_s_sleep(1);
        if ((++sp & 255u) == 0u) { if (xb_ld(&bar[XB_TMO])) break; if (sp > XB_SPIN_CAP) { atomicAdd(&bar[XB_TMO], 1u); break; } }
    }
    nloc = mine > 0u ? mine : 1u; nx = cnt > 0u ? cnt : 1u;
}

__device__ __forceinline__ void xcd_barrier(const XcdBarrier& b, int wave) {
    asm volatile("s_waitcnt vmcnt(0)" ::: "memory");
    __syncthreads();
    if (XB_TID == 0) {
        unsigned* bar = b.bar;
        __builtin_amdgcn_s_waitcnt(0);
        unsigned nloc = b.st[0], nx = b.st[1];
        if (nloc == 0u) { xcd_barrier_complete(bar, b.x, nloc, nx); b.st[0] = nloc; b.st[1] = nx; }
        const unsigned old = xb_add(&bar[XB_XSUB(b.x)], 1u);
        const unsigned gen = old / nloc;
        if (old + 1u == (gen + 1u) * nloc) {
            __builtin_amdgcn_fence(__ATOMIC_RELEASE, "agent");
            asm volatile("s_waitcnt vmcnt(0)" ::: "memory");
            const unsigned og = xb_add(&bar[XB_TOP], 1u);
            const unsigned tg = og / nx;
            if (og + 1u == (tg + 1u) * nx) xb_add(&bar[XB_TOPGEN], 1u);
            else XB_SPIN(xb_ld(&bar[XB_TOPGEN]) == tg, bar);
            __builtin_amdgcn_fence(__ATOMIC_ACQUIRE, "agent");
            xb_add(&bar[XB_XGEN(b.x)], 1u);
            asm volatile("s_waitcnt vmcnt(0)" ::: "memory");
        } else {
            XB_SPIN(xb_ld(&bar[XB_XGEN(b.x)]) == gen, bar);
            __builtin_amdgcn_fence(__ATOMIC_ACQUIRE, "agent");
            asm volatile("s_waitcnt vmcnt(0)" ::: "memory");
        }
    }
    __syncthreads();
}

struct Args { const float* in[23]; float* out; unsigned char* ws; int ph_lo, ph_hi; };

__device__ __forceinline__ void tr_item(const float* __restrict__ src, int ld, int K, bf16* __restrict__ dst, const float* __restrict__ scale, int n0, int k0, int drow0, LAS float* scr, int lane) {
    const int kr = lane >> 4, n4 = lane & 15;
    f32x4 v[16];
#pragma unroll
    for (int i = 0; i < 16; ++i) v[i] = *(const f32x4*)(src + (size_t)(k0 + 4 * i + kr) * ld + n0 + 4 * n4);
#pragma unroll
    for (int i = 0; i < 16; ++i) { LAS float* p = scr + (4 * i + kr) * 65 + 4 * n4; p[0] = v[i][0]; p[1] = v[i][1]; p[2] = v[i][2]; p[3] = v[i][3]; }
    LDS_WAIT(); asm volatile("" ::: "memory");
    const int c = lane & 7, nn = lane >> 3;
    f32x4 s0 = (f32x4){1.f, 1.f, 1.f, 1.f}, s1 = s0;
    if (scale) { s0 = *(const f32x4*)(scale + k0 + 8 * c); s1 = *(const f32x4*)(scale + k0 + 8 * c + 4); }
#pragma unroll
    for (int j = 0; j < 8; ++j) { const int n = nn + 8 * j; const LAS float* s = scr + (8 * c) * 65 + n;
        v4u o; o.x = pk2(s[0 * 65] * s0[0], s[1 * 65] * s0[1]); o.y = pk2(s[2 * 65] * s0[2], s[3 * 65] * s0[3]); o.z = pk2(s[4 * 65] * s1[0], s[5 * 65] * s1[1]); o.w = pk2(s[6 * 65] * s1[2], s[7 * 65] * s1[3]);
        *(v4u*)(dst + (size_t)(drow0 + n) * K + k0 + 8 * c) = o; }
    LDS_WAIT(); asm volatile("" ::: "memory");
}
__device__ __forceinline__ void tr_job(const float* src, int ld, int K, int N, bf16* dst, const float* scale, int ilv, int r, LAS float* scr, int lane) {
    const int nb = N / 64, kb = r / nb, nbi = r % nb, n0 = nbi * 64;
    int drow0 = n0;
    if (ilv) { const int hsel = n0 >= ilv ? 1 : 0, nn = n0 - hsel * ilv; drow0 = (nn >> 7) * 256 + hsel * 128 + (nn & 127); }
    tr_item(src, ld, K, dst, scale, n0, kb * 64, drow0, scr, lane);
}

__device__ __forceinline__ void s5_ops_group(const Args& a, int g, LAS float* L, int tid) {
    const float* a_re = a.in[14]; const float* a_im = a.in[15]; const float* log_dt = a.in[16]; const float* b_re = a.in[17]; const float* b_im = a.in[18];
    const float* c_re = a.in[19]; const float* c_im = a.in[20]; const float* dsk = a.in[21];
    LAS float* apr = L; LAS float* api = L + 2112; LAS float* qr = L + 4224; LAS float* qi = qr + 64; LAS float* Cr = qi + 64; LAS float* Ci = Cr + 1024;
    LAS float* Br = Ci + 1024; LAS float* Bi = Br + 1024; LAS float* Kt = Bi + 1024;
    bf16* TV = (bf16*)(a.ws + WS_S5TV) + (size_t)g * 512 * 640; bf16* W = (bf16*)(a.ws + WS_S5W) + (size_t)g * 256 * 512;
    const float dt = expf(log_dt[g]);
    for (int idx = tid; idx < 33 * 64; idx += 512) { const int tau = idx >> 6, p = idx & 63; const float ar = a_re[g * 64 + p], ai = a_im[g * 64 + p];
        const float mag = expf(ar * dt * (float)tau); float sn, cs; sincosf(ai * dt * (float)tau, &sn, &cs); apr[idx] = mag * cs; api[idx] = mag * sn; }
    if (tid < 64) { const float ar = a_re[g * 64 + tid], ai = a_im[g * 64 + tid]; const float er = expf(ar * dt); float sn, cs; sincosf(ai * dt, &sn, &cs);
        const float nr = er * cs - 1.f, ni = er * sn, den = ar * ar + ai * ai; qr[tid] = (nr * ar + ni * ai) / den; qi[tid] = (ni * ar - nr * ai) / den; }
    for (int idx = tid; idx < 1024; idx += 512) { Cr[idx] = c_re[(size_t)g * 1024 + idx]; Ci[idx] = c_im[(size_t)g * 1024 + idx]; }
    __syncthreads();
    for (int idx = tid; idx < 1024; idx += 512) { const int p = idx >> 4; const float br = b_re[(size_t)g * 1024 + idx], bi = b_im[(size_t)g * 1024 + idx];
        Br[idx] = qr[p] * br - qi[p] * bi; Bi[idx] = qr[p] * bi + qi[p] * br; }
    __syncthreads();
    for (int idx = tid; idx < 32 * 256; idx += 512) { const int tau = idx >> 8, c = (idx >> 4) & 15, cp = idx & 15; float s = 0.f;
        for (int p = 0; p < 64; ++p) { const float ar_ = apr[tau * 64 + p], ai_ = api[tau * 64 + p], br = Br[p * 16 + cp], bi = Bi[p * 16 + cp];
            const float xr = ar_ * br - ai_ * bi, xi = ar_ * bi + ai_ * br; s += Cr[c * 64 + p] * xr - Ci[c * 64 + p] * xi; }
        if (tau == 0 && c == cp) s += dsk[g * 16 + c];
        Kt[idx] = s; }
    __syncthreads();
    for (int idx = tid; idx < 512 * 80; idx += 512) { const int n = idx / 80, ch = idx % 80, j = n >> 4, c = n & 15; float o[8];
        if (ch < 64) { const int jp = ch >> 1, c0 = (ch & 1) * 8;
#pragma unroll
            for (int e = 0; e < 8; ++e) o[e] = (jp <= j) ? Kt[(j - jp) * 256 + c * 16 + c0 + e] : 0.f; }
        else { const int p0 = (ch - 64) * 4;
#pragma unroll
            for (int e = 0; e < 4; ++e) { const int p = p0 + e; const float ar_ = apr[(j + 1) * 64 + p], ai_ = api[(j + 1) * 64 + p], cr = Cr[c * 64 + p], ci = Ci[c * 64 + p];
                o[2 * e] = cr * ar_ - ci * ai_; o[2 * e + 1] = -(cr * ai_ + ci * ar_); } }
        v4u w; w.x = pk2(o[0], o[1]); w.y = pk2(o[2], o[3]); w.z = pk2(o[4], o[5]); w.w = pk2(o[6], o[7]);
        *(v4u*)(TV + (size_t)n * 640 + ch * 8) = w; }
    for (int idx = tid; idx < 128 * 64; idx += 512) { const int n = idx >> 6, ch = idx & 63, p = n >> 1, ri = n & 1, jp = ch >> 1, c0 = (ch & 1) * 8; float o[8];
        const float ar_ = apr[(31 - jp) * 64 + p], ai_ = api[(31 - jp) * 64 + p];
#pragma unroll
        for (int e = 0; e < 8; ++e) { const float br = Br[p * 16 + c0 + e], bi = Bi[p * 16 + c0 + e]; o[e] = ri ? (ar_ * bi + ai_ * br) : (ar_ * br - ai_ * bi); }
        v4u w; w.x = pk2(o[0], o[1]); w.y = pk2(o[2], o[3]); w.z = pk2(o[4], o[5]); w.w = pk2(o[6], o[7]);
        *(v4u*)(W + (size_t)n * 512 + ch * 8) = w; }
    __syncthreads();
}

__device__ __forceinline__ void p0_prologue(const Args& a, LAS unsigned char* lds, int tid, int lane, int wave, int vcu, int G) {
    const float* x = a.in[0]; const float* p = a.in[1]; const float* norm_g = a.in[2];
    unsigned char* ws = a.ws;
    for (int g = vcu; g < 128; g += G) s5_ops_group(a, g, (LAS float*)lds, tid);
    LAS float* scr = (LAS float*)(lds + wave * 16640);
    const int gw = vcu * NWAVES + wave, NGW = G * NWAVES;
    constexpr int I_FI = 32 * 176, I_FO = 88 * 32, I_PG = 32 * 32, I_PPJ = 4 * 32, I_QKV = 32 * 96, I_WO = 32 * 32, I_S5I = 32 * 32, I_GLU = 32 * 64;
    constexpr int N_TR = 8 * I_FI + 8 * I_FO + 4 * I_PG + 4 * I_PPJ + 3 * I_QKV + 3 * I_WO + I_S5I + I_GLU;
    constexpr int I_X = M, I_P = 4 * M * PLE / 512, I_WF = 32;
    constexpr int NITEMS = N_TR + I_X + I_P + I_WF;
    for (int it = gw; it < NITEMS; it += NGW) {
        int r = it;
        if (r < 8 * I_FI) { const int m = r / I_FI, layer = m >> 1, half = m & 1;
            tr_job(a.in[4] + (size_t)m * DM * 2 * FF, 2 * FF, DM, 2 * FF, (bf16*)(ws + WS_WFI) + (size_t)m * 2 * FF * DM, norm_g + (layer * 4 + half * 2) * DM, FF, r % I_FI, scr, lane); continue; } r -= 8 * I_FI;
        if (r < 8 * I_FO) { const int m = r / I_FO;
            tr_job(a.in[5] + (size_t)m * FF * DM, DM, FF, DM, (bf16*)(ws + WS_WFO) + (size_t)m * DM * FF, nullptr, 0, r % I_FO, scr, lane); continue; } r -= 8 * I_FO;
        if (r < 4 * I_PG) { const int m = r / I_PG;
            tr_job(a.in[6] + (size_t)m * DM * DM, DM, DM, DM, (bf16*)(ws + WS_WPG) + (size_t)m * DM * DM, norm_g + (m * 4 + 3) * DM, 0, r % I_PG, scr, lane); continue; } r -= 4 * I_PG;
        if (r < 4 * I_PPJ) { const int m = r / I_PPJ;
            tr_job(a.in[7] + (size_t)m * PLE * DM, DM, PLE, DM, (bf16*)(ws + WS_WPP) + (size_t)m * DM * PLE, nullptr, 0, r % I_PPJ, scr, lane); continue; } r -= 4 * I_PPJ;
        if (r < 3 * I_QKV) { const int m = r / I_QKV;
            const float* src = m == 1 ? a.in[11] : a.in[8] + (size_t)(m >> 1) * DM * (3 * DM + NH); const int ld = m == 1 ? 3 * DM : 3 * DM + NH; const int layer = m == 2 ? 3 : m;
            tr_job(src, ld, DM, 3 * DM, (bf16*)(ws + WS_WQKV) + (size_t)m * 3 * DM * DM, norm_g + (layer * 4 + 1) * DM, 0, r % I_QKV, scr, lane); continue; } r -= 3 * I_QKV;
        if (r < 3 * I_WO) { const int m = r / I_WO; const float* src = m == 1 ? a.in[12] : a.in[10] + (size_t)(m >> 1) * DM * DM;
            tr_job(src, DM, DM, DM, (bf16*)(ws + WS_WO) + (size_t)m * DM * DM, nullptr, 0, r % I_WO, scr, lane); continue; } r -= 3 * I_WO;
        if (r < I_S5I) { tr_job(a.in[13], DM, DM, DM, (bf16*)(ws + WS_WS5I), norm_g + (2 * 4 + 1) * DM, 0, r, scr, lane); continue; } r -= I_S5I;
        if (r < I_GLU) { tr_job(a.in[22], 2 * DM, DM, 2 * DM, (bf16*)(ws + WS_WGLU), nullptr, DM, r, scr, lane); continue; } r -= I_GLU;
        if (r < I_X) {
            const f32x4* xr = (const f32x4*)(x + (size_t)r * DM) + lane; f32x4 v[8]; float s = 0.f;
#pragma unroll
            for (int j = 0; j < 8; ++j) { v[j] = xr[64 * j]; s += (v[j][0] * v[j][0] + v[j][1] * v[j][1]) + (v[j][2] * v[j][2] + v[j][3] * v[j][3]); }
            s = wave_sum(s);
            v2u* o = (v2u*)((bf16*)(ws + WS_HB) + (size_t)r * DM) + lane;
#pragma unroll
            for (int j = 0; j < 8; ++j) { v2u w; w.x = pk2(v[j][0], v[j][1]); w.y = pk2(v[j][2], v[j][3]); o[64 * j] = w; }
            if (lane < 4) ((f32x4*)((float*)(ws + WS_SSQ) + (size_t)r * 16))[lane] = (f32x4){lane == 0 ? s : 0.f, 0.f, 0.f, 0.f};
            continue; } r -= I_X;
        if (r < I_P) {
            const f32x4* src = (const f32x4*)(p + (size_t)r * 512) + 2 * lane; const f32x4 v0 = src[0], v1 = src[1];
            v4u w; w.x = pk2(v0[0], v0[1]); w.y = pk2(v0[2], v0[3]); w.z = pk2(v1[0], v1[1]); w.w = pk2(v1[2], v1[3]);
            ((v4u*)((bf16*)(ws + WS_PBF) + (size_t)r * 512))[lane] = w; continue; } r -= I_P;
        {
            const int j = r >> 4, hd = r & 15, layer = j ? 3 : 0; const float* src = a.in[8] + (size_t)j * DM * (3 * DM + NH) + 3 * DM + hd; const float* g1 = norm_g + (layer * 4 + 1) * DM;
            float* dst = (float*)(ws + WS_WFT) + (size_t)(j * 16 + hd) * DM;
            for (int k = lane; k < DM; k += 64) dst[k] = g1[k] * src[(size_t)k * (3 * DM + NH)];
        }
    }
}

__device__ __forceinline__ void fox_gate_phase(const bf16* Hb, const float* WfT, const float* bfv, float* logf, int lane, int gw, int NGW) {
    for (int task = gw; task < M / 4; task += NGW) {
        const int r0 = task * 4;
        float xv[4][32]; float ss[4];
#pragma unroll
        for (int rr = 0; rr < 4; ++rr) { const v4u* xr = (const v4u*)(Hb + (size_t)(r0 + rr) * DM) + lane; float s = 0.f;
#pragma unroll
            for (int j = 0; j < 4; ++j) { const v4u w = xr[64 * j];
#pragma unroll
                for (int e = 0; e < 8; ++e) { const unsigned ww = w[e >> 1]; const float x = __uint_as_float((e & 1) ? (ww & 0xffff0000u) : (ww << 16)); xv[rr][j * 8 + e] = x; s = fmaf(x, x, s); } }
            ss[rr] = wave_sum(s); }
        float res[4] = {0.f, 0.f, 0.f, 0.f};
#pragma unroll 1
        for (int hd = 0; hd < 16; ++hd) { const f32x4* wr_ = (const f32x4*)(WfT + (size_t)hd * DM) + 2 * lane; float d[4] = {0.f, 0.f, 0.f, 0.f};
#pragma unroll
            for (int j = 0; j < 4; ++j) { const f32x4 w0 = wr_[128 * j], w1 = wr_[128 * j + 1];
#pragma unroll
                for (int rr = 0; rr < 4; ++rr) {
#pragma unroll
                    for (int e = 0; e < 4; ++e) { d[rr] = fmaf(xv[rr][j * 8 + e], w0[e], d[rr]); d[rr] = fmaf(xv[rr][j * 8 + 4 + e], w1[e], d[rr]); } } }
#pragma unroll
            for (int rr = 0; rr < 4; ++rr) { const float t = wave_sum(d[rr]); if (lane == hd) res[rr] = t; } }
        if (lane < 16) { const float bb = bfv[lane];
#pragma unroll
            for (int rr = 0; rr < 4; ++rr) { const int r = r0 + rr, b = r >> 11, s = r & 2047; const float rstd = 1.0f / sqrtf(ss[rr] * (1.0f / DM) + 1e-6f);
                const float xg = res[rr] * rstd + bb; logf[(size_t)(b * 16 + lane) * SEQ + s] = fminf(xg, 0.f) - log1pf(expf(-fabsf(xg))); } }
    }
}
__device__ __forceinline__ void moba_kmean_phase(const bf16* Kh, float* km, int lane, int gw, int NGW) {
    for (int task = gw; task < 512; task += NGW) {
        const int rg = lane >> 4, ch = lane & 15; const bf16* base = Kh + ((size_t)task * 256 + rg) * HD + ch * 8; float s[8] = {0.f, 0.f, 0.f, 0.f, 0.f, 0.f, 0.f, 0.f};
#pragma unroll 8
        for (int i = 0; i < 64; ++i) { const v4u w = *(const v4u*)(base + (size_t)i * 4 * HD);
            s[0] += __uint_as_float(w.x << 16); s[1] += __uint_as_float(w.x & 0xffff0000u); s[2] += __uint_as_float(w.y << 16); s[3] += __uint_as_float(w.y & 0xffff0000u);
            s[4] += __uint_as_float(w.z << 16); s[5] += __uint_as_float(w.z & 0xffff0000u); s[6] += __uint_as_float(w.w << 16); s[7] += __uint_as_float(w.w & 0xffff0000u); }
#pragma unroll
        for (int e = 0; e < 8; ++e) { s[e] += __shfl_xor(s[e], 16); s[e] += __shfl_xor(s[e], 32); }
        if (rg == 0) { float* o = km + (size_t)task * HD + ch * 8;
            *(f32x4*)o = (f32x4){s[0], s[1], s[2], s[3]} * (1.f / 256.f); *(f32x4*)(o + 4) = (f32x4){s[4], s[5], s[6], s[7]} * (1.f / 256.f); }
    }
}
__device__ __forceinline__ void fox_bias_phase(const float* logf, float* bias, int lane, int gw, int NGW) {
    for (int task = gw; task < 64; task += NGW) {
        const f32x4* src = (const f32x4*)(logf + (size_t)task * SEQ + 32 * lane); f32x4 v[8]; float run = 0.f;
#pragma unroll
        for (int j = 0; j < 8; ++j) { v[j] = src[j]; v[j][0] += run; v[j][1] += v[j][0]; v[j][2] += v[j][1]; v[j][3] += v[j][2]; run = v[j][3]; }
        float sc = run;
#pragma unroll
        for (int o = 1; o < 64; o <<= 1) { const float t = __shfl_up(sc, o); if (lane >= o) sc += t; }
        const float base = sc - run, ns = -1.0f / att::SCALE; f32x4* dst = (f32x4*)(bias + (size_t)task * SEQ + 32 * lane);
#pragma unroll
        for (int j = 0; j < 8; ++j) dst[j] = (v[j] + base) * ns;
    }
}
__device__ __forceinline__ void moba_bias_phase(float* bias, int lane, int gw, int NGW) {
    for (int task = gw; task < 64 * 8; task += NGW) { const int bh = task >> 3, s0 = (task & 7) * 256 + 4 * lane;
        const float sl = exp2f(-0.5f * (float)((bh & 15) + 1)) * (1.0f / att::SCALE);
        *(f32x4*)(bias + (size_t)bh * SEQ + s0) = (f32x4){sl * (float)s0, sl * (float)(s0 + 1), sl * (float)(s0 + 2), sl * (float)(s0 + 3)}; }
}
__device__ __forceinline__ void moba_select_phase(const bf16* Qh, const float* km, unsigned* sel, int lane, int gw, int NGW) {
    for (int task = gw; task < 64 * 32; task += NGW) {
        const int bh = task >> 5, t0 = (task & 31) * 64, own = t0 >> 8;
        const bf16* qrow = Qh + ((size_t)bh * SEQ + t0 + lane) * HD; const float* kmb = km + (size_t)bh * 8 * HD;
        float gt[8];
#pragma unroll
        for (int n = 0; n < 8; ++n) gt[n] = 0.f;
#pragma unroll 2
        for (int c = 0; c < 16; ++c) { const v4u w = *(const v4u*)(qrow + c * 8); float q[8];
            q[0] = __uint_as_float(w.x << 16); q[1] = __uint_as_float(w.x & 0xffff0000u); q[2] = __uint_as_float(w.y << 16); q[3] = __uint_as_float(w.y & 0xffff0000u);
            q[4] = __uint_as_float(w.z << 16); q[5] = __uint_as_float(w.z & 0xffff0000u); q[6] = __uint_as_float(w.w << 16); q[7] = __uint_as_float(w.w & 0xffff0000u);
#pragma unroll
            for (int n = 0; n < 7; ++n) if (n < own) { const float* kp = kmb + n * HD + c * 8;
#pragma unroll
                for (int j = 0; j < 8; ++j) gt[n] = fmaf(q[j], kp[j], gt[n]); } }
        unsigned m = 0u;
#pragma unroll
        for (int r = 0; r < 3; ++r) { int best = -1; float bv = -__builtin_inff();
#pragma unroll
            for (int n = 0; n < 7; ++n) if (n < own && !((m >> n) & 1u) && gt[n] > bv) { bv = gt[n]; best = n; }
            if (best >= 0) m |= 1u << best; }
        sel[(size_t)bh * SEQ + t0 + lane] = m;
    }
}
__device__ __forceinline__ void s5_scan_phase(const Args& a, int lane, int wave, int vcu, int G) {
    const float* a_re = a.in[14]; const float* a_im = a.in[15]; const float* log_dt = a.in[16];
    const float* Hl = (const float*)(a.ws + WS_HLOC); bf16* UH = (bf16*)(a.ws + WS_UH);
    for (int task = wave * G + vcu; task < 512; task += NWAVES * G) {
        const int g = task >> 2, b = task & 3, p = lane; const float dt = expf(log_dt[g]);
        const float mag = expf(a_re[g * 64 + p] * dt * 32.f); float sn, cs; sincosf(a_im[g * 64 + p] * dt * 32.f, &sn, &cs); const float ar = mag * cs, ai = mag * sn;
        float hr = 0.f, hi = 0.f;
#pragma unroll 8
        for (int k = 0; k < 64; ++k) { const size_t row = (size_t)g * 256 + b * 64 + k;
            *(unsigned*)(UH + row * 640 + 512 + 2 * p) = pk2(hr, hi);
            const f32x2 hl = *(const f32x2*)(Hl + row * 128 + 2 * p);
            const float nr = ar * hr - ai * hi + hl[0], ni = ar * hi + ai * hr + hl[1]; hr = nr; hi = ni; }
    }
}
__device__ __forceinline__ void final_norm_phase(const bf16* Hb, const float* ssq, const float* fg, float* out, int lane, int gw, int NGW) {
    for (int r = gw; r < M; r += NGW) {
        const f32x4* sp = (const f32x4*)(ssq + (size_t)r * 16); const f32x4 s4 = sp[0] + sp[1];
        const float rstd = 1.0f / sqrtf(((s4[0] + s4[1]) + (s4[2] + s4[3])) * (1.0f / DM) + 1e-6f);
        const v4u* xr = (const v4u*)(Hb + (size_t)r * DM) + lane; const f32x4* gr = (const f32x4*)fg + 2 * lane; f32x4* o = (f32x4*)(out + (size_t)r * DM) + 2 * lane;
#pragma unroll
        for (int j = 0; j < 4; ++j) { const v4u w = xr[64 * j]; const f32x4 g0 = gr[128 * j], g1 = gr[128 * j + 1];
            f32x4 a, b; a[0] = __uint_as_float(w.x << 16); a[1] = __uint_as_float(w.x & 0xffff0000u); a[2] = __uint_as_float(w.y << 16); a[3] = __uint_as_float(w.y & 0xffff0000u);
            b[0] = __uint_as_float(w.z << 16); b[1] = __uint_as_float(w.z & 0xffff0000u); b[2] = __uint_as_float(w.w << 16); b[3] = __uint_as_float(w.w & 0xffff0000u);
            o[128 * j] = a * g0 * rstd; o[128 * j + 1] = b * g1 * rstd; }
    }
}
__global__ void __launch_bounds__(NWAVES * 64, 2) mk_fwd(Args args) {
    extern __shared__ __attribute__((aligned(16))) unsigned char lds[];
    LAS unsigned char* L = (LAS unsigned char*)lds;
    volatile LAS unsigned* MISC = (volatile LAS unsigned*)(L + MISC_OFF);
    const int wave = __builtin_amdgcn_readfirstlane((int)threadIdx.x >> 6);
    const int tid = MK_TID();
#define TIDL() ({ int t_ = MK_TID(); asm volatile("" : "+v"(t_)); t_; })
    const int G = gridDim.x; const int bx = blockIdx.x; const int vcu = (G % 8 == 0) ? (bx % 8) * (G / 8) + bx / 8 : bx;
    const int gw = vcu * NWAVES + wave, NGW = G * NWAVES;
    unsigned char* ws = args.ws;
    unsigned* ctl = (unsigned*)(ws + WS_CTL);
    for (int u = tid; u < (LDS_BYTES - LDSCTL_OFF) / 4; u += NWAVES * 64) ((LAS unsigned*)(L + LDSCTL_OFF))[u] = 0u;
    __syncthreads();
    const int lo = args.ph_lo, hi = args.ph_hi;
    const bool single = (hi - lo) > 1;
    XcdBarrier bar; bar.bar = ctl + CW_BAR; bar.x = 0; bar.st = nullptr;
    if (single) bar = xcd_barrier_post(ctl + CW_BAR, MISC + 8, wave);
    int pc = 0;
#ifndef MK_SITES
#define MK_SITES 0xffffffu
#endif
#define SITE(n) (((MK_SITES >> (n)) & 1u) != 0u)
#define RUN() (pc >= lo && pc < hi)
#ifndef MK_REP_SITE
#define MK_REP_SITE -1
#endif
#ifndef MK_REP_N
#define MK_REP_N 1
#endif
#define REP(n) for (int rep_ = 0; rep_ < ((n) == MK_REP_SITE ? MK_REP_N : 1); ++rep_)
#define SEAM() do { if (pc >= lo && pc + 1 < hi) xcd_barrier(bar, wave); ++pc; } while (0)
#define ACT ((bf16*)(ws + WS_ACT))
#define QKV ((bf16*)(ws + WS_QKV))
#define OB ((bf16*)(ws + WS_OB))
#define PP ((bf16*)(ws + WS_PP))
#define LOGF ((float*)(ws + WS_LOGF))
#define KMEAN ((float*)(ws + WS_KMEAN))
#define UH ((bf16*)(ws + WS_UH))
#define HLOC ((float*)(ws + WS_HLOC))
#define YB ((bf16*)(ws + WS_YB))

    if (SITE(0) && RUN()) REP(0) { const int t = TIDL(); p0_prologue(args, L, t, t & 63, wave, vcu, G); }
    SEAM();
    if (SITE(1) && RUN()) REP(1) { pg8::Gemm g{(const bf16*)(ws + WS_PBF), (const bf16*)(ws + WS_WPP), PLE, PLE, PLE}; pg8::PpOrder S; S.init(G, bx);
        pg8::EpiBf16 E{PP, DM, nullptr, 0}; pg8::gemm_phase(L + RING_OFF, g, S, E, wave); }
    SEAM();
    int np = 8, sel = 0;
#define HBR ((const bf16*)(ws + (sel ? WS_HB2 : WS_HB)))
#define HBW ((bf16*)(ws + (sel ? WS_HB : WS_HB2)))
#define SSQR ((const float*)(ws + WS_SSQ) + (sel ? M * 16 : 0))
#define SSQW ((float*)(ws + WS_SSQ) + (sel ? 0 : M * 16))
    for (int layer = 0; layer < DEPTH; ++layer) {
        const int kind = layer % 3;
        for (int half = 0; half < 2; ++half) {
            if (SITE(2) && RUN()) REP(2) { pg8::Gemm g{HBR, (const bf16*)(ws + WS_WFI) + (size_t)(layer * 2 + half) * 2 * FF * DM, DM, DM, DM}; pg8::StaticOrder S; S.init(M, 2 * FF, G, bx);
                pg8::EpiSwiglu E{ACT, FF, SSQR, np}; pg8::gemm_phase(L + RING_OFF, g, S, E, wave); }
            SEAM();
            if (SITE(3) && RUN()) REP(3) { pg8::Gemm g{ACT, (const bf16*)(ws + WS_WFO) + (size_t)(layer * 2 + half) * DM * FF, FF, FF, FF}; pg8::StaticOrder S; S.init(M, DM, G, bx);
                pg8::EpiRes<0> E{HBR, (layer == 0 && half == 0) ? args.in[0] : nullptr, HBW, SSQW, 0.5f, nullptr, 0, nullptr}; pg8::gemm_phase(L + RING_OFF, g, S, E, wave); }
            SEAM(); np = 8; sel ^= 1;
            if (half == 0) {
                if (kind < 2) {
                    const int wslot = layer == 0 ? 0 : (layer == 1 ? 1 : 2);
                    if (kind == 0) { if (SITE(4) && RUN()) REP(4) fox_gate_phase(HBR, (const float*)(ws + WS_WFT) + (size_t)(layer / 3) * 16 * DM, args.in[9] + (layer / 3) * 16, LOGF, TIDL() & 63, gw, NGW); SEAM(); }
                    if (RUN()) {
                        if (SITE(4) && kind == 0) fox_bias_phase(LOGF, (float*)(ws + WS_BIAS), TIDL() & 63, wave * G + vcu, NGW);
                        if (SITE(5)) REP(5) { pg8::Gemm g{HBR, (const bf16*)(ws + WS_WQKV) + (size_t)wslot * 3 * DM * DM, DM, DM, DM}; pg8::StaticOrder S; S.init(M, 3 * DM, G, bx);
                        pg8::EpiQkv E{QKV, SSQR, np}; pg8::gemm_phase(L + RING_OFF, g, S, E, wave); } }
                    SEAM();
                    if (kind == 1) {
                        if (SITE(6) && RUN()) REP(6) { moba_kmean_phase(QKV + (size_t)M * DM, KMEAN, TIDL() & 63, gw, NGW); moba_bias_phase((float*)(ws + WS_BIAS), TIDL() & 63, gw, NGW); }
                        SEAM();
                        if (SITE(6) && RUN()) REP(6) moba_select_phase(QKV, KMEAN, (unsigned*)(ws + WS_SEL), TIDL() & 63, gw, NGW);
                        SEAM(); }
                    if (RUN()) {
                        if (kind == 0) { if (SITE(7)) REP(7) att::attn_phase<false>((char*)lds + RING_OFF, QKV, QKV + (size_t)M * DM, QKV + (size_t)2 * M * DM, OB, (const float*)(ws + WS_BIAS), nullptr, wave); }
                        else if (SITE(8)) REP(8) att::attn_phase<true>((char*)lds + RING_OFF, QKV, QKV + (size_t)M * DM, QKV + (size_t)2 * M * DM, OB, (const float*)(ws + WS_BIAS), (const unsigned*)(ws + WS_SEL), wave); }
                    SEAM();
                    if (SITE(9) && RUN()) REP(9) { pg8::Gemm g{OB, (const bf16*)(ws + WS_WO) + (size_t)wslot * DM * DM, DM, DM, DM}; pg8::StaticOrder S; S.init(M, DM, G, bx);
                        pg8::EpiRes<0> E{HBR, nullptr, HBW, SSQW, 1.0f, nullptr, 0, nullptr}; pg8::gemm_phase(L + RING_OFF, g, S, E, wave); }
                    SEAM(); sel ^= 1;
                } else {
                    if (SITE(10) && RUN()) REP(10) { pg8::Gemm g{HBR, (const bf16*)(ws + WS_WS5I), DM, DM, DM}; pg8::StaticOrder S; S.init(M, DM, G, bx);
                        pg8::EpiS5U E{UH, SSQR, np}; pg8::gemm_phase(L + RING_OFF, g, S, E, wave); }
                    SEAM();
                    if (SITE(11) && RUN()) REP(11) { pg8::Gemm g{UH, (const bf16*)(ws + WS_S5W), 640, 512, 512}; pg8::BatchOrder<1> S; S.init(G, bx);
                        pg8::EpiS5H E{HLOC}; pg8::gemm_phase(L + RING_OFF, g, S, E, wave); }
                    SEAM();
                    if (SITE(12) && RUN()) REP(12) s5_scan_phase(args, TIDL() & 63, wave, vcu, G);
                    SEAM();
                    if (SITE(13) && RUN()) REP(13) { pg8::Gemm g{UH, (const bf16*)(ws + WS_S5TV), 640, 640, 640}; pg8::BatchOrder<2> S; S.init(G, bx);
                        pg8::EpiS5Y E{YB}; pg8::gemm_phase(L + RING_OFF, g, S, E, wave); }
                    SEAM();
                    if (SITE(14) && RUN()) REP(14) { pg8::Gemm g{YB, (const bf16*)(ws + WS_WGLU), DM, DM, DM}; pg8::StaticOrder S; S.init(M, 2 * DM, G, bx);
                        pg8::EpiRes<2> E{HBR, nullptr, HBW, SSQW, 1.0f, nullptr, 0, nullptr}; pg8::gemm_phase(L + RING_OFF, g, S, E, wave); }
                    SEAM(); np = 16; sel ^= 1;
                }
            } else {
                if (SITE(15) && RUN()) REP(15) { pg8::Gemm g{HBR, (const bf16*)(ws + WS_WPG) + (size_t)layer * DM * DM, DM, DM, DM}; pg8::StaticOrder S; S.init(M, DM, G, bx);
                    pg8::EpiRes<1> E{HBR, nullptr, HBW, SSQW, 1.0f, SSQR, np, PP + (size_t)layer * M * DM}; pg8::gemm_phase(L + RING_OFF, g, S, E, wave); }
                SEAM(); sel ^= 1;
            }
        }
    }
    if (SITE(16) && RUN()) REP(16) final_norm_phase(HBR, SSQR, args.in[3], args.out, TIDL() & 63, gw, NGW);
#undef RUN
#undef SEAM
}
constexpr int N_PHASES = 2 + 4 * 5 + (4 + 5 + 4 + 5) + 1;

#ifndef MK_PER_PHASE
#define MK_PER_PHASE 0
#endif
static void mk_launch(void* const* d_in, float* d_out, void* d_ws, hipStream_t stream) {
    static int grid = 0;
    if (grid == 0) {
        int dev = 0, cus = 0, per_cu = 0;
        if (hipGetDevice(&dev) != hipSuccess || hipDeviceGetAttribute(&cus, hipDeviceAttributeMultiprocessorCount, dev) != hipSuccess) { fprintf(stderr, "mk_launch: device query failed\n"); grid = -1; return; }
        if (hipFuncSetAttribute((const void*)mk_fwd, hipFuncAttributeMaxDynamicSharedMemorySize, LDS_BYTES) != hipSuccess) { fprintf(stderr, "mk_launch: hipFuncSetAttribute failed\n"); grid = -1; return; }
        if (hipOccupancyMaxActiveBlocksPerMultiprocessor(&per_cu, (const void*)mk_fwd, NWAVES * 64, LDS_BYTES) != hipSuccess || per_cu < 1) fprintf(stderr, "mk_launch: occupancy query reports %d\n", per_cu);
        (void)hipGetLastError();
        grid = cus;
    }
    if (grid < 0) return;
    if (hipMemsetAsync((char*)d_ws + WS_CTL, 0, CTL_ZERO_BYTES, stream) != hipSuccess) { fprintf(stderr, "mk_launch: memset failed\n"); return; }
    Args a{};
    for (int i = 0; i < 23; ++i) a.in[i] = (const float*)d_in[i];
    a.out = d_out; a.ws = (unsigned char*)d_ws;
#if MK_PER_PHASE
    for (int ph = 0; ph < N_PHASES; ++ph) { a.ph_lo = ph; a.ph_hi = ph + 1; hipLaunchKernelGGL(mk_fwd, dim3(grid), dim3(NWAVES * 64), LDS_BYTES, stream, a); }
#else
    a.ph_lo = 0; a.ph_hi = 1 << 20;
    hipLaunchKernelGGL(mk_fwd, dim3(grid), dim3(NWAVES * 64), LDS_BYTES, stream, a);
#endif
    const hipError_t le = hipPeekAtLastError();
    if (le != hipSuccess) fprintf(stderr, "mk_launch: launch failed: %s\n", hipGetErrorName(le));
}

extern "C" void kernel_launch(void* const* d_in, const int* in_sizes, int n_in, void* d_out, int out_size, void* d_ws, size_t ws_size, hipStream_t stream) {
    if (n_in != 23 || out_size != M * DM || in_sizes[0] != M * DM || ws_size < WS_END) { fprintf(stderr, "kernel_launch: unexpected shapes n_in=%d out=%d ws=%zu\n", n_in, out_size, ws_size); return; }
    mk_launch(d_in, (float*)d_out, d_ws, stream);
}
```

```cpp
#include <hip/hip_runtime.h>
#include <cstdio>
#include <cstdint>
#include <cmath>
#define MK_TID() ({ unsigned l_; asm volatile("v_mbcnt_lo_u32_b32 %0, -1, 0\n\tv_mbcnt_hi_u32_b32 %0, -1, %0" : "=v"(l_)); (int)(((unsigned)wave << 6) | l_); })
#define XB_TID ((unsigned)MK_TID())
namespace pg8 {
#define PG8_LAS __attribute__((address_space(3)))
typedef unsigned short bf16_t;
typedef short bf16x8 __attribute__((ext_vector_type(8)));
typedef float f32x4 __attribute__((ext_vector_type(4)));
typedef float f32x2 __attribute__((ext_vector_type(2)));
typedef unsigned u32x4 __attribute__((ext_vector_type(4)));
typedef unsigned u32x2 __attribute__((ext_vector_type(2)));
#ifndef MK_WGM
#define MK_WGM 4
#endif
constexpr int BM = 256, BK = 64, HALF = 128, HTB = HALF * BK * 2  , STAGE_BYTES = 8 * HTB, NXCD = 8, WGM = MK_WGM;
constexpr int EPI_LDS_OFF = STAGE_BYTES;
constexpr float RMS_EPS = 1e-6f;

__host__ __device__ __forceinline__ int lds_byte(int r, int c) { const int st = (r >> 4) * 2 + (c >> 5), rr = r & 15, cc = c & 31, ob = rr * 64 + cc * 2; return st * 1024 + (ob ^ (((ob >> 9) & 1) << 5)); }
__host__ __device__ __forceinline__ void stage_rc(int b, int& R, int& C) { const int st = b / 1024, sb = b % 1024, swz = sb ^ (((sb >> 9) & 1) << 5); R = (st >> 1) * 16 + swz / 64; C = (st & 1) * 32 + (swz % 64) / 2; }
__host__ __device__ __forceinline__ int perm32(int rho) { const int n = rho >> 4, i = rho & 15; return 8 * (i >> 2) + 4 * n + (i & 3); }

struct Unit { int pm, pn, pb; };
struct Gemm { const bf16_t* A; const bf16_t* Bt; int lda, ldb, K; };

struct StaticOrder {
    int nM, nN, nwg, G, c, lim;
    __device__ void init(int M, int N, int G_, int c_) { nM = M / BM; nN = N / BM; nwg = nM * nN; G = G_; c = c_; lim = nwg; }
    __device__ bool next(int i, Unit& u) const {
        const long L = (long)i * G + c; if (L >= lim) return false;
        int wgid = (int)L; { const int q = nwg / NXCD, r = nwg % NXCD, xcd = wgid % NXCD, off = wgid / NXCD; wgid = (xcd < r ? xcd * (q + 1) : r * (q + 1) + (xcd - r) * q) + off; }
        const int nig = WGM * nN, gid = wgid / nig, fm = gid * WGM, gsz = (nM - fm) < WGM ? (nM - fm) : WGM;
        u.pm = fm + ((wgid % nig) % gsz); u.pn = (wgid % nig) / gsz; u.pb = u.pn; return true;
    }
};
struct PpOrder {
    StaticOrder s;
    __device__ void init(int G_, int c_) { s.init(4 * 8192, 2048, G_, c_); }
    __device__ bool next(int i, Unit& u) const { if (!s.next(i, u)) return false; u.pb = (u.pm >> 5) * 8 + u.pn; return true; }
};
template <int NT> struct BatchOrder {
    int G, c;
    __device__ void init(int G_, int c_) { G = G_; c = c_; }
    __device__ bool next(int i, Unit& u) const { const int L = i * G + c; if (L >= 128 * NT) return false; u.pm = L / NT; u.pn = L % NT; u.pb = L; return true; }
};

__device__ __forceinline__ unsigned cvt_pk_bf16(float lo, float hi) { unsigned r; asm volatile("v_cvt_pk_bf16_f32 %0, %1, %2" : "=v"(r) : "v"(lo), "v"(hi)); return r; }
__device__ __forceinline__ float fast_sigmoid(float x) { return __builtin_amdgcn_rcpf(1.0f + __builtin_amdgcn_exp2f(-1.4426950408889634f * x)); }
__device__ __forceinline__ float fast_silu(float x) { return x * fast_sigmoid(x); }
__device__ __forceinline__ float gelu_tanh(float v) {
    const float z = 0.7978845608028654f * (v + 0.044715f * v * v * v); return v * fast_sigmoid(2.0f * z);
}

typedef f32x4 Acc[2][2][4][2];

__device__ __forceinline__ void row_rstd(const float* ssq, int np, const Unit& u, int wr, int fr, float (&rs)[2][4], PG8_LAS unsigned char* lds, int tid) {
    PG8_LAS float* R = (PG8_LAS float*)(lds + EPI_LDS_OFF + 4096);
    if (tid < 256) { const f32x4* sp = (const f32x4*)(ssq + ((size_t)u.pm * BM + tid) * 16);
        f32x4 a = sp[0] + sp[1]; if (np > 8) a += sp[2] + sp[3];
        R[tid] = __builtin_amdgcn_rsqf(((a[0] + a[1]) + (a[2] + a[3])) * (1.0f / 2048.0f) + RMS_EPS); }
    asm volatile("s_waitcnt lgkmcnt(0)" ::: "memory"); __builtin_amdgcn_s_barrier(); asm volatile("" ::: "memory");
#pragma unroll
    for (int ai = 0; ai < 2; ++ai)
#pragma unroll
        for (int m = 0; m < 4; ++m) rs[ai][m] = R[ai * HALF + wr * 64 + m * 16 + fr];
}

struct EpiNone {
    static constexpr bool PERM = true, BAR = false;
    float* sink; int never;
    __device__ __forceinline__ void operator()(const Acc& acc, const Unit& u, int wr, int wc, int fr, int fq, PG8_LAS unsigned char* lds, int tid) const {
        if (never) { f32x4 t = (f32x4){0.f, 0.f, 0.f, 0.f};
#pragma unroll
            for (int ai = 0; ai < 2; ++ai)
#pragma unroll
                for (int bj = 0; bj < 2; ++bj)
#pragma unroll
                    for (int m = 0; m < 4; ++m)
#pragma unroll
                        for (int n = 0; n < 2; ++n) t += acc[ai][bj][m][n];
            *(f32x4*)(sink + tid * 4) = t; }
    }
};
struct EpiSwiglu {
    static constexpr bool PERM = true, BAR = false;
    bf16_t* O; int ldo; const float* ssq; int np;
    __device__ __forceinline__ void operator()(const Acc& acc, const Unit& u, int wr, int wc, int fr, int fq, PG8_LAS unsigned char* lds, int tid) const {
        float rs[2][4]; row_rstd(ssq, np, u, wr, fr, rs, lds, tid);
        const int col0 = u.pn * HALF + wc * 32 + 8 * fq;
#pragma unroll
        for (int ai = 0; ai < 2; ++ai)
#pragma unroll
            for (int m = 0; m < 4; ++m) { const float s = rs[ai][m]; float o[8];
#pragma unroll
                for (int n = 0; n < 2; ++n)
#pragma unroll
                    for (int i = 0; i < 4; ++i) o[n * 4 + i] = fast_silu(acc[ai][0][m][n][i] * s) * (acc[ai][1][m][n][i] * s);
                u32x4 w; w.x = cvt_pk_bf16(o[0], o[1]); w.y = cvt_pk_bf16(o[2], o[3]); w.z = cvt_pk_bf16(o[4], o[5]); w.w = cvt_pk_bf16(o[6], o[7]);
                *(u32x4*)(O + (size_t)(u.pm * BM + ai * HALF + wr * 64 + m * 16 + fr) * ldo + col0) = w; }
    }
};
struct EpiBf16 {
    static constexpr bool PERM = true, BAR = false;
    bf16_t* O; int ldo; const float* ssq; int np;
    __device__ __forceinline__ void operator()(const Acc& acc, const Unit& u, int wr, int wc, int fr, int fq, PG8_LAS unsigned char* lds, int tid) const {
        float rs[2][4];
        if (ssq) row_rstd(ssq, np, u, wr, fr, rs, lds, tid); else {
#pragma unroll
            for (int a = 0; a < 2; ++a)
#pragma unroll
                for (int m = 0; m < 4; ++m) rs[a][m] = 1.f; }
        const int col0 = u.pn * BM + wc * 32 + 8 * fq;
#pragma unroll
        for (int ai = 0; ai < 2; ++ai)
#pragma unroll
            for (int m = 0; m < 4; ++m) { const float s = rs[ai][m]; bf16_t* rowp = O + (size_t)(u.pm * BM + ai * HALF + wr * 64 + m * 16 + fr) * ldo + col0;
#pragma unroll
                for (int bj = 0; bj < 2; ++bj) { const f32x4 v0 = acc[ai][bj][m][0] * s, v1 = acc[ai][bj][m][1] * s;
                    u32x4 w; w.x = cvt_pk_bf16(v0[0], v0[1]); w.y = cvt_pk_bf16(v0[2], v0[3]); w.z = cvt_pk_bf16(v1[0], v1[1]); w.w = cvt_pk_bf16(v1[2], v1[3]);
                    *(u32x4*)(rowp + bj * HALF) = w; } }
    }
};
struct EpiQkv {
    static constexpr bool PERM = true, BAR = false;
    bf16_t* O; const float* ssq; int np;
    __device__ __forceinline__ void operator()(const Acc& acc, const Unit& u, int wr, int wc, int fr, int fq, PG8_LAS unsigned char* lds, int tid) const {
        float rs[2][4]; row_rstd(ssq, np, u, wr, fr, rs, lds, tid);
        const int which = u.pn >> 3, hd0 = (u.pn & 7) * 2, d0 = wc * 32 + 8 * fq;
#pragma unroll
        for (int ai = 0; ai < 2; ++ai)
#pragma unroll
            for (int m = 0; m < 4; ++m) { const float s = rs[ai][m]; const int r = u.pm * BM + ai * HALF + wr * 64 + m * 16 + fr, b = r >> 11, t = r & 2047;
#pragma unroll
                for (int bj = 0; bj < 2; ++bj) { const f32x4 v0 = acc[ai][bj][m][0] * s, v1 = acc[ai][bj][m][1] * s;
                    u32x4 w; w.x = cvt_pk_bf16(v0[0], v0[1]); w.y = cvt_pk_bf16(v0[2], v0[3]); w.z = cvt_pk_bf16(v1[0], v1[1]); w.w = cvt_pk_bf16(v1[2], v1[3]);
                    *(u32x4*)(O + (size_t)which * (8192 * 2048) + ((size_t)((b * 16 + hd0 + bj) * 2048 + t)) * 128 + d0) = w; } }
    }
};
struct EpiS5U {
    static constexpr bool PERM = true, BAR = false;
    bf16_t* UH; const float* ssq; int np;
    __device__ __forceinline__ void operator()(const Acc& acc, const Unit& u, int wr, int wc, int fr, int fq, PG8_LAS unsigned char* lds, int tid) const {
        float rs[2][4]; row_rstd(ssq, np, u, wr, fr, rs, lds, tid);
#pragma unroll
        for (int ai = 0; ai < 2; ++ai)
#pragma unroll
            for (int m = 0; m < 4; ++m) { const float s = rs[ai][m]; const int r = u.pm * BM + ai * HALF + wr * 64 + m * 16 + fr;
#pragma unroll
                for (int bj = 0; bj < 2; ++bj) { const int cg = u.pn * BM + bj * HALF + wc * 32 + 8 * fq, g = cg >> 4, c0 = cg & 15;
                    const f32x4 v0 = acc[ai][bj][m][0] * s, v1 = acc[ai][bj][m][1] * s;
                    u32x4 w; w.x = cvt_pk_bf16(v0[0], v0[1]); w.y = cvt_pk_bf16(v0[2], v0[3]); w.z = cvt_pk_bf16(v1[0], v1[1]); w.w = cvt_pk_bf16(v1[2], v1[3]);
                    *(u32x4*)(UH + ((size_t)g * 256 + (r >> 5)) * 640 + (r & 31) * 16 + c0) = w; } }
    }
};
struct EpiS5H {
    static constexpr bool PERM = false, BAR = false;
    float* Hl;
    __device__ __forceinline__ void operator()(const Acc& acc, const Unit& u, int wr, int wc, int fr, int fq, PG8_LAS unsigned char* lds, int tid) const {
#pragma unroll
        for (int ai = 0; ai < 2; ++ai)
#pragma unroll
            for (int m = 0; m < 4; ++m) { float* rowp = Hl + ((size_t)u.pm * 256 + ai * HALF + wr * 64 + m * 16 + fr) * 128 + wc * 32 + 4 * fq;
#pragma unroll
                for (int n = 0; n < 2; ++n) *(f32x4*)(rowp + n * 16) = acc[ai][0][m][n]; }
    }
};
struct EpiS5Y {
    static constexpr bool PERM = true, BAR = false;
    bf16_t* Y;
    __device__ __forceinline__ void operator()(const Acc& acc, const Unit& u, int wr, int wc, int fr, int fq, PG8_LAS unsigned char* lds, int tid) const {
#pragma unroll
        for (int ai = 0; ai < 2; ++ai)
#pragma unroll
            for (int m = 0; m < 4; ++m) { const int crow = ai * HALF + wr * 64 + m * 16 + fr;
#pragma unroll
                for (int bj = 0; bj < 2; ++bj) { const int col = u.pn * BM + bj * HALF + wc * 32 + 8 * fq, j = col >> 4, c0 = col & 15;
                    float o[8];
#pragma unroll
                    for (int n = 0; n < 2; ++n)
#pragma unroll
                        for (int i = 0; i < 4; ++i) o[n * 4 + i] = gelu_tanh(acc[ai][bj][m][n][i]);
                    u32x4 w; w.x = cvt_pk_bf16(o[0], o[1]); w.y = cvt_pk_bf16(o[2], o[3]); w.z = cvt_pk_bf16(o[4], o[5]); w.w = cvt_pk_bf16(o[6], o[7]);
                    *(u32x4*)(Y + ((size_t)crow * 32 + j) * 2048 + u.pm * 16 + c0) = w; } }
    }
};
template <int MODE> struct EpiRes {
    static constexpr bool PERM = true, BAR = true;
    const bf16_t* hin; const float* hin32; bf16_t* hout; float* ssq_out; float alpha; const float* ssq; int np; const bf16_t* pp;
    __device__ __forceinline__ void operator()(const Acc& acc, const Unit& u, int wr, int wc, int fr, int fq, PG8_LAS unsigned char* lds, int tid) const {
        float rs[2][4];
        if (MODE == 1) row_rstd(ssq, np, u, wr, fr, rs, lds, tid);
        PG8_LAS float* P = (PG8_LAS float*)(lds + EPI_LDS_OFF);
        constexpr int NBJ = (MODE == 2) ? 1 : 2; constexpr int CW = (MODE == 2) ? HALF : BM;
#pragma unroll
        for (int ai = 0; ai < 2; ++ai)
#pragma unroll
            for (int m = 0; m < 4; ++m) { const int rl = ai * HALF + wr * 64 + m * 16 + fr; const size_t r = (size_t)u.pm * BM + rl; float sq = 0.f;
#pragma unroll
                for (int bj = 0; bj < NBJ; ++bj) { const int col = u.pn * CW + bj * HALF + wc * 32 + 8 * fq; const size_t off = r * 2048 + col;
                    float f[8], h[8];
                    if (MODE == 0) {
#pragma unroll
                        for (int e = 0; e < 8; ++e) f[e] = acc[ai][bj][m][e >> 2][e & 3] * alpha; }
                    else if (MODE == 1) { const u32x4 pw = *(const u32x4*)(pp + off); const float s = rs[ai][m];
#pragma unroll
                        for (int e = 0; e < 8; ++e) { const unsigned w = pw[e >> 1]; const float pv = __uint_as_float((e & 1) ? (w & 0xffff0000u) : (w << 16)); f[e] = fast_sigmoid(acc[ai][bj][m][e >> 2][e & 3] * s) * pv; } }
                    else {
#pragma unroll
                        for (int e = 0; e < 8; ++e) f[e] = acc[ai][0][m][e >> 2][e & 3] * fast_sigmoid(acc[ai][1][m][e >> 2][e & 3]); }
                    if (hin32) { const f32x4 a = *(const f32x4*)(hin32 + off), b = *(const f32x4*)(hin32 + off + 4);
#pragma unroll
                        for (int e = 0; e < 4; ++e) { h[e] = a[e]; h[4 + e] = b[e]; } }
                    else { const u32x4 hw = *(const u32x4*)(hin + off);
#pragma unroll
                        for (int e = 0; e < 8; ++e) { const unsigned w = hw[e >> 1]; h[e] = __uint_as_float((e & 1) ? (w & 0xffff0000u) : (w << 16)); } }
                    float o[8];
#pragma unroll
                    for (int e = 0; e < 8; ++e) { o[e] = h[e] + f[e]; sq = fmaf(o[e], o[e], sq); }
                    u32x4 w; w.x = cvt_pk_bf16(o[0], o[1]); w.y = cvt_pk_bf16(o[2], o[3]); w.z = cvt_pk_bf16(o[4], o[5]); w.w = cvt_pk_bf16(o[6], o[7]);
                    *(u32x4*)(hout + off) = w; }
                sq += __shfl_xor(sq, 16); sq += __shfl_xor(sq, 32);
                if (fq == 0) P[rl * 4 + wc] = sq;
                if (m & 1) asm volatile("" ::: "memory"); }
        asm volatile("s_waitcnt lgkmcnt(0)" ::: "memory"); __builtin_amdgcn_s_barrier(); asm volatile("" ::: "memory");
        if (tid < 256) { const f32x4 p4 = *(const PG8_LAS f32x4*)(P + tid * 4); ssq_out[((size_t)u.pm * BM + tid) * 16 + u.pn] = (p4[0] + p4[1]) + (p4[2] + p4[3]); }
    }
};

template <class Epi, class Sched>
__device__ __forceinline__ void gemm_phase(PG8_LAS unsigned char* lds, const Gemm g, const Sched& S, const Epi& E, const int wave) {
    int tid_raw_ = MK_TID(); asm volatile("" : "+v"(tid_raw_)); const int tid = tid_raw_, wid = __builtin_amdgcn_readfirstlane(tid >> 6), lane = tid & 63, wr = wid >> 2, wc = wid & 3, fr = lane & 15, fq = lane >> 4;
    int K_ = g.K; asm volatile("" : "+s"(K_)); const int K = K_, nt = K / BK;
    unsigned voffA[2], voffB[2];
#pragma unroll
    for (int i = 0; i < 2; ++i) { int R, C; stage_rc(tid * 16 + i * 8192, R, C); const int Rb = Epi::PERM ? ((R & ~31) + perm32(R & 31)) : R;
        voffA[i] = (unsigned)(R * g.lda + C) * 2u; voffB[i] = (unsigned)(Rb * g.ldb + C) * 2u; }
    const size_t kstep = (size_t)(BK * 2);
    const size_t hstepA = (size_t)HALF * g.lda * 2, hstepB = (size_t)HALF * g.ldb * 2;
    const size_t tstepA = 2 * hstepA, tstepB = 2 * hstepB;
    const unsigned ldsw = (unsigned)wid * 1024u;
    const int aoff = lds_byte(wr * 64 + fr, fq * 8), boff = lds_byte(wc * 32 + fr, fq * 8);
#define PG8_SA(b, h) (((b) * 2 + (h)) * HTB)
#define PG8_SB(b, h) ((4 + (b) * 2 + (h)) * HTB)
#define PG8_STAGE(bufoff, gbase, voff) do { _Pragma("unroll") for (int _i = 0; _i < 2; ++_i) \
        __builtin_amdgcn_global_load_lds((const unsigned*)((const char*)(gbase) + (voff)[_i]), (PG8_LAS unsigned*)(lds + (bufoff) + ldsw + _i * 8192), 16, 0, 0); } while (0)
#define PG8_LDA(dst, b, h) do { _Pragma("unroll") for (int m = 0; m < 4; ++m) _Pragma("unroll") for (int k = 0; k < 2; ++k) dst[m][k] = *(const PG8_LAS bf16x8*)(lds + PG8_SA(b, h) + aoff + m * 2048 + k * 1024); } while (0)
#define PG8_LDB(dst, b, h) do { _Pragma("unroll") for (int n = 0; n < 2; ++n) _Pragma("unroll") for (int k = 0; k < 2; ++k) dst[n][k] = *(const PG8_LAS bf16x8*)(lds + PG8_SB(b, h) + boff + n * 2048 + k * 1024); } while (0)
#define PG8_MMA(ai, bj, At, Bt) do { __builtin_amdgcn_s_setprio(1); _Pragma("unroll") for (int m = 0; m < 4; ++m) _Pragma("unroll") for (int n = 0; n < 2; ++n) _Pragma("unroll") for (int k = 0; k < 2; ++k) \
        acc[ai][bj][m][n] = __builtin_amdgcn_mfma_f32_16x16x32_bf16(Bt[n][k], At[m][k], acc[ai][bj][m][n], 0, 0, 0); __builtin_amdgcn_s_setprio(0); } while (0)
#define PG8_WAIT_V(n) asm volatile("s_waitcnt vmcnt(" #n ")" ::: "memory")
#define PG8_WAIT_L(n) asm volatile("s_waitcnt lgkmcnt(" #n ")" ::: "memory")
#define PG8_BAR __builtin_amdgcn_s_barrier()
#define PG8_SCHED __builtin_amdgcn_sched_barrier(0)
    Unit cur, nxt; int ui = 0;
    if (!S.next(0, cur)) return;
    f32x4 acc[2][2][4][2];
#pragma unroll
    for (int a = 0; a < 2; ++a)
#pragma unroll
        for (int b = 0; b < 2; ++b)
#pragma unroll
            for (int m = 0; m < 4; ++m)
#pragma unroll
                for (int n = 0; n < 2; ++n) acc[a][b][m][n] = (f32x4){0.f, 0.f, 0.f, 0.f};
    bf16x8 At[4][2], B0[2][2], B1[2][2];
    const char* cA = (const char*)g.A + (size_t)cur.pm * tstepA; const char* cB = (const char*)g.Bt + (size_t)cur.pb * tstepB;
    PG8_STAGE(PG8_SB(0, 0), cB, voffB); PG8_STAGE(PG8_SB(0, 1), cB + hstepB, voffB); PG8_STAGE(PG8_SA(0, 0), cA, voffA); PG8_STAGE(PG8_SA(0, 1), cA + hstepA, voffA);
    if (wr == 1) PG8_BAR;
    PG8_WAIT_V(2); PG8_BAR;
    PG8_STAGE(PG8_SB(1, 0), cB + kstep, voffB); PG8_STAGE(PG8_SA(1, 0), cA + kstep, voffA); PG8_STAGE(PG8_SB(1, 1), cB + hstepB + kstep, voffB);
    PG8_WAIT_V(6); PG8_BAR;
    for (;;) {
        const bool has_next = S.next(ui + 1, nxt);
        const char* nA = has_next ? (const char*)g.A + (size_t)nxt.pm * tstepA : cA; const char* nB = has_next ? (const char*)g.Bt + (size_t)nxt.pb * tstepB : cB;
        for (int t = 0; t < nt; t += 2) {
            const bool last = (t == nt - 2);
            const char* a1 = cA + (size_t)(t + 1) * kstep;
            const char* a2 = last ? nA : cA + (size_t)(t + 2) * kstep; const char* b2 = last ? nB : cB + (size_t)(t + 2) * kstep;
            const char* a3 = a2 + kstep; const char* b3 = b2 + kstep;
            PG8_LDB(B0, 0, 0); PG8_LDB(B1, 0, 1); PG8_SCHED; PG8_LDA(At, 0, 0); PG8_STAGE(PG8_SA(1, 1), a1 + hstepA, voffA);
            PG8_WAIT_V(8); PG8_WAIT_L(0); PG8_BAR; PG8_MMA(0, 0, At, B0); PG8_MMA(0, 1, At, B1); PG8_BAR; PG8_SCHED;
            PG8_LDA(At, 0, 1); PG8_STAGE(PG8_SB(0, 0), b2, voffB); PG8_STAGE(PG8_SB(0, 1), b2 + hstepB, voffB); PG8_STAGE(PG8_SA(0, 0), a2, voffA);
            PG8_WAIT_V(8); PG8_WAIT_L(0); PG8_BAR; PG8_MMA(1, 0, At, B0); PG8_MMA(1, 1, At, B1); PG8_BAR; PG8_SCHED;
            PG8_LDB(B0, 1, 0); PG8_LDB(B1, 1, 1); PG8_SCHED; PG8_LDA(At, 1, 0); PG8_STAGE(PG8_SA(0, 1), a2 + hstepA, voffA);
            PG8_WAIT_V(8); PG8_WAIT_L(0); PG8_BAR; PG8_MMA(0, 0, At, B0); PG8_MMA(0, 1, At, B1); PG8_BAR; PG8_SCHED;
            PG8_LDA(At, 1, 1); PG8_STAGE(PG8_SB(1, 0), b3, voffB); PG8_STAGE(PG8_SB(1, 1), b3 + hstepB, voffB); PG8_STAGE(PG8_SA(1, 0), a3, voffA);
            PG8_WAIT_V(8); PG8_WAIT_L(0); PG8_BAR; PG8_MMA(1, 0, At, B0); PG8_MMA(1, 1, At, B1); PG8_BAR; PG8_SCHED;
        }
        if (wr == 0) PG8_BAR;
        { int le_ = lane; asm volatile("" : "+v"(le_));
          E(acc, cur, wr, wc, le_ & 15, le_ >> 4, lds, (wid << 6) | le_); }
        if (!has_next) break;
#pragma unroll
        for (int a = 0; a < 2; ++a)
#pragma unroll
            for (int b = 0; b < 2; ++b)
#pragma unroll
                for (int m = 0; m < 4; ++m)
#pragma unroll
                    for (int n = 0; n < 2; ++n) acc[a][b][m][n] = (f32x4){0.f, 0.f, 0.f, 0.f};
        cur = nxt; cA = nA; cB = nB; ++ui;
        if (wr == 1) PG8_BAR;
    }
    PG8_WAIT_V(0);
    PG8_BAR;
#undef PG8_SA
#undef PG8_SB
#undef PG8_STAGE
#undef PG8_LDA
#undef PG8_LDB
#undef PG8_MMA
#undef PG8_WAIT_V
#undef PG8_WAIT_L
#undef PG8_BAR
#undef PG8_SCHED
}
}
namespace att {
typedef unsigned short bf16;
typedef short bf16x8 __attribute__((ext_vector_type(8)));
typedef short s16x4 __attribute__((ext_vector_type(4)));
typedef float f32x16 __attribute__((ext_vector_type(16)));
typedef float f32x4 __attribute__((ext_vector_type(4)));
typedef unsigned u32x4 __attribute__((ext_vector_type(4)));
constexpr int D = 128, SEQ = 2048, OS = 2048;
constexpr float SCALE = 0.08838834764831845f, THR = 8.f;
constexpr int NW = 8, QBLK = 32, KVBLK = 64, QB = NW * QBLK;
constexpr int SHM_V = KVBLK * D * 2, SHM_K = KVBLK * D * 2;
constexpr int LDS_WS = 2 * SHM_V + 2 * SHM_K;
constexpr int LDS_BIAS = LDS_WS + NW * 64 * 4;
constexpr int LDS_NEG = LDS_BIAS + SEQ * 4;
constexpr int LDS_BYTES = LDS_NEG + 256;

#define KSWZ(row, colB) ((row) * 256 + ((colB) ^ (((row) & 7) << 4)))
#define SBAR() __builtin_amdgcn_sched_barrier(0)
__device__ __forceinline__ int v_st(int k, int c) { const int kk = (k & ~0xC) | ((k & 4) << 1) | ((k & 8) >> 1); return ((kk >> 3) * 4 + (c >> 5)) * 512 + ((kk & 7) * 32 + (c & 31)) * 2; }
__device__ __forceinline__ int v_rd_base(int lane) { return ((lane & 3) << 3) | (((lane >> 2) & 3) << 6) | (((lane >> 4) & 1) << 5) | (((lane >> 5) & 1) << 8); }
constexpr int v_rd_off(int d0, int ks, int half) { return d0 * 512 + ks * 4096 + half * 2048; }
__device__ __forceinline__ int crow(int r, int hi) { return (r & 3) + 8 * (r >> 2) + 4 * hi; }
__device__ __forceinline__ unsigned cvtpk(float lo, float hi) { unsigned r; asm volatile("v_cvt_pk_bf16_f32 %0, %1, %2" : "=v"(r) : "v"(lo), "v"(hi)); return r; }
__device__ __forceinline__ bf16x8 load8(const bf16* p) { return *reinterpret_cast<const bf16x8*>(p); }
__device__ __forceinline__ void mask_tile(f32x16& p0, f32x16& p1, int dq) {
    const float NEG = -__builtin_inff();
#pragma unroll
    for (int r = 0; r < 16; ++r) {
        const int c = (r & 3) + 8 * (r >> 2);
        if (dq - c < 0) p0[r] = NEG;
        if (dq - c - 32 < 0) p1[r] = NEG;
    }
}
__device__ __forceinline__ void partialSM(f32x16& p0, f32x16& p1, float& m_reg, float& mn, float& alpha) {
    float pmax = p0[0]; for (int r = 1; r < 16; ++r) pmax = fmaxf(pmax, p0[r]); for (int r = 0; r < 16; ++r) pmax = fmaxf(pmax, p1[r]);
    { auto rr = __builtin_amdgcn_permlane32_swap(__float_as_uint(pmax), __float_as_uint(pmax), false, false);
      pmax = fmaxf(__uint_as_float(rr[0]), __uint_as_float(rr[1])); }
    constexpr float C2 = 1.4426950408889634f * SCALE;
    if (__builtin_expect(__all((pmax - m_reg) * SCALE <= THR), 1)) { mn = m_reg; alpha = 1.f; }
    else { mn = fmaxf(m_reg, pmax); alpha = __builtin_amdgcn_exp2f((m_reg - mn) * C2); m_reg = mn; }
    const float mnL = -mn * C2;
    for (int r = 0; r < 16; ++r) p0[r] = fmaf(p0[r], C2, mnL); for (int r = 0; r < 16; ++r) p1[r] = fmaf(p1[r], C2, mnL);
    for (int r = 0; r < 16; ++r) p0[r] = __builtin_amdgcn_exp2f(p0[r]);
}
__device__ __forceinline__ void finishSM(f32x16& p0, f32x16& p1, float alpha, float& l_reg, bf16x8& pa0, bf16x8& pa1, bf16x8& pa2, bf16x8& pa3) {
    for (int r = 0; r < 16; ++r) p1[r] = __builtin_amdgcn_exp2f(p1[r]);
    float ps = 0; for (int r = 0; r < 16; ++r) ps += p0[r]; for (int r = 0; r < 16; ++r) ps += p1[r];
    { auto rr = __builtin_amdgcn_permlane32_swap(__float_as_uint(ps), __float_as_uint(ps), false, false);
      ps = __uint_as_float(rr[0]) + __uint_as_float(rr[1]); }
    l_reg = l_reg * alpha + ps;
#define PK4(P, B_, OUT) do { unsigned a0 = cvtpk(P[B_+0], P[B_+1]), a1 = cvtpk(P[B_+2], P[B_+3]);                          \
        unsigned b0 = cvtpk(P[B_+4], P[B_+5]), b1 = cvtpk(P[B_+6], P[B_+7]);                                             \
        auto r0 = __builtin_amdgcn_permlane32_swap(a0, b0, false, false); auto r1 = __builtin_amdgcn_permlane32_swap(a1, b1, false, false); \
        u32x4 w = {r0[0], r1[0], r0[1], r1[1]}; OUT = *reinterpret_cast<bf16x8*>(&w); } while (0)
    PK4(p0, 0, pa0); PK4(p0, 8, pa1); PK4(p1, 0, pa2); PK4(p1, 8, pa3);
#undef PK4
}
template <int KB>
__device__ __forceinline__ void qkt(f32x16& p0, f32x16& p1, const char* K_lds, int r32, int hi, const bf16x8* qr, const __attribute__((address_space(3))) char* bp) {
    { unsigned bpa = (unsigned)(uintptr_t)bp; asm volatile("" : "+v"(bpa));
      const __attribute__((address_space(3))) f32x4* b4 = (const __attribute__((address_space(3))) f32x4*)(uintptr_t)bpa;
      const f32x4 x0 = b4[0], x1 = b4[2], x2 = b4[4], x3 = b4[6], y0 = b4[8], y1 = b4[10], y2 = b4[12], y3 = b4[14];
      p0 = (f32x16){x0[0], x0[1], x0[2], x0[3], x1[0], x1[1], x1[2], x1[3], x2[0], x2[1], x2[2], x2[3], x3[0], x3[1], x3[2], x3[3]};
      p1 = (f32x16){y0[0], y0[1], y0[2], y0[3], y1[0], y1[1], y1[2], y1[3], y2[0], y2[1], y2[2], y2[3], y3[0], y3[1], y3[2], y3[3]}; }
    const char* kb[4];
#pragma unroll
    for (int dd = 0; dd < 4; ++dd) kb[dd] = K_lds + KB * SHM_K + KSWZ(r32, (dd * 16 + hi * 8) * 2);
#pragma unroll
    for (int d0 = 0; d0 < 8; ++d0) { const char* a = kb[d0 & 3] + (d0 >> 2) * 128;
        bf16x8 b0 = *reinterpret_cast<const bf16x8*>(a);
        bf16x8 b1 = *reinterpret_cast<const bf16x8*>(a + 32 * 256);
        p0 = __builtin_amdgcn_mfma_f32_32x32x16_bf16(b0, qr[d0], p0, 0, 0, 0);
        p1 = __builtin_amdgcn_mfma_f32_32x32x16_bf16(b1, qr[d0], p1, 0, 0, 0); }
}
template <int VB>
__device__ __forceinline__ void pv_tile(f32x16* o, int vb0, bf16x8 pa0, bf16x8 pa1, bf16x8 pa2, bf16x8 pa3) {
#define TRRD(dst, off) asm volatile("ds_read_b64_tr_b16 %0, %1 offset:%2" : "=&v"(dst) : "v"(vb0), "i"(off) : "memory")
#define PV_D0(d0) do { s16x4 l0, l1, l2, l3, h0, h1, h2, h3; constexpr int b_ = VB * SHM_V + v_rd_off(d0, 0, 0); \
        TRRD(l0, b_); TRRD(h0, b_ + 2048); TRRD(l1, b_ + 4096); TRRD(h1, b_ + 6144); TRRD(l2, b_ + 8192); TRRD(h2, b_ + 10240); TRRD(l3, b_ + 12288); TRRD(h3, b_ + 14336); \
        asm volatile("s_waitcnt lgkmcnt(0)" ::: "memory"); SBAR();   \
        o[d0] = __builtin_amdgcn_mfma_f32_32x32x16_bf16(pa0, (bf16x8){l0[0], l0[1], l0[2], l0[3], h0[0], h0[1], h0[2], h0[3]}, o[d0], 0, 0, 0);   \
        o[d0] = __builtin_amdgcn_mfma_f32_32x32x16_bf16(pa1, (bf16x8){l1[0], l1[1], l1[2], l1[3], h1[0], h1[1], h1[2], h1[3]}, o[d0], 0, 0, 0);   \
        o[d0] = __builtin_amdgcn_mfma_f32_32x32x16_bf16(pa2, (bf16x8){l2[0], l2[1], l2[2], l2[3], h2[0], h2[1], h2[2], h2[3]}, o[d0], 0, 0, 0);   \
        o[d0] = __builtin_amdgcn_mfma_f32_32x32x16_bf16(pa3, (bf16x8){l3[0], l3[1], l3[2], l3[3], h3[0], h3[1], h3[2], h3[3]}, o[d0], 0, 0, 0); } while (0)
    PV_D0(0); PV_D0(1); PV_D0(2); PV_D0(3);
#undef PV_D0
#undef TRRD
}

struct BlockRef { const bf16* Q; const bf16* K; const bf16* V; bf16* O; int P0; int bh; };
struct Seam { bf16x8 qr[8]; bf16x8 st_v0, st_v1, st_k0, st_k1; };
#define ROW(p, k0, rr) ((const bf16*)((const char*)((p) + (size_t)(k0) * D) + (unsigned)(((rr) * D + sc) * 2)))
#define VMW() asm volatile("s_waitcnt vmcnt(0)" ::: "memory")
#define VMWN(n) asm volatile("s_waitcnt vmcnt(%0)" :: "i"(n) : "memory")
#define SLOAD_H(Kp, Vp, k0) do { S.st_v0 = load8(ROW(Vp, k0, sr)); S.st_v1 = load8(ROW(Vp, k0, 32 + sr));              \
                         S.st_k0 = load8(ROW(Kp, k0, sr)); S.st_k1 = load8(ROW(Kp, k0, 32 + sr)); } while (0)
#define SWRITE_HK(bf) do { *(bf16x8*)(K_lds + (bf) * SHM_K + kws) = S.st_k0; *(bf16x8*)(K_lds + (bf) * SHM_K + kws + 32 * 256) = S.st_k1; } while (0)
#define SWRITE_HV(bf) do { *(bf16x8*)(V_lds + (bf) * SHM_V + vst0) = S.st_v0; *(bf16x8*)(V_lds + (bf) * SHM_V + vst1) = S.st_v1; } while (0)
#define SWRITE_H(bf) do { SWRITE_HV(bf); SWRITE_HK(bf); } while (0)
__device__ __forceinline__ void attn_prime(const BlockRef& cur, char* lds, Seam& S, const int wave) {
    int tid_raw_ = MK_TID(); asm volatile("" : "+v"(tid_raw_)); const int tid = tid_raw_, wid = __builtin_amdgcn_readfirstlane(tid >> 6), lane = tid & 63, r32 = lane & 31, hi = lane >> 5;
    const int sr = tid >> 4, sc = (tid & 15) * 8, kws = KSWZ(sr, sc * 2); char* K_lds = lds + 2 * SHM_V;
    for (int d0 = 0; d0 < 8; ++d0) S.qr[d0] = load8((const bf16*)((const char*)(cur.Q + (size_t)(wid * QBLK) * D) + (unsigned)((r32 * D + hi * 8) * 2)) + d0 * 16);
    SLOAD_H(cur.K, cur.V, 0); VMW(); SWRITE_HK(0);
    __syncthreads();
}
template <bool MOBA>
__device__ __forceinline__ void attn_block(const BlockRef& cur, const BlockRef& nxt, char* lds, Seam& S, const float* __restrict__ biasG  , const unsigned* __restrict__ selG  , const int wave) {
    int tid_raw_ = MK_TID(); asm volatile("" : "+v"(tid_raw_)); const int tid = tid_raw_, wid = __builtin_amdgcn_readfirstlane(tid >> 6), lane = tid & 63, r32 = lane & 31, hi = lane >> 5;
    const int NT = (cur.P0 + QB) / KVBLK;
    const int qlo = cur.P0 + wid * QBLK, qm = qlo + r32 - 4 * hi;
    char* V_lds = lds; char* K_lds = lds + 2 * SHM_V;
    float* ws = (float*)(lds + LDS_WS) + wid * 64; float* li_l = ws, * al_l = ws + 32;
    float* biasL = (float*)(lds + LDS_BIAS); float* negL = (float*)(lds + LDS_NEG);
    unsigned selmask = 0u; const int own = cur.P0 >> 8;
    { int te = tid; asm volatile("" : "+v"(te));
      if (te < 64) negL[te] = -__builtin_inff();
      *(f32x4*)(biasL + 4 * te) = *(const f32x4*)(biasG + (size_t)cur.bh * SEQ + 4 * te);
      if (MOBA) selmask = selG[(size_t)cur.bh * SEQ + cur.P0 + (te >> 6) * QBLK + (te & 31)]; }
    __syncthreads();
    typedef const __attribute__((address_space(3))) char* lcp; const lcp bias_b = (lcp)((const char*)biasL) + 16 * hi; const lcp neg_b = (lcp)((const char*)negL) + 16 * hi;
    float m_reg = -1e30f, l_reg = 0; f32x16 o[4] = {};
    const int sr = tid >> 4, sc = (tid & 15) * 8, vst0 = v_st(sr, sc), vst1 = v_st(32 + sr, sc), kws = KSWZ(sr, sc * 2);
    const int vb0 = (int)(uintptr_t)V_lds + v_rd_base(lane);
    const bf16* Kh = cur.K; const bf16* Vh = cur.V;
#define RESC(a) do { if (__any((a) < 1.f)) { if (hi == 0) al_l[r32] = (a); asm volatile("s_waitcnt lgkmcnt(0)" ::: "memory");              \
                     for (int d_ = 0; d_ < 4; ++d_) for (int r = 0; r < 16; ++r) o[d_][r] *= al_l[crow(r, hi)]; } } while (0)
#define KBASE(t) ((t) * KVBLK)
#define BP(t) ((!MOBA || (KBASE(t) >> 8) >= own || ((selmask >> (KBASE(t) >> 8)) & 1u)) ? (bias_b + KBASE(t) * 4) : neg_b)
#define MASKT(P0_, P1_, t) do { const int kb_ = KBASE(t); if (kb_ + KVBLK - 1 > qlo) mask_tile(P0_, P1_, qm - kb_); } while (0)
#define SEAM_K0() do { VMWN(8); SWRITE_HK(0); SBAR(); } while (0)
    f32x16 pA0, pA1, pB0, pB1; float mnA, mnB, alA, alB; bf16x8 pa0, pa1, pa2, pa3;
    SWRITE_HV(0); SBAR();
    SLOAD_H(Kh, Vh, KBASE(1));
    SBAR(); qkt<0>(pA0, pA1, K_lds, r32, hi, S.qr, BP(0));
    MASKT(pA0, pA1, 0); partialSM(pA0, pA1, m_reg, mnA, alA);
    VMW(); SWRITE_H(1);
    __syncthreads();
#define HALF_STEP(PX0, PX1, mnX, alX, PY0, PY1, alY, t, KB, VB, SB) do {                                                      \
        SBAR(); qkt<KB>(PX0, PX1, K_lds, r32, hi, S.qr, BP(t));                                                               \
        finishSM(PY0, PY1, alY, l_reg, pa0, pa1, pa2, pa3); SBAR();                                                           \
        if ((t) + 1 < NT) { SLOAD_H(Kh, Vh, KBASE((t) + 1)); SBAR(); }                                                        \
        pv_tile<VB>(o, vb0, pa0, pa1, pa2, pa3); MASKT(PX0, PX1, (t)); partialSM(PX0, PX1, m_reg, mnX, alX);                  \
        __syncthreads();                                                                                                      \
        if ((t) + 1 < NT) { VMW(); SWRITE_H(SB); }                                                                            \
        RESC(alX); __syncthreads(); } while (0)
    for (int t = 1; t + 1 < NT; t += 2) {
        HALF_STEP(pB0, pB1, mnB, alB, pA0, pA1, alA, t, 1, 0, 0);
        HALF_STEP(pA0, pA1, mnA, alA, pB0, pB1, alB, t + 1, 0, 1, 1);
    }
    { SBAR(); qkt<1>(pB0, pB1, K_lds, r32, hi, S.qr, BP(NT - 1)); SBAR(); }
    SLOAD_H(nxt.K, nxt.V, 0); SBAR();
    { int lq = lane; asm volatile("" : "+v"(lq));
#pragma unroll
    for (int d0 = 0; d0 < 8; ++d0) S.qr[d0] = load8((const bf16*)((const char*)(nxt.Q + (size_t)(wid * QBLK) * D) + (unsigned)(((lq & 31) * D + (lq >> 5) * 8) * 2)) + d0 * 16); }
    SBAR();
    finishSM(pA0, pA1, alA, l_reg, pa0, pa1, pa2, pa3); SBAR();
    pv_tile<0>(o, vb0, pa0, pa1, pa2, pa3);
    { MASKT(pB0, pB1, NT - 1); partialSM(pB0, pB1, m_reg, mnB, alB); __syncthreads(); RESC(alB);
      finishSM(pB0, pB1, alB, l_reg, pa0, pa1, pa2, pa3); SBAR(); pv_tile<1>(o, vb0, pa0, pa1, pa2, pa3); }
    SBAR(); SEAM_K0();
    { int le = lane; asm volatile("" : "+v"(le)); const int r32e = le & 31, hie = le >> 5;
    if (hie == 0) li_l[r32e] = l_reg; asm volatile("s_waitcnt lgkmcnt(0)" ::: "memory");
    float rli[16];
#pragma unroll
    for (int r = 0; r < 16; ++r) rli[r] = __builtin_amdgcn_rcpf(li_l[crow(r, hie)]);
    bf16* Ow = cur.O + (size_t)(wid * QBLK) * OS;
#pragma unroll
    for (int r = 0; r < 16; ++r) { const int orow = crow(r, hie);
#pragma unroll
        for (int d0 = 0; d0 < 4; ++d0) { const float v = o[d0][r] * rli[r];
            const float vn = __uint_as_float(__builtin_amdgcn_mov_dpp(__float_as_uint(v), 0xB1, 0xF, 0xF, true));
            if ((r32e & 1) == 0) *(unsigned*)(Ow + (size_t)orow * OS + d0 * 32 + r32e) = cvtpk(v, vn); } } }
    __syncthreads();
#undef RESC
#undef KBASE
#undef BP
#undef MASKT
#undef SEAM_K0
#undef HALF_STEP
}
#undef ROW
#undef VMW
#undef VMWN
#undef SLOAD_H
#undef SWRITE_HK
#undef SWRITE_HV
#undef SWRITE_H

template <bool MOBA>
__device__ __forceinline__ void attn_phase(char* lds, const bf16* Q, const bf16* K, const bf16* V, bf16* O, const float* biasG, const unsigned* selG, const int wave) {
    const int G = gridDim.x; int idx = blockIdx.x; if (idx >= 256) return;
    auto ref = [&](int id, int pass) { const int xcd = id & 7, k = id >> 3, bh = xcd * 8 + (k >> 2), y = k & 3, qb = pass ? 7 - y : y, b = bh >> 4, h = bh & 15;
        BlockRef r; r.Q = Q + ((size_t)bh * SEQ + (size_t)qb * QB) * D; r.K = K + (size_t)bh * SEQ * D; r.V = V + (size_t)bh * SEQ * D;
        r.O = O + ((size_t)b * SEQ + (size_t)qb * QB) * OS + h * D; r.P0 = qb * QB; r.bh = bh; return r; };
    int pass = 0; BlockRef cur = ref(idx, 0);
    Seam S;
    attn_prime(cur, lds, S, wave);
    for (;;) {
        const bool more_pass = pass == 0, more_item = idx + G < 256, last = !more_pass && !more_item;
        int idn = idx, passn = pass + 1; if (!more_pass) { passn = 0; idn = more_item ? idx + G : idx; }
        const BlockRef nxt = last ? cur : ref(idn, passn);
        attn_block<MOBA>(cur, nxt, lds, S, biasG, selG, wave);
        if (last) break;
        cur = nxt; idx = idn; pass = passn;
    }
}
}
constexpr int NWAVES = 8;
constexpr int BATCH = 4, SEQ = 2048, DM = 2048, M = BATCH * SEQ, FF = 5632, NH = 16, HD = 128, PLE = 256, DEPTH = 4;
constexpr size_t MiB = 1u << 20;
constexpr size_t WS_CTL = 0, CTL_ZERO_BYTES = 1 * MiB;
constexpr size_t WS_WFI = 1 * MiB;
constexpr size_t WS_WFO = WS_WFI + 352 * MiB;
constexpr size_t WS_WPG = WS_WFO + 176 * MiB;
constexpr size_t WS_WPP = WS_WPG + 32 * MiB;
constexpr size_t WS_WQKV = WS_WPP + 4 * MiB;
constexpr size_t WS_WO = WS_WQKV + 72 * MiB;
constexpr size_t WS_WS5I = WS_WO + 24 * MiB;
constexpr size_t WS_WGLU = WS_WS5I + 8 * MiB;
constexpr size_t WS_S5TV = WS_WGLU + 16 * MiB;
constexpr size_t WS_S5W = WS_S5TV + 80 * MiB;
constexpr size_t WS_WFT = WS_S5W + 32 * MiB;
constexpr size_t WS_H = WS_WFT + 1 * MiB;
constexpr size_t WS_HB = WS_H + 64 * MiB;
constexpr size_t WS_ACT = WS_HB + 32 * MiB;
constexpr size_t WS_QKV = WS_ACT + 88 * MiB;
constexpr size_t WS_OB = WS_QKV + 96 * MiB;
constexpr size_t WS_SSQ = WS_OB + 32 * MiB;
constexpr size_t WS_PP = WS_SSQ + 1 * MiB;
constexpr size_t WS_PBF = WS_PP + 128 * MiB;
constexpr size_t WS_LOGF = WS_PBF + 16 * MiB;
constexpr size_t WS_KMEAN = WS_LOGF + 1 * MiB;
constexpr size_t WS_UH = WS_KMEAN + 1 * MiB;
constexpr size_t WS_HLOC = WS_UH + 40 * MiB;
constexpr size_t WS_YB = WS_HLOC + 16 * MiB;
constexpr size_t WS_HB2 = WS_YB + 32 * MiB;
constexpr size_t WS_H2 = WS_HB2 + 32 * MiB;
constexpr size_t WS_BIAS = WS_H2 + 64 * MiB;
constexpr size_t WS_SEL = WS_BIAS + 1 * MiB;
constexpr size_t WS_END = WS_SEL + 1 * MiB;
constexpr int CW_BAR = 4096;
constexpr int RING_OFF = 0, RING_BYTES = 131072, EPI_OFF = 131072, LDSCTL_OFF = 139264, MISC_OFF = LDSCTL_OFF + 320, LDS_BYTES = 147456;
static_assert(att::LDS_BYTES <= RING_BYTES && pg8::EPI_LDS_OFF == EPI_OFF, "LDS map");

#define GAS __attribute__((address_space(1)))
#define LAS __attribute__((address_space(3)))
typedef unsigned short bf16;
typedef unsigned v4u __attribute__((ext_vector_type(4)));
typedef unsigned v2u __attribute__((ext_vector_type(2)));
typedef float f32x4 __attribute__((ext_vector_type(4)));
typedef float f32x2 __attribute__((ext_vector_type(2)));
typedef GAS unsigned gu32;
#define RLX_AGENT __ATOMIC_RELAXED, __HIP_MEMORY_SCOPE_AGENT
#define LDS_WAIT() asm volatile("s_waitcnt lgkmcnt(0)" ::: "memory")
#define VM_WAIT() asm volatile("s_waitcnt vmcnt(0)" ::: "memory")
__device__ __forceinline__ unsigned f2bf(float f) { unsigned u = __builtin_bit_cast(unsigned, f); return (u + 0x7fffu + ((u >> 16) & 1u)) >> 16; }
__device__ __forceinline__ unsigned pk2(float lo, float hi) { return f2bf(lo) | (f2bf(hi) << 16); }
__device__ __forceinline__ float wave_sum(float v) {
#pragma unroll
    for (int o = 1; o < 64; o <<= 1) v += __shfl_xor(v, o);
    return v;
}

#define XB_TMO      128
#define XB_XCNT(j)  (256  + 64 * (j))
#define XB_XSUB(j)  (1280 + 64 * (j))
#define XB_XGEN(j)  (2304 + 64 * (j))
#define XB_TOP      3328
#define XB_TOPGEN   3392
#define XCD_BAR_WORDS 3456
#define XB_SPIN_CAP (1u << 18)

__device__ __forceinline__ unsigned xb_ld(unsigned* p)              { return __hip_atomic_load(p, __ATOMIC_RELAXED, __HIP_MEMORY_SCOPE_AGENT); }
__device__ __forceinline__ unsigned xb_add(unsigned* p, unsigned v) { return __hip_atomic_fetch_add(p, v, __ATOMIC_RELAXED, __HIP_MEMORY_SCOPE_AGENT); }
__device__ __forceinline__ unsigned xb_xcc_id() { return (unsigned)__builtin_amdgcn_s_getreg((3 << 11) | 20) & 0xFu; }
#define XB_SPIN(cond, bar) do { unsigned _sp = 0; while (cond) { __builtin_amdgcn_s_sleep(1); \
    if ((++_sp & 255u) == 0u) { if (xb_ld(&(bar)[XB_TMO])) break; if (_sp > XB_SPIN_CAP) { atomicAdd(&(bar)[XB_TMO], 1u); break; } } } } while (0)

struct XcdBarrier {
    unsigned* bar; unsigned x;
    volatile LAS unsigned* st;
};

__device__ __forceinline__ XcdBarrier xcd_barrier_post(unsigned* bar, volatile LAS unsigned* st, int wave) {
    XcdBarrier b; b.bar = bar; b.x = xb_xcc_id(); b.st = st;
    if (XB_TID == 0) (void)xb_add(&bar[XB_XCNT(b.x)], 1u);
    return b;
}
__device__ __forceinline__ void xcd_barrier_complete(unsigned* bar, unsigned x, unsigned& nloc, unsigned& nx) {
    const unsigned G = gridDim.x * gridDim.y * gridDim.z;
    unsigned sum, cnt, mine, sp = 0u;
    for (;;) {
        sum = 0u; cnt = 0u; mine = 0u;
#pragma unroll
        for (unsigned j = 0; j < 16; ++j) { const unsigned c = xb_ld(&bar[XB_XCNT(j)]); sum += c; cnt += (c > 0u) ? 1u : 0u; mine = (j == x) ? c : mine; }
        if (sum == G) break;
        __builtin_amdgcn_s_sleep(1);
        if ((++sp & 255u) == 0u) { if (xb_ld(&bar[XB_TMO])) break; if (sp > XB_SPIN_CAP) { atomicAdd(&bar[XB_TMO], 1u); break; } }
    }
    nloc = mine > 0u ? mine : 1u; nx = cnt > 0u ? cnt : 1u;
}

__device__ __forceinline__ void xcd_barrier(const XcdBarrier& b, int wave) {
    asm volatile("s_waitcnt vmcnt(0)" ::: "memory");
    __syncthreads();
    if (XB_TID == 0) {
        unsigned* bar = b.bar;
        __builtin_amdgcn_s_waitcnt(0);
        unsigned nloc = b.st[0], nx = b.st[1];
        if (nloc == 0u) { xcd_barrier_complete(bar, b.x, nloc, nx); b.st[0] = nloc; b.st[1] = nx; }
        const unsigned old = xb_add(&bar[XB_XSUB(b.x)], 1u);
        const unsigned gen = old / nloc;
        if (old + 1u == (gen + 1u) * nloc) {
            __builtin_amdgcn_fence(__ATOMIC_RELEASE, "agent");
            asm volatile("s_waitcnt vmcnt(0)" ::: "memory");
            const unsigned og = xb_add(&bar[XB_TOP], 1u);
            const unsigned tg = og / nx;
            if (og + 1u == (tg + 1u) * nx) xb_add(&bar[XB_TOPGEN], 1u);
            else XB_SPIN(xb_ld(&bar[XB_TOPGEN]) == tg, bar);
            __builtin_amdgcn_fence(__ATOMIC_ACQUIRE, "agent");
            xb_add(&bar[XB_XGEN(b.x)], 1u);
            asm volatile("s_waitcnt vmcnt(0)" ::: "memory");
        } else {
            XB_SPIN(xb_ld(&bar[XB_XGEN(b.x)]) == gen, bar);
            __builtin_amdgcn_fence(__ATOMIC_ACQUIRE, "agent");
            asm volatile("s_waitcnt vmcnt(0)" ::: "memory");
        }
    }
    __syncthreads();
}

struct Args { const float* in[23]; float* out; unsigned char* ws; int ph_lo, ph_hi; };

__device__ __forceinline__ void tr_item(const float* __restrict__ src, int ld, int K, bf16* __restrict__ dst, const float* __restrict__ scale, int n0, int k0, int drow0, LAS float* scr, int lane) {
    const int kr = lane >> 4, n4 = lane & 15;
    f32x4 v[16];
#pragma unroll
    for (int i = 0; i < 16; ++i) v[i] = __builtin_nontemporal_load((const f32x4*)(src + (size_t)(k0 + 4 * i + kr) * ld + n0 + 4 * n4));
#pragma unroll
    for (int i = 0; i < 16; ++i) { LAS float* p = scr + (4 * i + kr) * 65 + 4 * n4; p[0] = v[i][0]; p[1] = v[i][1]; p[2] = v[i][2]; p[3] = v[i][3]; }
    LDS_WAIT(); asm volatile("" ::: "memory");
    const int c = lane & 7, nn = lane >> 3;
    f32x4 s0 = (f32x4){1.f, 1.f, 1.f, 1.f}, s1 = s0;
    if (scale) { s0 = *(const f32x4*)(scale + k0 + 8 * c); s1 = *(const f32x4*)(scale + k0 + 8 * c + 4); }
#pragma unroll
    for (int j = 0; j < 8; ++j) { const int n = nn + 8 * j; const LAS float* s = scr + (8 * c) * 65 + n;
        v4u o; o.x = pk2(s[0 * 65] * s0[0], s[1 * 65] * s0[1]); o.y = pk2(s[2 * 65] * s0[2], s[3 * 65] * s0[3]); o.z = pk2(s[4 * 65] * s1[0], s[5 * 65] * s1[1]); o.w = pk2(s[6 * 65] * s1[2], s[7 * 65] * s1[3]);
        __builtin_nontemporal_store(o, (v4u*)(dst + (size_t)(drow0 + n) * K + k0 + 8 * c)); }
    LDS_WAIT(); asm volatile("" ::: "memory");
}
__device__ __forceinline__ void tr_job(const float* src, int ld, int K, int N, bf16* dst, const float* scale, int ilv, int r, LAS float* scr, int lane) {
    const int nb = N / 64, kb = r / nb, nbi = r % nb, n0 = nbi * 64;
    int drow0 = n0;
    if (ilv) { const int hsel = n0 >= ilv ? 1 : 0, nn = n0 - hsel * ilv; drow0 = (nn >> 7) * 256 + hsel * 128 + (nn & 127); }
    tr_item(src, ld, K, dst, scale, n0, kb * 64, drow0, scr, lane);
}

__device__ __forceinline__ void s5_ops_group(const Args& a, int g, LAS float* L, int tid) {
    const float* a_re = a.in[14]; const float* a_im = a.in[15]; const float* log_dt = a.in[16]; const float* b_re = a.in[17]; const float* b_im = a.in[18];
    const float* c_re = a.in[19]; const float* c_im = a.in[20]; const float* dsk = a.in[21];
    LAS float* apr = L; LAS float* api = L + 2112; LAS float* qr = L + 4224; LAS float* qi = qr + 64; LAS float* Cr = qi + 64; LAS float* Ci = Cr + 1024;
    LAS float* Br = Ci + 1024; LAS float* Bi = Br + 1024; LAS float* Kt = Bi + 1024;
    bf16* TV = (bf16*)(a.ws + WS_S5TV) + (size_t)g * 512 * 640; bf16* W = (bf16*)(a.ws + WS_S5W) + (size_t)g * 256 * 512;
    const float dt = expf(log_dt[g]);
    for (int idx = tid; idx < 33 * 64; idx += 512) { const int tau = idx >> 6, p = idx & 63; const float ar = a_re[g * 64 + p], ai = a_im[g * 64 + p];
        const float mag = expf(ar * dt * (float)tau); float sn, cs; sincosf(ai * dt * (float)tau, &sn, &cs); apr[idx] = mag * cs; api[idx] = mag * sn; }
    if (tid < 64) { const float ar = a_re[g * 64 + tid], ai = a_im[g * 64 + tid]; const float er = expf(ar * dt); float sn, cs; sincosf(ai * dt, &sn, &cs);
        const float nr = er * cs - 1.f, ni = er * sn, den = ar * ar + ai * ai; qr[tid] = (nr * ar + ni * ai) / den; qi[tid] = (ni * ar - nr * ai) / den; }
    for (int idx = tid; idx < 1024; idx += 512) { Cr[idx] = c_re[(size_t)g * 1024 + idx]; Ci[idx] = c_im[(size_t)g * 1024 + idx]; }
    __syncthreads();
    for (int idx = tid; idx < 1024; idx += 512) { const int p = idx >> 4; const float br = b_re[(size_t)g * 1024 + idx], bi = b_im[(size_t)g * 1024 + idx];
        Br[idx] = qr[p] * br - qi[p] * bi; Bi[idx] = qr[p] * bi + qi[p] * br; }
    __syncthreads();
    for (int idx = tid; idx < 32 * 256; idx += 512) { const int tau = idx >> 8, c = (idx >> 4) & 15, cp = idx & 15; float s = 0.f;
        for (int p = 0; p < 64; ++p) { const float ar_ = apr[tau * 64 + p], ai_ = api[tau * 64 + p], br = Br[p * 16 + cp], bi = Bi[p * 16 + cp];
            const float xr = ar_ * br - ai_ * bi, xi = ar_ * bi + ai_ * br; s += Cr[c * 64 + p] * xr - Ci[c * 64 + p] * xi; }
        if (tau == 0 && c == cp) s += dsk[g * 16 + c];
        Kt[idx] = s; }
    __syncthreads();
    for (int idx = tid; idx < 512 * 80; idx += 512) { const int n = idx / 80, ch = idx % 80, j = n >> 4, c = n & 15; float o[8];
        if (ch < 64) { const int jp = ch >> 1, c0 = (ch & 1) * 8;
#pragma unroll
            for (int e = 0; e < 8; ++e) o[e] = (jp <= j) ? Kt[(j - jp) * 256 + c * 16 + c0 + e] : 0.f; }
        else { const int p0 = (ch - 64) * 4;
#pragma unroll
            for (int e = 0; e < 4; ++e) { const int p = p0 + e; const float ar_ = apr[(j + 1) * 64 + p], ai_ = api[(j + 1) * 64 + p], cr = Cr[c * 64 + p], ci = Ci[c * 64 + p];
                o[2 * e] = cr * ar_ - ci * ai_; o[2 * e + 1] = -(cr * ai_ + ci * ar_); } }
        v4u w; w.x = pk2(o[0], o[1]); w.y = pk2(o[2], o[3]); w.z = pk2(o[4], o[5]); w.w = pk2(o[6], o[7]);
        *(v4u*)(TV + (size_t)n * 640 + ch * 8) = w; }
    for (int idx = tid; idx < 128 * 64; idx += 512) { const int n = idx >> 6, ch = idx & 63, p = n >> 1, ri = n & 1, jp = ch >> 1, c0 = (ch & 1) * 8; float o[8];
        const float ar_ = apr[(31 - jp) * 64 + p], ai_ = api[(31 - jp) * 64 + p];
#pragma unroll
        for (int e = 0; e < 8; ++e) { const float br = Br[p * 16 + c0 + e], bi = Bi[p * 16 + c0 + e]; o[e] = ri ? (ar_ * bi + ai_ * br) : (ar_ * br - ai_ * bi); }
        v4u w; w.x = pk2(o[0], o[1]); w.y = pk2(o[2], o[3]); w.z = pk2(o[4], o[5]); w.w = pk2(o[6], o[7]);
        *(v4u*)(W + (size_t)n * 512 + ch * 8) = w; }
    __syncthreads();
}

namespace cv {
constexpr int I_FI = 32 * 176, I_FO = 88 * 32, I_PG = 32 * 32, I_QKV = 32 * 96, I_WO = 32 * 32, I_S5I = 32 * 32, I_GLU = 32 * 64, I_WF = 16;
constexpr int mix_items(int L) { return (L % 3 == 0) ? I_QKV + I_WO + I_WF : ((L % 3 == 1) ? I_QKV + I_WO : I_S5I + I_GLU); }
constexpr int layer_items(int L) { return 2 * I_FI + 2 * I_FO + I_PG + mix_items(L); }
constexpr int layer_start(int L) { int s = 0; for (int l = 0; l < L; ++l) s += layer_items(l); return s; }
constexpr int TOTAL = layer_start(4);
constexpr int pos_after(int L, int h) { return layer_start(L) + I_FI + (h ? I_FO + mix_items(L) + I_FI : 0); }
#ifndef MK_TAILQ
#define MK_TAILQ 7
#endif
constexpr int TAIL_WAVES = 128 * NWAVES, QTOT = MK_TAILQ * TAIL_WAVES;
constexpr int tail_b(int k) { int hi = TOTAL; for (int j = 7; j > k; --j) { const int pa = pos_after(j >> 1, j & 1); const int a = (hi - QTOT > pa) ? hi - QTOT : pa; hi = a < hi ? a : hi; } return hi; }
constexpr int tail_a(int k) { const int hi = tail_b(k), pa = pos_after(k >> 1, k & 1); const int a = (hi - QTOT > pa) ? hi - QTOT : pa; return a < hi ? a : hi; }
}
__device__ __forceinline__ void cv_item(const Args& a, int idx, LAS float* scr, int lane) {
    using namespace cv;
    const float* norm_g = a.in[2]; unsigned char* ws = a.ws;
    const int L = idx >= layer_start(3) ? 3 : (idx >= layer_start(2) ? 2 : (idx >= layer_start(1) ? 1 : 0));
    int r = idx - (L == 3 ? layer_start(3) : (L == 2 ? layer_start(2) : (L == 1 ? layer_start(1) : 0)));
    const int kind = L % 3, mixn = kind == 0 ? I_QKV + I_WO + I_WF : (kind == 1 ? I_QKV + I_WO : I_S5I + I_GLU);
    int half = 0;
    if (r >= I_FI + I_FO + mixn) { r -= I_FI + I_FO + mixn; half = 1; if (r >= I_FI + I_FO) {
            r -= I_FI + I_FO; tr_job(a.in[6] + (size_t)L * DM * DM, DM, DM, DM, (bf16*)(ws + WS_WPG) + (size_t)L * DM * DM, norm_g + (L * 4 + 3) * DM, 0, r, scr, lane); return; } }
    else if (r >= I_FI + I_FO) { r -= I_FI + I_FO;
        if (kind < 2) { const int m = L == 0 ? 0 : (L == 1 ? 1 : 2);
            if (r < I_QKV) { const float* src = m == 1 ? a.in[11] : a.in[8] + (size_t)(m >> 1) * DM * (3 * DM + NH); const int ld = m == 1 ? 3 * DM : 3 * DM + NH;
                tr_job(src, ld, DM, 3 * DM, (bf16*)(ws + WS_WQKV) + (size_t)m * 3 * DM * DM, norm_g + (L * 4 + 1) * DM, 0, r, scr, lane); return; } r -= I_QKV;
            if (r < I_WO) { const float* src = m == 1 ? a.in[12] : a.in[10] + (size_t)(m >> 1) * DM * DM;
                tr_job(src, DM, DM, DM, (bf16*)(ws + WS_WO) + (size_t)m * DM * DM, nullptr, 0, r, scr, lane); return; } r -= I_WO;
            {
                const int j = m >> 1, hd = r; const float* src = a.in[8] + (size_t)j * DM * (3 * DM + NH) + 3 * DM + hd; const float* g1 = norm_g + (L * 4 + 1) * DM;
                float* dst = (float*)(ws + WS_WFT) + (size_t)(j * 16 + hd) * DM;
                for (int k = lane; k < DM; k += 64) dst[k] = g1[k] * src[(size_t)k * (3 * DM + NH)];
                return; } }
        if (r < I_S5I) { tr_job(a.in[13], DM, DM, DM, (bf16*)(ws + WS_WS5I), norm_g + (2 * 4 + 1) * DM, 0, r, scr, lane); return; } r -= I_S5I;
        tr_job(a.in[22], 2 * DM, DM, 2 * DM, (bf16*)(ws + WS_WGLU), nullptr, DM, r, scr, lane); return; }
    const int m = L * 2 + half;
    if (r < I_FI) { tr_job(a.in[4] + (size_t)m * DM * 2 * FF, 2 * FF, DM, 2 * FF, (bf16*)(ws + WS_WFI) + (size_t)m * 2 * FF * DM, norm_g + (L * 4 + half * 2) * DM, FF, r, scr, lane); return; }
    r -= I_FI;
    tr_job(a.in[5] + (size_t)m * FF * DM, DM, FF, DM, (bf16*)(ws + WS_WFO) + (size_t)m * DM * FF, nullptr, 0, r, scr, lane);
}
__device__ __forceinline__ void cv_tail(const Args& a, int k, LAS unsigned char* lds, int lane, int wave, int bx, int G) {
    if (G != 256 || bx < 128) return;
    int lo_ = 0, hi_ = 0;
    switch (k) { case 0: lo_ = cv::tail_a(0); hi_ = cv::tail_b(0); break; case 1: lo_ = cv::tail_a(1); hi_ = cv::tail_b(1); break; case 2: lo_ = cv::tail_a(2); hi_ = cv::tail_b(2); break;
                 case 3: lo_ = cv::tail_a(3); hi_ = cv::tail_b(3); break; case 4: lo_ = cv::tail_a(4); hi_ = cv::tail_b(4); break; case 5: lo_ = cv::tail_a(5); hi_ = cv::tail_b(5); break;
                 case 6: lo_ = cv::tail_a(6); hi_ = cv::tail_b(6); break; default: lo_ = cv::tail_a(7); hi_ = cv::tail_b(7); break; }
    LAS float* scr = (LAS float*)(lds + wave * 16640);
    for (int it = lo_ + (bx - 128) * NWAVES + wave; it < hi_; it += cv::TAIL_WAVES) cv_item(a, it, scr, lane);
}
__device__ __forceinline__ void p0_prologue(const Args& a, LAS unsigned char* lds, int tid, int lane, int wave, int vcu, int G) {
    const float* x = a.in[0]; const float* p = a.in[1];
    unsigned char* ws = a.ws;
    for (int g = vcu; g < 128; g += G) s5_ops_group(a, g, (LAS float*)lds, tid);
    LAS float* scr = (LAS float*)(lds + wave * 16640);
    const int gw = vcu * NWAVES + wave, NGW = G * NWAVES;
    constexpr int I_PPJ = 4 * 32, I_X = M, I_P = 4 * M * PLE / 512;
    const int n_cv = (G == 256) ? cv::tail_a(0) : cv::TOTAL;
    const int NITEMS = n_cv + 4 * I_PPJ + I_X + I_P;
    for (int it = gw; it < NITEMS; it += NGW) {
        int r = it;
        if (r < n_cv) { cv_item(a, r, scr, lane); continue; } r -= n_cv;
        if (r < 4 * I_PPJ) { const int m = r / I_PPJ;
            tr_job(a.in[7] + (size_t)m * PLE * DM, DM, PLE, DM, (bf16*)(ws + WS_WPP) + (size_t)m * DM * PLE, nullptr, 0, r % I_PPJ, scr, lane); continue; } r -= 4 * I_PPJ;
        if (r < I_X) {
            const f32x4* xr = (const f32x4*)(x + (size_t)r * DM) + lane; f32x4 v[8]; float s = 0.f;
#pragma unroll
            for (int j = 0; j < 8; ++j) { v[j] = xr[64 * j]; s += (v[j][0] * v[j][0] + v[j][1] * v[j][1]) + (v[j][2] * v[j][2] + v[j][3] * v[j][3]); }
            s = wave_sum(s);
            v2u* o = (v2u*)((bf16*)(ws + WS_HB) + (size_t)r * DM) + lane;
#pragma unroll
            for (int j = 0; j < 8; ++j) { v2u w; w.x = pk2(v[j][0], v[j][1]); w.y = pk2(v[j][2], v[j][3]); o[64 * j] = w; }
            if (lane < 4) ((f32x4*)((float*)(ws + WS_SSQ) + (size_t)r * 16))[lane] = (f32x4){lane == 0 ? s : 0.f, 0.f, 0.f, 0.f};
            continue; } r -= I_X;
        {
            const f32x4* src = (const f32x4*)(p + (size_t)r * 512) + 2 * lane; const f32x4 v0 = src[0], v1 = src[1];
            v4u w; w.x = pk2(v0[0], v0[1]); w.y = pk2(v0[2], v0[3]); w.z = pk2(v1[0], v1[1]); w.w = pk2(v1[2], v1[3]);
            ((v4u*)((bf16*)(ws + WS_PBF) + (size_t)r * 512))[lane] = w; }
    }
}

__device__ __forceinline__ void fox_gate_phase(const bf16* Hb, const float* WfT, const float* bfv, float* logf, int lane, int gw, int NGW) {
    for (int task = gw; task < M / 4; task += NGW) {
        const int r0 = task * 4;
        float xv[4][32]; float ss[4];
#pragma unroll
        for (int rr = 0; rr < 4; ++rr) { const v4u* xr = (const v4u*)(Hb + (size_t)(r0 + rr) * DM) + lane; float s = 0.f;
#pragma unroll
            for (int j = 0; j < 4; ++j) { const v4u w = xr[64 * j];
#pragma unroll
                for (int e = 0; e < 8; ++e) { const unsigned ww = w[e >> 1]; const float x = __uint_as_float((e & 1) ? (ww & 0xffff0000u) : (ww << 16)); xv[rr][j * 8 + e] = x; s = fmaf(x, x, s); } }
            ss[rr] = wave_sum(s); }
        float res[4] = {0.f, 0.f, 0.f, 0.f};
#pragma unroll 1
        for (int hd = 0; hd < 16; ++hd) { const f32x4* wr_ = (const f32x4*)(WfT + (size_t)hd * DM) + 2 * lane; float d[4] = {0.f, 0.f, 0.f, 0.f};
#pragma unroll
            for (int j = 0; j < 4; ++j) { const f32x4 w0 = wr_[128 * j], w1 = wr_[128 * j + 1];
#pragma unroll
                for (int rr = 0; rr < 4; ++rr) {
#pragma unroll
                    for (int e = 0; e < 4; ++e) { d[rr] = fmaf(xv[rr][j * 8 + e], w0[e], d[rr]); d[rr] = fmaf(xv[rr][j * 8 + 4 + e], w1[e], d[rr]); } } }
#pragma unroll
            for (int rr = 0; rr < 4; ++rr) { const float t = wave_sum(d[rr]); if (lane == hd) res[rr] = t; } }
        if (lane < 16) { const float bb = bfv[lane];
#pragma unroll
            for (int rr = 0; rr < 4; ++rr) { const int r = r0 + rr, b = r >> 11, s = r & 2047; const float rstd = 1.0f / sqrtf(ss[rr] * (1.0f / DM) + 1e-6f);
                const float xg = res[rr] * rstd + bb; logf[(size_t)(b * 16 + lane) * SEQ + s] = fminf(xg, 0.f) - log1pf(expf(-fabsf(xg))); } }
    }
}
__device__ __forceinline__ void moba_kmean_phase(const bf16* Kh, float* km, int lane, int gw, int NGW) {
    for (int task = gw; task < 512; task += NGW) {
        const int rg = lane >> 4, ch = lane & 15; const bf16* base = Kh + ((size_t)task * 256 + rg) * HD + ch * 8; float s[8] = {0.f, 0.f, 0.f, 0.f, 0.f, 0.f, 0.f, 0.f};
#pragma unroll 8
        for (int i = 0; i < 64; ++i) { const v4u w = *(const v4u*)(base + (size_t)i * 4 * HD);
            s[0] += __uint_as_float(w.x << 16); s[1] += __uint_as_float(w.x & 0xffff0000u); s[2] += __uint_as_float(w.y << 16); s[3] += __uint_as_float(w.y & 0xffff0000u);
            s[4] += __uint_as_float(w.z << 16); s[5] += __uint_as_float(w.z & 0xffff0000u); s[6] += __uint_as_float(w.w << 16); s[7] += __uint_as_float(w.w & 0xffff0000u); }
#pragma unroll
        for (int e = 0; e < 8; ++e) { s[e] += __shfl_xor(s[e], 16); s[e] += __shfl_xor(s[e], 32); }
        if (rg == 0) { float* o = km + (size_t)task * HD + ch * 8;
            *(f32x4*)o = (f32x4){s[0], s[1], s[2], s[3]} * (1.f / 256.f); *(f32x4*)(o + 4) = (f32x4){s[4], s[5], s[6], s[7]} * (1.f / 256.f); }
    }
}
__device__ __forceinline__ void fox_bias_phase(const float* logf, float* bias, int lane, int gw, int NGW) {
    for (int task = gw; task < 64; task += NGW) {
        const f32x4* src = (const f32x4*)(logf + (size_t)task * SEQ + 32 * lane); f32x4 v[8]; float run = 0.f;
#pragma unroll
        for (int j = 0; j < 8; ++j) { v[j] = src[j]; v[j][0] += run; v[j][1] += v[j][0]; v[j][2] += v[j][1]; v[j][3] += v[j][2]; run = v[j][3]; }
        float sc = run;
#pragma unroll
        for (int o = 1; o < 64; o <<= 1) { const float t = __shfl_up(sc, o); if (lane >= o) sc += t; }
        const float base = sc - run, ns = -1.0f / att::SCALE; f32x4* dst = (f32x4*)(bias + (size_t)task * SEQ + 32 * lane);
#pragma unroll
        for (int j = 0; j < 8; ++j) dst[j] = (v[j] + base) * ns;
    }
}
__device__ __forceinline__ void moba_bias_phase(float* bias, int lane, int gw, int NGW) {
    for (int task = gw; task < 64 * 8; task += NGW) { const int bh = task >> 3, s0 = (task & 7) * 256 + 4 * lane;
        const float sl = exp2f(-0.5f * (float)((bh & 15) + 1)) * (1.0f / att::SCALE);
        *(f32x4*)(bias + (size_t)bh * SEQ + s0) = (f32x4){sl * (float)s0, sl * (float)(s0 + 1), sl * (float)(s0 + 2), sl * (float)(s0 + 3)}; }
}
__device__ __forceinline__ void moba_select_phase(const bf16* Qh, const float* km, unsigned* sel, int lane, int gw, int NGW) {
    for (int task = gw; task < 64 * 32; task += NGW) {
        const int bh = task >> 5, t0 = (task & 31) * 64, own = t0 >> 8;
        const bf16* qrow = Qh + ((size_t)bh * SEQ + t0 + lane) * HD; const float* kmb = km + (size_t)bh * 8 * HD;
        float gt[8];
#pragma unroll
        for (int n = 0; n < 8; ++n) gt[n] = 0.f;
#pragma unroll 2
        for (int c = 0; c < 16; ++c) { const v4u w = *(const v4u*)(qrow + c * 8); float q[8];
            q[0] = __uint_as_float(w.x << 16); q[1] = __uint_as_float(w.x & 0xffff0000u); q[2] = __uint_as_float(w.y << 16); q[3] = __uint_as_float(w.y & 0xffff0000u);
            q[4] = __uint_as_float(w.z << 16); q[5] = __uint_as_float(w.z & 0xffff0000u); q[6] = __uint_as_float(w.w << 16); q[7] = __uint_as_float(w.w & 0xffff0000u);
#pragma unroll
            for (int n = 0; n < 7; ++n) if (n < own) { const float* kp = kmb + n * HD + c * 8;
#pragma unroll
                for (int j = 0; j < 8; ++j) gt[n] = fmaf(q[j], kp[j], gt[n]); } }
        unsigned m = 0u;
#pragma unroll
        for (int r = 0; r < 3; ++r) { int best = -1; float bv = -__builtin_inff();
#pragma unroll
            for (int n = 0; n < 7; ++n) if (n < own && !((m >> n) & 1u) && gt[n] > bv) { bv = gt[n]; best = n; }
            if (best >= 0) m |= 1u << best; }
        sel[(size_t)bh * SEQ + t0 + lane] = m;
    }
}
__device__ __forceinline__ void s5_scan_phase(const Args& a, int lane, int wave, int vcu, int G) {
    const float* a_re = a.in[14]; const float* a_im = a.in[15]; const float* log_dt = a.in[16];
    const float* Hl = (const float*)(a.ws + WS_HLOC); bf16* UH = (bf16*)(a.ws + WS_UH);
    for (int task = wave * G + vcu; task < 512; task += NWAVES * G) {
        const int g = task >> 2, b = task & 3, p = lane; const float dt = expf(log_dt[g]);
        const float mag = expf(a_re[g * 64 + p] * dt * 32.f); float sn, cs; sincosf(a_im[g * 64 + p] * dt * 32.f, &sn, &cs); const float ar = mag * cs, ai = mag * sn;
        float hr = 0.f, hi = 0.f;
#pragma unroll 8
        for (int k = 0; k < 64; ++k) { const size_t row = (size_t)g * 256 + b * 64 + k;
            *(unsigned*)(UH + row * 640 + 512 + 2 * p) = pk2(hr, hi);
            const f32x2 hl = *(const f32x2*)(Hl + row * 128 + 2 * p);
            const float nr = ar * hr - ai * hi + hl[0], ni = ar * hi + ai * hr + hl[1]; hr = nr; hi = ni; }
    }
}
__device__ __forceinline__ void final_norm_phase(const bf16* Hb, const float* ssq, const float* fg, float* out, int lane, int gw, int NGW) {
    for (int r = gw; r < M; r += NGW) {
        const f32x4* sp = (const f32x4*)(ssq + (size_t)r * 16); const f32x4 s4 = sp[0] + sp[1];
        const float rstd = 1.0f / sqrtf(((s4[0] + s4[1]) + (s4[2] + s4[3])) * (1.0f / DM) + 1e-6f);
        const v4u* xr = (const v4u*)(Hb + (size_t)r * DM) + lane; const f32x4* gr = (const f32x4*)fg + 2 * lane; f32x4* o = (f32x4*)(out + (size_t)r * DM) + 2 * lane;
#pragma unroll
        for (int j = 0; j < 4; ++j) { const v4u w = xr[64 * j]; const f32x4 g0 = gr[128 * j], g1 = gr[128 * j + 1];
            f32x4 a, b; a[0] = __uint_as_float(w.x << 16); a[1] = __uint_as_float(w.x & 0xffff0000u); a[2] = __uint_as_float(w.y << 16); a[3] = __uint_as_float(w.y & 0xffff0000u);
            b[0] = __uint_as_float(w.z << 16); b[1] = __uint_as_float(w.z & 0xffff0000u); b[2] = __uint_as_float(w.w << 16); b[3] = __uint_as_float(w.w & 0xffff0000u);
            o[128 * j] = a * g0 * rstd; o[128 * j + 1] = b * g1 * rstd; }
    }
}
__global__ void __launch_bounds__(NWAVES * 64, 2) mk_fwd(Args args) {
    extern __shared__ __attribute__((aligned(16))) unsigned char lds[];
    LAS unsigned char* L = (LAS unsigned char*)lds;
    volatile LAS unsigned* MISC = (volatile LAS unsigned*)(L + MISC_OFF);
    const int wave = __builtin_amdgcn_readfirstlane((int)threadIdx.x >> 6);
    const int tid = MK_TID();
#define TIDL() ({ int t_ = MK_TID(); asm volatile("" : "+v"(t_)); t_; })
    const int G = gridDim.x; const int bx = blockIdx.x; const int vcu = (G % 8 == 0) ? (bx % 8) * (G / 8) + bx / 8 : bx;
    const int gw = vcu * NWAVES + wave, NGW = G * NWAVES;
    unsigned char* ws = args.ws;
    unsigned* ctl = (unsigned*)(ws + WS_CTL);
    for (int u = tid; u < (LDS_BYTES - LDSCTL_OFF) / 4; u += NWAVES * 64) ((LAS unsigned*)(L + LDSCTL_OFF))[u] = 0u;
    __syncthreads();
    const int lo = args.ph_lo, hi = args.ph_hi;
    const bool single = (hi - lo) > 1;
    XcdBarrier bar; bar.bar = ctl + CW_BAR; bar.x = 0; bar.st = nullptr;
    if (single) bar = xcd_barrier_post(ctl + CW_BAR, MISC + 8, wave);
    int pc = 0;
#ifndef MK_SITES
#define MK_SITES 0xffffffu
#endif
#define SITE(n) (((MK_SITES >> (n)) & 1u) != 0u)
#define RUN() (pc >= lo && pc < hi)
#ifndef MK_REP_SITE
#define MK_REP_SITE -1
#endif
#ifndef MK_REP_N
#define MK_REP_N 1
#endif
#define REP(n) for (int rep_ = 0; rep_ < ((n) == MK_REP_SITE ? MK_REP_N : 1); ++rep_)
#define SEAM() do { if (pc >= lo && pc + 1 < hi) xcd_barrier(bar, wave); ++pc; } while (0)
#define ACT ((bf16*)(ws + WS_ACT))
#define QKV ((bf16*)(ws + WS_QKV))
#define OB ((bf16*)(ws + WS_OB))
#define PP ((bf16*)(ws + WS_PP))
#define LOGF ((float*)(ws + WS_LOGF))
#define KMEAN ((float*)(ws + WS_KMEAN))
#define UH ((bf16*)(ws + WS_UH))
#define HLOC ((float*)(ws + WS_HLOC))
#define YB ((bf16*)(ws + WS_YB))

    if (SITE(0) && RUN()) REP(0) { const int t = TIDL(); p0_prologue(args, L, t, t & 63, wave, vcu, G); }
    SEAM();
    if (SITE(1) && RUN()) REP(1) { pg8::Gemm g{(const bf16*)(ws + WS_PBF), (const bf16*)(ws + WS_WPP), PLE, PLE, PLE}; pg8::PpOrder S; S.init(G, bx);
        pg8::EpiBf16 E{PP, DM, nullptr, 0}; pg8::gemm_phase(L + RING_OFF, g, S, E, wave); }
    SEAM();
    int np = 8, sel = 0;
#define HBR ((const bf16*)(ws + (sel ? WS_HB2 : WS_HB)))
#define HBW ((bf16*)(ws + (sel ? WS_HB : WS_HB2)))
#define SSQR ((const float*)(ws + WS_SSQ) + (sel ? M * 16 : 0))
#define SSQW ((float*)(ws + WS_SSQ) + (sel ? 0 : M * 16))
    for (int layer = 0; layer < DEPTH; ++layer) {
        const int kind = layer % 3;
        for (int half = 0; half < 2; ++half) {
#if defined(MK_EXP) && (MK_EXP == 1 || MK_EXP == 2)
            if (RUN()) { pg8::Gemm g{HBR, (const bf16*)(ws + WS_WFI) + (size_t)(layer * 2 + half) * 2 * FF * DM, DM, DM, DM}; pg8::StaticOrder S; S.init(M, 2 * FF, G, bx);
#if MK_EXP == 2
                S.lim = 1280;
#endif
                pg8::EpiNone E{(float*)(ws + WS_CTL), (int)(lo > 1000000)}; pg8::gemm_phase(L + RING_OFF, g, S, E, wave); }
#endif
            if (SITE(2) && RUN()) REP(2) { pg8::Gemm g{HBR, (const bf16*)(ws + WS_WFI) + (size_t)(layer * 2 + half) * 2 * FF * DM, DM, DM, DM}; pg8::StaticOrder S; S.init(M, 2 * FF, G, bx);
                pg8::EpiSwiglu E{ACT, FF, SSQR, np}; pg8::gemm_phase(L + RING_OFF, g, S, E, wave);
                if (rep_ == 0) cv_tail(args, layer * 2 + half, L, TIDL() & 63, wave, bx, G); }
            SEAM();
            if (SITE(3) && RUN()) REP(3) { pg8::Gemm g{ACT, (const bf16*)(ws + WS_WFO) + (size_t)(layer * 2 + half) * DM * FF, FF, FF, FF}; pg8::StaticOrder S; S.init(M, DM, G, bx);
                pg8::EpiRes<0> E{HBR, (layer == 0 && half == 0) ? args.in[0] : nullptr, HBW, SSQW, 0.5f, nullptr, 0, nullptr}; pg8::gemm_phase(L + RING_OFF, g, S, E, wave); }
            SEAM(); np = 8; sel ^= 1;
            if (half == 0) {
                if (kind < 2) {
                    const int wslot = layer == 0 ? 0 : (layer == 1 ? 1 : 2);
                    if (kind == 0) { if (SITE(4) && RUN()) REP(4) fox_gate_phase(HBR, (const float*)(ws + WS_WFT) + (size_t)(layer / 3) * 16 * DM, args.in[9] + (layer / 3) * 16, LOGF, TIDL() & 63, gw, NGW); SEAM(); }
                    if (RUN()) {
                        if (SITE(4) && kind == 0) fox_bias_phase(LOGF, (float*)(ws + WS_BIAS), TIDL() & 63, wave * G + vcu, NGW);
                        if (SITE(5)) REP(5) { pg8::Gemm g{HBR, (const bf16*)(ws + WS_WQKV) + (size_t)wslot * 3 * DM * DM, DM, DM, DM}; pg8::StaticOrder S; S.init(M, 3 * DM, G, bx);
                        pg8::EpiQkv E{QKV, SSQR, np}; pg8::gemm_phase(L + RING_OFF, g, S, E, wave); } }
                    SEAM();
                    if (kind == 1) {
                        if (SITE(6) && RUN()) REP(6) { moba_kmean_phase(QKV + (size_t)M * DM, KMEAN, TIDL() & 63, gw, NGW); moba_bias_phase((float*)(ws + WS_BIAS), TIDL() & 63, gw, NGW); }
                        SEAM();
                        if (SITE(6) && RUN()) REP(6) moba_select_phase(QKV, KMEAN, (unsigned*)(ws + WS_SEL), TIDL() & 63, gw, NGW);
                        SEAM(); }
                    if (RUN()) {
                        if (kind == 0) { if (SITE(7)) REP(7) att::attn_phase<false>((char*)lds + RING_OFF, QKV, QKV + (size_t)M * DM, QKV + (size_t)2 * M * DM, OB, (const float*)(ws + WS_BIAS), nullptr, wave); }
                        else if (SITE(8)) REP(8) att::attn_phase<true>((char*)lds + RING_OFF, QKV, QKV + (size_t)M * DM, QKV + (size_t)2 * M * DM, OB, (const float*)(ws + WS_BIAS), (const unsigned*)(ws + WS_SEL), wave); }
                    SEAM();
                    if (SITE(9) && RUN()) REP(9) { pg8::Gemm g{OB, (const bf16*)(ws + WS_WO) + (size_t)wslot * DM * DM, DM, DM, DM}; pg8::StaticOrder S; S.init(M, DM, G, bx);
                        pg8::EpiRes<0> E{HBR, nullptr, HBW, SSQW, 1.0f, nullptr, 0, nullptr}; pg8::gemm_phase(L + RING_OFF, g, S, E, wave); }
                    SEAM(); sel ^= 1;
                } else {
                    if (SITE(10) && RUN()) REP(10) { pg8::Gemm g{HBR, (const bf16*)(ws + WS_WS5I), DM, DM, DM}; pg8::StaticOrder S; S.init(M, DM, G, bx);
                        pg8::EpiS5U E{UH, SSQR, np}; pg8::gemm_phase(L + RING_OFF, g, S, E, wave); }
                    SEAM();
                    if (SITE(11) && RUN()) REP(11) { pg8::Gemm g{UH, (const bf16*)(ws + WS_S5W), 640, 512, 512}; pg8::BatchOrder<1> S; S.init(G, bx);
                        pg8::EpiS5H E{HLOC}; pg8::gemm_phase(L + RING_OFF, g, S, E, wave); }
                    SEAM();
                    if (SITE(12) && RUN()) REP(12) s5_scan_phase(args, TIDL() & 63, wave, vcu, G);
                    SEAM();
                    if (SITE(13) && RUN()) REP(13) { pg8::Gemm g{UH, (const bf16*)(ws + WS_S5TV), 640, 640, 640}; pg8::BatchOrder<2> S; S.init(G, bx);
                        pg8::EpiS5Y E{YB}; pg8::gemm_phase(L + RING_OFF, g, S, E, wave); }
                    SEAM();
                    if (SITE(14) && RUN()) REP(14) { pg8::Gemm g{YB, (const bf16*)(ws + WS_WGLU), DM, DM, DM}; pg8::StaticOrder S; S.init(M, 2 * DM, G, bx);
                        pg8::EpiRes<2> E{HBR, nullptr, HBW, SSQW, 1.0f, nullptr, 0, nullptr}; pg8::gemm_phase(L + RING_OFF, g, S, E, wave); }
                    SEAM(); np = 16; sel ^= 1;
                }
            } else {
                if (SITE(15) && RUN()) REP(15) { pg8::Gemm g{HBR, (const bf16*)(ws + WS_WPG) + (size_t)layer * DM * DM, DM, DM, DM}; pg8::StaticOrder S; S.init(M, DM, G, bx);
                    pg8::EpiRes<1> E{HBR, nullptr, HBW, SSQW, 1.0f, SSQR, np, PP + (size_t)layer * M * DM}; pg8::gemm_phase(L + RING_OFF, g, S, E, wave); }
                SEAM(); sel ^= 1;
            }
        }
    }
    if (SITE(16) && RUN()) REP(16) final_norm_phase(HBR, SSQR, args.in[3], args.out, TIDL() & 63, gw, NGW);
#undef RUN
#undef SEAM
}
constexpr int N_PHASES = 2 + 4 * 5 + (4 + 5 + 4 + 5) + 1;

#ifndef MK_PER_PHASE
#define MK_PER_PHASE 0
#endif
static void mk_launch(void* const* d_in, float* d_out, void* d_ws, hipStream_t stream) {
    static int grid = 0;
    if (grid == 0) {
        int dev = 0, cus = 0, per_cu = 0;
        if (hipGetDevice(&dev) != hipSuccess || hipDeviceGetAttribute(&cus, hipDeviceAttributeMultiprocessorCount, dev) != hipSuccess) { fprintf(stderr, "mk_launch: device query failed\n"); grid = -1; return; }
        if (hipFuncSetAttribute((const void*)mk_fwd, hipFuncAttributeMaxDynamicSharedMemorySize, LDS_BYTES) != hipSuccess) { fprintf(stderr, "mk_launch: hipFuncSetAttribute failed\n"); grid = -1; return; }
        if (hipOccupancyMaxActiveBlocksPerMultiprocessor(&per_cu, (const void*)mk_fwd, NWAVES * 64, LDS_BYTES) != hipSuccess || per_cu < 1) fprintf(stderr, "mk_launch: occupancy query reports %d\n", per_cu);
        (void)hipGetLastError();
        grid = cus;
    }
    if (grid < 0) return;
    if (hipMemsetAsync((char*)d_ws + WS_CTL, 0, CTL_ZERO_BYTES, stream) != hipSuccess) { fprintf(stderr, "mk_launch: memset failed\n"); return; }
    Args a{};
    for (int i = 0; i < 23; ++i) a.in[i] = (const float*)d_in[i];
    a.out = d_out; a.ws = (unsigned char*)d_ws;
#if MK_PER_PHASE
    for (int ph = 0; ph < N_PHASES; ++ph) { a.ph_lo = ph; a.ph_hi = ph + 1; hipLaunchKernelGGL(mk_fwd, dim3(grid), dim3(NWAVES * 64), LDS_BYTES, stream, a); }
#else
    a.ph_lo = 0; a.ph_hi = 1 << 20;
    hipLaunchKernelGGL(mk_fwd, dim3(grid), dim3(NWAVES * 64), LDS_BYTES, stream, a);
#endif
    const hipError_t le = hipPeekAtLastError();
    if (le != hipSuccess) fprintf(stderr, "mk_launch: launch failed: %s\n", hipGetErrorName(le));
}

extern "C" void kernel_launch(void* const* d_in, const int* in_sizes, int n_in, void* d_out, int out_size, void* d_ws, size_t ws_size, hipStream_t stream) {
    if (n_in != 23 || out_size != M * DM || in_sizes[0] != M * DM || ws_size < WS_END) { fprintf(stderr, "kernel_launch: unexpected shapes n_in=%d out=%d ws=%zu\n", n_in, out_size, ws_size); return; }
    mk_launch(d_in, (float*)d_out, d_ws, stream);
}
```

```cpp
#define MK_CV18 1
#define MK_TAILFENCE 1
#include <hip/hip_runtime.h>
#include <cstdio>
#include <cstdint>
#include <cmath>
#define MK_TID() ({ unsigned l_; asm volatile("v_mbcnt_lo_u32_b32 %0, -1, 0\n\tv_mbcnt_hi_u32_b32 %0, -1, %0" : "=v"(l_)); (int)(((unsigned)wave << 6) | l_); })
#define XB_TID ((unsigned)MK_TID())
namespace pg8 {
#define PG8_LAS __attribute__((address_space(3)))
typedef unsigned short bf16_t;
typedef short bf16x8 __attribute__((ext_vector_type(8)));
typedef float f32x4 __attribute__((ext_vector_type(4)));
typedef float f32x2 __attribute__((ext_vector_type(2)));
typedef unsigned u32x4 __attribute__((ext_vector_type(4)));
typedef unsigned u32x2 __attribute__((ext_vector_type(2)));
#ifndef MK_WGM
#define MK_WGM 4
#endif
constexpr int BM = 256, BK = 64, HALF = 128, HTB = HALF * BK * 2  , STAGE_BYTES = 8 * HTB, NXCD = 8, WGM = MK_WGM;
constexpr int EPI_LDS_OFF = STAGE_BYTES;
constexpr float RMS_EPS = 1e-6f;

__host__ __device__ __forceinline__ int lds_byte(int r, int c) { const int st = (r >> 4) * 2 + (c >> 5), rr = r & 15, cc = c & 31, ob = rr * 64 + cc * 2; return st * 1024 + (ob ^ (((ob >> 9) & 1) << 5)); }
__host__ __device__ __forceinline__ void stage_rc(int b, int& R, int& C) { const int st = b / 1024, sb = b % 1024, swz = sb ^ (((sb >> 9) & 1) << 5); R = (st >> 1) * 16 + swz / 64; C = (st & 1) * 32 + (swz % 64) / 2; }
__host__ __device__ __forceinline__ int perm32(int rho) { const int n = rho >> 4, i = rho & 15; return 8 * (i >> 2) + 4 * n + (i & 3); }

struct Unit { int pm, pn, pb; };
struct Gemm { const bf16_t* A; const bf16_t* Bt; int lda, ldb, K; };

struct StaticOrder {
    int nM, nN, nwg, G, c, lim, pbmask;
    __device__ void init(int M, int N, int G_, int c_) { asm volatile("" : "+s"(c_)); nM = M / BM; nN = N / BM; nwg = nM * nN; G = G_; c = c_; lim = nwg; pbmask = -1; }
    __device__ bool next(int i, Unit& u) const {
        const long L = (long)i * G + c; if (L >= lim) return false;
        int wgid = (int)L; { const int q = nwg / NXCD, r = nwg % NXCD, xcd = wgid % NXCD, off = wgid / NXCD; wgid = (xcd < r ? xcd * (q + 1) : r * (q + 1) + (xcd - r) * q) + off; }
        const int nig = WGM * nN, gid = wgid / nig, fm = gid * WGM, gsz = (nM - fm) < WGM ? (nM - fm) : WGM;
        u.pm = fm + ((wgid % nig) % gsz); u.pn = (wgid % nig) / gsz; u.pb = u.pn & pbmask; return true;
    }
};
struct PpOrder {
    StaticOrder s;
    __device__ void init(int G_, int c_) { s.init(4 * 8192, 2048, G_, c_); }
    __device__ bool next(int i, Unit& u) const { if (!s.next(i, u)) return false; u.pb = (u.pm >> 5) * 8 + u.pn; return true; }
};
template <int NT> struct BatchOrder {
    int G, c;
    __device__ void init(int G_, int c_) { G = G_; c = c_; }
    __device__ bool next(int i, Unit& u) const { const int L = i * G + c; if (L >= 128 * NT) return false; u.pm = L / NT; u.pn = L % NT; u.pb = L; return true; }
};

__device__ __forceinline__ unsigned cvt_pk_bf16(float lo, float hi) { unsigned r; asm volatile("v_cvt_pk_bf16_f32 %0, %1, %2" : "=v"(r) : "v"(lo), "v"(hi)); return r; }
__device__ __forceinline__ float fast_sigmoid(float x) { return __builtin_amdgcn_rcpf(1.0f + __builtin_amdgcn_exp2f(-1.4426950408889634f * x)); }
__device__ __forceinline__ float fast_silu(float x) { return x * fast_sigmoid(x); }
__device__ __forceinline__ float gelu_tanh(float v) {
    const float z = 0.7978845608028654f * (v + 0.044715f * v * v * v); return v * fast_sigmoid(2.0f * z);
}

#ifndef MK_WT
#define MK_WT 1
#endif
typedef __amdgpu_buffer_rsrc_t rsrc_t;
__device__ __forceinline__ rsrc_t out_rsrc(const void* base, unsigned nbytes) { return __builtin_amdgcn_make_buffer_rsrc((void*)base, 0, (int)nbytes, 0x00020000); }
__device__ __forceinline__ void st16(void* base, rsrc_t r, unsigned boff, u32x4 v) {
#if MK_WT
    (void)base; __builtin_amdgcn_raw_buffer_store_b128(v, r, boff, 0, 16);
#else
    (void)r; *(u32x4*)((char*)base + boff) = v;
#endif
}
typedef f32x4 Acc[2][2][4][2];

__device__ __forceinline__ void fill_rstd(const float* ssq, int np, int pm, PG8_LAS unsigned char* lds, int tid) {
    PG8_LAS float* R = (PG8_LAS float*)(lds + EPI_LDS_OFF + 4096);
#pragma unroll
    for (int h = 0; h < 2; ++h) { const int row = tid + 512 * h; const f32x4* sp = (const f32x4*)(ssq + ((size_t)(pm >> 2) * 4 * BM + row) * 16);
        f32x4 a = sp[0] + sp[1]; if (np > 8) a += sp[2] + sp[3];
        R[row] = __builtin_amdgcn_rsqf(((a[0] + a[1]) + (a[2] + a[3])) * (1.0f / 2048.0f) + RMS_EPS); }
    asm volatile("s_waitcnt lgkmcnt(0)" ::: "memory"); __builtin_amdgcn_s_barrier(); asm volatile("" ::: "memory");
}
__device__ __forceinline__ void row_rstd(int pm, int wr, int fr, float (&rs)[2][4], PG8_LAS unsigned char* lds) {
    const PG8_LAS float* R = (const PG8_LAS float*)(lds + EPI_LDS_OFF + 4096) + (pm & 3) * BM;
#pragma unroll
    for (int ai = 0; ai < 2; ++ai)
#pragma unroll
        for (int m = 0; m < 4; ++m) rs[ai][m] = R[ai * HALF + wr * 64 + m * 16 + fr];
}

struct EpiNone {
    static constexpr bool PRE = false; static constexpr bool RSTD = false; static constexpr bool PERM = true, BAR = false;
    float* sink; int never;
    __device__ __forceinline__ void operator()(const Acc& acc, const Unit& u, int wr, int wc, int fr, int fq, PG8_LAS unsigned char* lds, int tid) const {
        if (never) { f32x4 t = (f32x4){0.f, 0.f, 0.f, 0.f};
#pragma unroll
            for (int ai = 0; ai < 2; ++ai)
#pragma unroll
                for (int bj = 0; bj < 2; ++bj)
#pragma unroll
                    for (int m = 0; m < 4; ++m)
#pragma unroll
                        for (int n = 0; n < 2; ++n) t += acc[ai][bj][m][n];
            *(f32x4*)(sink + tid * 4) = t; }
    }
};
struct EpiStoreOnly {
    static constexpr bool PRE = false; static constexpr bool RSTD = false; static constexpr bool PERM = true, BAR = false;
    bf16_t* O;
    __device__ __forceinline__ void operator()(const Acc& acc, const Unit& u, int wr, int wc, int fr, int fq, PG8_LAS unsigned char* lds, int tid) const {
        const rsrc_t rs_o = out_rsrc(O, 8192u * 2048u * 4u);
#pragma unroll
        for (int ai = 0; ai < 2; ++ai)
#pragma unroll
            for (int m = 0; m < 4; ++m)
#pragma unroll
                for (int bj = 0; bj < 2; ++bj) { const f32x4 v0 = acc[ai][bj][m][0], v1 = acc[ai][bj][m][1];
                    u32x4 w; w.x = __float_as_uint(v0[0]) ^ __float_as_uint(v1[0]); w.y = __float_as_uint(v0[1]) ^ __float_as_uint(v1[1]); w.z = __float_as_uint(v0[2]) ^ __float_as_uint(v1[2]); w.w = __float_as_uint(v0[3]) ^ __float_as_uint(v1[3]);
                    st16(O, rs_o, (unsigned)((((size_t)((u.pm & 7) * BM + ai * HALF + wr * 64 + m * 16 + fr)) * 2048 + (u.pn & 7) * BM + bj * HALF + wc * 32 + 8 * fq) * 2), w); }
#if defined(MK_EXP) && MK_EXP == 9
        asm volatile("s_waitcnt vmcnt(0)" ::: "memory");
#endif
    }
};
struct EpiSwiglu {
    static constexpr bool PRE = false; static constexpr bool RSTD = true; static constexpr bool PERM = true, BAR = false;
    bf16_t* O; int ldo; const float* ssq; int np;
    __device__ __forceinline__ void operator()(const Acc& acc, const Unit& u, int wr, int wc, int fr, int fq, PG8_LAS unsigned char* lds, int tid) const {
        float rs[2][4]; row_rstd(u.pm, wr, fr, rs, lds);
        const rsrc_t rs_o = out_rsrc(O, 8192u * 5632u * 2u);
        const int col0 = u.pn * HALF + wc * 32 + 8 * fq;
#pragma unroll
        for (int ai = 0; ai < 2; ++ai)
#pragma unroll
            for (int m = 0; m < 4; ++m) { const float s = rs[ai][m]; float o[8];
#pragma unroll
                for (int n = 0; n < 2; ++n)
#pragma unroll
                    for (int i = 0; i < 4; ++i) o[n * 4 + i] = fast_silu(acc[ai][0][m][n][i] * s) * (acc[ai][1][m][n][i] * s);
                u32x4 w; w.x = cvt_pk_bf16(o[0], o[1]); w.y = cvt_pk_bf16(o[2], o[3]); w.z = cvt_pk_bf16(o[4], o[5]); w.w = cvt_pk_bf16(o[6], o[7]);
                st16(O, rs_o, (unsigned)(((size_t)(u.pm * BM + ai * HALF + wr * 64 + m * 16 + fr) * ldo + col0) * 2), w); }
    }
};
struct EpiBf16 {
    static constexpr bool PRE = false; static constexpr bool RSTD = true; static constexpr bool PERM = true, BAR = false;
    bf16_t* O; int ldo; const float* ssq; int np;
    __device__ __forceinline__ void operator()(const Acc& acc, const Unit& u, int wr, int wc, int fr, int fq, PG8_LAS unsigned char* lds, int tid) const {
        float rs[2][4];
        if (ssq) row_rstd(u.pm, wr, fr, rs, lds); else {
#pragma unroll
            for (int a = 0; a < 2; ++a)
#pragma unroll
                for (int m = 0; m < 4; ++m) rs[a][m] = 1.f; }
        const rsrc_t rs_o = out_rsrc(O, 32768u * 2048u * 2u);
        const int col0 = u.pn * BM + wc * 32 + 8 * fq;
#pragma unroll
        for (int ai = 0; ai < 2; ++ai)
#pragma unroll
            for (int m = 0; m < 4; ++m) { const float s = rs[ai][m];
#pragma unroll
                for (int bj = 0; bj < 2; ++bj) { const f32x4 v0 = acc[ai][bj][m][0] * s, v1 = acc[ai][bj][m][1] * s;
                    u32x4 w; w.x = cvt_pk_bf16(v0[0], v0[1]); w.y = cvt_pk_bf16(v0[2], v0[3]); w.z = cvt_pk_bf16(v1[0], v1[1]); w.w = cvt_pk_bf16(v1[2], v1[3]);
                    st16(O, rs_o, (unsigned)(((size_t)(u.pm * BM + ai * HALF + wr * 64 + m * 16 + fr) * ldo + col0 + bj * HALF) * 2), w); } }
    }
};
struct EpiQkv {
    static constexpr bool PRE = false; static constexpr bool RSTD = true; static constexpr bool PERM = true, BAR = false;
    bf16_t* O; const float* ssq; int np;
    __device__ __forceinline__ void operator()(const Acc& acc, const Unit& u, int wr, int wc, int fr, int fq, PG8_LAS unsigned char* lds, int tid) const {
        float rs[2][4]; row_rstd(u.pm, wr, fr, rs, lds);
        const rsrc_t rs_o = out_rsrc(O, 3u * 8192u * 2048u * 2u);
        const int which = u.pn >> 3, hd0 = (u.pn & 7) * 2, d0 = wc * 32 + 8 * fq;
#pragma unroll
        for (int ai = 0; ai < 2; ++ai)
#pragma unroll
            for (int m = 0; m < 4; ++m) { const float s = rs[ai][m]; const int r = u.pm * BM + ai * HALF + wr * 64 + m * 16 + fr, b = r >> 11, t = r & 2047;
#pragma unroll
                for (int bj = 0; bj < 2; ++bj) { const f32x4 v0 = acc[ai][bj][m][0] * s, v1 = acc[ai][bj][m][1] * s;
                    u32x4 w; w.x = cvt_pk_bf16(v0[0], v0[1]); w.y = cvt_pk_bf16(v0[2], v0[3]); w.z = cvt_pk_bf16(v1[0], v1[1]); w.w = cvt_pk_bf16(v1[2], v1[3]);
                    st16(O, rs_o, (unsigned)(((size_t)which * (8192 * 2048) + ((size_t)((b * 16 + hd0 + bj) * 2048 + t)) * 128 + d0) * 2), w); } }
    }
};
struct EpiS5U {
    static constexpr bool PRE = false; static constexpr bool RSTD = true; static constexpr bool PERM = true, BAR = false;
    bf16_t* UH; const float* ssq; int np;
    __device__ __forceinline__ void operator()(const Acc& acc, const Unit& u, int wr, int wc, int fr, int fq, PG8_LAS unsigned char* lds, int tid) const {
        const rsrc_t rs_o = out_rsrc(UH, 128u * 256u * 640u * 2u); float rs[2][4]; row_rstd(u.pm, wr, fr, rs, lds);
#pragma unroll
        for (int ai = 0; ai < 2; ++ai)
#pragma unroll
            for (int m = 0; m < 4; ++m) { const float s = rs[ai][m]; const int r = u.pm * BM + ai * HALF + wr * 64 + m * 16 + fr;
#pragma unroll
                for (int bj = 0; bj < 2; ++bj) { const int cg = u.pn * BM + bj * HALF + wc * 32 + 8 * fq, g = cg >> 4, c0 = cg & 15;
                    const f32x4 v0 = acc[ai][bj][m][0] * s, v1 = acc[ai][bj][m][1] * s;
                    u32x4 w; w.x = cvt_pk_bf16(v0[0], v0[1]); w.y = cvt_pk_bf16(v0[2], v0[3]); w.z = cvt_pk_bf16(v1[0], v1[1]); w.w = cvt_pk_bf16(v1[2], v1[3]);
                    st16(UH, rs_o, (unsigned)((((size_t)g * 256 + (r >> 5)) * 640 + (r & 31) * 16 + c0) * 2), w); } }
    }
};
struct EpiS5H {
    static constexpr bool PRE = false; static constexpr bool RSTD = false; static constexpr bool PERM = false, BAR = false;
    float* Hl;
    __device__ __forceinline__ void operator()(const Acc& acc, const Unit& u, int wr, int wc, int fr, int fq, PG8_LAS unsigned char* lds, int tid) const {
        const rsrc_t rs_o = out_rsrc(Hl, 128u * 256u * 128u * 4u);
#pragma unroll
        for (int ai = 0; ai < 2; ++ai)
#pragma unroll
            for (int m = 0; m < 4; ++m) {
#pragma unroll
                for (int n = 0; n < 2; ++n) st16(Hl, rs_o, (unsigned)((((size_t)u.pm * 256 + ai * HALF + wr * 64 + m * 16 + fr) * 128 + wc * 32 + 4 * fq + n * 16) * 4), __builtin_bit_cast(u32x4, acc[ai][0][m][n])); }
    }
};
struct EpiS5Y {
    static constexpr bool PRE = false; static constexpr bool RSTD = false; static constexpr bool PERM = true, BAR = false;
    bf16_t* Y;
    __device__ __forceinline__ void operator()(const Acc& acc, const Unit& u, int wr, int wc, int fr, int fq, PG8_LAS unsigned char* lds, int tid) const {
        const rsrc_t rs_o = out_rsrc(Y, 8192u * 2048u * 2u);
#pragma unroll
        for (int ai = 0; ai < 2; ++ai)
#pragma unroll
            for (int m = 0; m < 4; ++m) { const int crow = ai * HALF + wr * 64 + m * 16 + fr;
#pragma unroll
                for (int bj = 0; bj < 2; ++bj) { const int col = u.pn * BM + bj * HALF + wc * 32 + 8 * fq, j = col >> 4, c0 = col & 15;
                    float o[8];
#pragma unroll
                    for (int n = 0; n < 2; ++n)
#pragma unroll
                        for (int i = 0; i < 4; ++i) o[n * 4 + i] = gelu_tanh(acc[ai][bj][m][n][i]);
                    u32x4 w; w.x = cvt_pk_bf16(o[0], o[1]); w.y = cvt_pk_bf16(o[2], o[3]); w.z = cvt_pk_bf16(o[4], o[5]); w.w = cvt_pk_bf16(o[6], o[7]);
                    st16(Y, rs_o, (unsigned)((((size_t)crow * 32 + j) * 2048 + u.pm * 16 + c0) * 2), w); } }
    }
};
template <int MODE> struct EpiRes {
    static constexpr bool RSTD = (MODE == 1); static constexpr bool PERM = true, BAR = true; static constexpr bool PRE = false;
    const bf16_t* hin; const float* hin32; bf16_t* hout; float* ssq_out; float alpha; const float* ssq; int np; const bf16_t* pp;
    __device__ __forceinline__ void preload(Acc& acc, const Unit& u, int wr, int wc, int fr, int fq) const {
        const float ia = 1.0f / alpha;
#pragma unroll
        for (int ai = 0; ai < 2; ++ai)
#pragma unroll
            for (int m = 0; m < 4; ++m) { const size_t r = (size_t)u.pm * BM + ai * HALF + wr * 64 + m * 16 + fr;
#pragma unroll
                for (int bj = 0; bj < 2; ++bj) { const size_t off = r * 2048 + u.pn * BM + bj * HALF + wc * 32 + 8 * fq;
                    if (hin32) { acc[ai][bj][m][0] = *(const f32x4*)(hin32 + off) * ia; acc[ai][bj][m][1] = *(const f32x4*)(hin32 + off + 4) * ia; }
                    else { const u32x4 hw = *(const u32x4*)(hin + off);
                        acc[ai][bj][m][0] = (f32x4){__uint_as_float(hw.x << 16), __uint_as_float(hw.x & 0xffff0000u), __uint_as_float(hw.y << 16), __uint_as_float(hw.y & 0xffff0000u)} * ia;
                        acc[ai][bj][m][1] = (f32x4){__uint_as_float(hw.z << 16), __uint_as_float(hw.z & 0xffff0000u), __uint_as_float(hw.w << 16), __uint_as_float(hw.w & 0xffff0000u)} * ia; } } }
    }
    bool pre;
    __device__ __forceinline__ void operator()(const Acc& acc, const Unit& u, int wr, int wc, int fr, int fq, PG8_LAS unsigned char* lds, int tid) const {
        float rs[2][4];
        if (MODE == 1) row_rstd(u.pm, wr, fr, rs, lds);
        PG8_LAS float* P = (PG8_LAS float*)(lds + EPI_LDS_OFF);
        const rsrc_t rs_o = out_rsrc(hout, 8192u * 2048u * 2u);
        constexpr int NBJ = (MODE == 2) ? 1 : 2; constexpr int CW = (MODE == 2) ? HALF : BM;
#pragma unroll
        for (int ai = 0; ai < 2; ++ai)
#pragma unroll
            for (int m = 0; m < 4; ++m) { const int rl = ai * HALF + wr * 64 + m * 16 + fr; const size_t r = (size_t)u.pm * BM + rl; float sq = 0.f;
#pragma unroll
                for (int bj = 0; bj < NBJ; ++bj) { const int col = u.pn * CW + bj * HALF + wc * 32 + 8 * fq; const size_t off = r * 2048 + col;
                    float f[8], h[8];
                    if (MODE == 0) {
#pragma unroll
                        for (int e = 0; e < 8; ++e) f[e] = acc[ai][bj][m][e >> 2][e & 3] * alpha; }
                    else if (MODE == 1) { const u32x4 pw = *(const u32x4*)(pp + off); const float s = rs[ai][m];
#pragma unroll
                        for (int e = 0; e < 8; ++e) { const unsigned w = pw[e >> 1]; const float pv = __uint_as_float((e & 1) ? (w & 0xffff0000u) : (w << 16)); f[e] = fast_sigmoid(acc[ai][bj][m][e >> 2][e & 3] * s) * pv; } }
                    else {
#pragma unroll
                        for (int e = 0; e < 8; ++e) f[e] = acc[ai][0][m][e >> 2][e & 3] * fast_sigmoid(acc[ai][1][m][e >> 2][e & 3]); }
                    if (MODE == 0 && pre) {
#pragma unroll
                        for (int e = 0; e < 8; ++e) h[e] = 0.f; }
                    else if (hin32) { const f32x4 a = *(const f32x4*)(hin32 + off), b = *(const f32x4*)(hin32 + off + 4);
#pragma unroll
                        for (int e = 0; e < 4; ++e) { h[e] = a[e]; h[4 + e] = b[e]; } }
                    else { const u32x4 hw = *(const u32x4*)(hin + off);
#pragma unroll
                        for (int e = 0; e < 8; ++e) { const unsigned w = hw[e >> 1]; h[e] = __uint_as_float((e & 1) ? (w & 0xffff0000u) : (w << 16)); } }
                    float o[8];
#pragma unroll
                    for (int e = 0; e < 8; ++e) { o[e] = h[e] + f[e]; sq = fmaf(o[e], o[e], sq); }
                    u32x4 w; w.x = cvt_pk_bf16(o[0], o[1]); w.y = cvt_pk_bf16(o[2], o[3]); w.z = cvt_pk_bf16(o[4], o[5]); w.w = cvt_pk_bf16(o[6], o[7]);
                    st16(hout, rs_o, (unsigned)(off * 2), w); }
                sq += __shfl_xor(sq, 16); sq += __shfl_xor(sq, 32);
                if (fq == 0) P[rl * 4 + wc] = sq;
                if (m & 1) asm volatile("" ::: "memory"); }
        asm volatile("s_waitcnt lgkmcnt(0)" ::: "memory"); __builtin_amdgcn_s_barrier(); asm volatile("" ::: "memory");
        if (tid < 256) { const f32x4 p4 = *(const PG8_LAS f32x4*)(P + tid * 4); const float sv = (p4[0] + p4[1]) + (p4[2] + p4[3]);
#if MK_WT
            __hip_atomic_store(ssq_out + ((size_t)u.pm * BM + tid) * 16 + u.pn, sv, __ATOMIC_RELAXED, __HIP_MEMORY_SCOPE_AGENT);
#else
            ssq_out[((size_t)u.pm * BM + tid) * 16 + u.pn] = sv;
#endif
        }
    }
};

template <class Epi, class Sched, bool NOMMA = false, bool MMAONLY = false>
__device__ __forceinline__ void gemm_phase(PG8_LAS unsigned char* lds, const Gemm g, const Sched& S, Epi E, const int wave, unsigned* pcnt = nullptr) {
    int tid_raw_ = MK_TID(); asm volatile("" : "+v"(tid_raw_)); const int tid = tid_raw_, wid = __builtin_amdgcn_readfirstlane(tid >> 6), lane = tid & 63, wr = wid >> 2, wc = wid & 3, fr = lane & 15, fq = lane >> 4;
    int K_ = g.K; asm volatile("" : "+s"(K_)); const int K = K_, nt = K / BK;
    unsigned voffA[2], voffB[2];
#pragma unroll
    for (int i = 0; i < 2; ++i) { int R, C; stage_rc(tid * 16 + i * 8192, R, C); const int Rb = Epi::PERM ? ((R & ~31) + perm32(R & 31)) : R;
        voffA[i] = (unsigned)(R * g.lda + C) * 2u; voffB[i] = (unsigned)(Rb * g.ldb + C) * 2u; }
    const size_t kstep = (size_t)(BK * 2);
    const size_t hstepA = (size_t)HALF * g.lda * 2, hstepB = (size_t)HALF * g.ldb * 2;
    const size_t tstepA = 2 * hstepA, tstepB = 2 * hstepB;
    const unsigned ldsw = (unsigned)wid * 1024u;
    const int aoff = lds_byte(wr * 64 + fr, fq * 8), boff = lds_byte(wc * 32 + fr, fq * 8);
#define PG8_SA(b, h) (((b) * 2 + (h)) * HTB)
#define PG8_SB(b, h) ((4 + (b) * 2 + (h)) * HTB)
#ifndef MK_BNT
#define MK_BNT 0
#endif
#define PG8_STAGE_(bufoff, gbase, voff, aux) do { if (MMAONLY) break; _Pragma("unroll") for (int _i = 0; _i < 2; ++_i) \
        __builtin_amdgcn_global_load_lds((const unsigned*)((const char*)(gbase) + (voff)[_i]), (PG8_LAS unsigned*)(lds + (bufoff) + ldsw + _i * 8192), 16, 0, aux); } while (0)
#define PG8_STAGE(bufoff, gbase, voff) PG8_STAGE_(bufoff, gbase, voff, 0)
#define PG8_STAGEB(bufoff, gbase, voff) PG8_STAGE_(bufoff, gbase, voff, MK_BNT)
#define PG8_LDA(dst, b, h) do { if (MMAONLY) { asm volatile("" : "+v"(dst[0][0]), "+v"(dst[1][0]), "+v"(dst[2][0]), "+v"(dst[3][0])); break; } _Pragma("unroll") for (int m = 0; m < 4; ++m) _Pragma("unroll") for (int k = 0; k < 2; ++k) dst[m][k] = *(const PG8_LAS bf16x8*)(lds + PG8_SA(b, h) + aoff + m * 2048 + k * 1024); } while (0)
#define PG8_LDB(dst, b, h) do { if (MMAONLY) { asm volatile("" : "+v"(dst[0][0]), "+v"(dst[1][0])); break; } _Pragma("unroll") for (int n = 0; n < 2; ++n) _Pragma("unroll") for (int k = 0; k < 2; ++k) dst[n][k] = *(const PG8_LAS bf16x8*)(lds + PG8_SB(b, h) + boff + n * 2048 + k * 1024); } while (0)
#define PG8_MMA(ai, bj, At, Bt) do { if (NOMMA) { asm volatile("" :: "v"(At[0][0]), "v"(At[0][1]), "v"(At[1][0]), "v"(At[1][1]), "v"(At[2][0]), "v"(At[2][1]), "v"(At[3][0]), "v"(At[3][1]), "v"(Bt[0][0]), "v"(Bt[0][1]), "v"(Bt[1][0]), "v"(Bt[1][1])); break; } __builtin_amdgcn_s_setprio(1); _Pragma("unroll") for (int m = 0; m < 4; ++m) _Pragma("unroll") for (int n = 0; n < 2; ++n) _Pragma("unroll") for (int k = 0; k < 2; ++k) \
        acc[ai][bj][m][n] = __builtin_amdgcn_mfma_f32_16x16x32_bf16(Bt[n][k], At[m][k], acc[ai][bj][m][n], 0, 0, 0); __builtin_amdgcn_s_setprio(0); } while (0)
#define PG8_WAIT_V(n) asm volatile("s_waitcnt vmcnt(" #n ")" ::: "memory")
#define PG8_WAIT_L(n) asm volatile("s_waitcnt lgkmcnt(" #n ")" ::: "memory")
#define PG8_BAR do { if (!MMAONLY) __builtin_amdgcn_s_barrier(); } while (0)
#define PG8_SCHED __builtin_amdgcn_sched_barrier(0)
    Unit cur, nxt; int ui = 0;
    if (!S.next(0, cur)) return;
    int pm_r = -1;
    if constexpr (Epi::RSTD) { if (E.ssq) { fill_rstd(E.ssq, E.np, cur.pm, lds, tid); pm_r = cur.pm >> 2; } }
    f32x4 acc[2][2][4][2];
#pragma unroll
    for (int a = 0; a < 2; ++a)
#pragma unroll
        for (int b = 0; b < 2; ++b)
#pragma unroll
            for (int m = 0; m < 4; ++m)
#pragma unroll
                for (int n = 0; n < 2; ++n) acc[a][b][m][n] = (f32x4){0.f, 0.f, 0.f, 0.f};
    if constexpr (Epi::PRE) { int lp_ = lane; asm volatile("" : "+v"(lp_)); E.preload(acc, cur, wr, wc, lp_ & 15, lp_ >> 4); E.pre = true; }
    bf16x8 At[4][2], B0[2][2], B1[2][2];
    if (MMAONLY) {
#pragma unroll
        for (int m = 0; m < 4; ++m)
#pragma unroll
            for (int k = 0; k < 2; ++k) At[m][k] = (bf16x8){(short)(0x3f80 + lane), 0x3f00, 0x4000, 0x3e80, 0x3f80, 0x3f00, 0x4000, 0x3e80};
#pragma unroll
        for (int n = 0; n < 2; ++n)
#pragma unroll
            for (int k = 0; k < 2; ++k) { B0[n][k] = At[n][k]; B1[n][k] = At[n + 2][k]; } }
    const char* cA = (const char*)g.A + (size_t)cur.pm * tstepA; const char* cB = (const char*)g.Bt + (size_t)cur.pb * tstepB;
    PG8_STAGEB(PG8_SB(0, 0), cB, voffB); PG8_STAGEB(PG8_SB(0, 1), cB + hstepB, voffB); PG8_STAGE(PG8_SA(0, 0), cA, voffA); PG8_STAGE(PG8_SA(0, 1), cA + hstepA, voffA);
    if (wr == 1) PG8_BAR;
    PG8_WAIT_V(2); PG8_BAR;
    PG8_STAGEB(PG8_SB(1, 0), cB + kstep, voffB); PG8_STAGE(PG8_SA(1, 0), cA + kstep, voffA); PG8_STAGEB(PG8_SB(1, 1), cB + hstepB + kstep, voffB);
    PG8_WAIT_V(6); PG8_BAR;
    for (;;) {
        const bool has_next = S.next(ui + 1, nxt);
        const char* nA = has_next ? (const char*)g.A + (size_t)nxt.pm * tstepA : cA; const char* nB = has_next ? (const char*)g.Bt + (size_t)nxt.pb * tstepB : cB;
        for (int t = 0; t < nt; t += 2) {
            const bool last = (t == nt - 2);
            const char* a1 = cA + (size_t)(t + 1) * kstep;
            const char* a2 = last ? nA : cA + (size_t)(t + 2) * kstep; const char* b2 = last ? nB : cB + (size_t)(t + 2) * kstep;
            const char* a3 = a2 + kstep; const char* b3 = b2 + kstep;
            PG8_LDB(B0, 0, 0); PG8_LDB(B1, 0, 1); PG8_SCHED; PG8_LDA(At, 0, 0); PG8_STAGE(PG8_SA(1, 1), a1 + hstepA, voffA);
            PG8_WAIT_V(8); PG8_WAIT_L(0); PG8_BAR; PG8_MMA(0, 0, At, B0); PG8_MMA(0, 1, At, B1); PG8_BAR; PG8_SCHED;
            PG8_LDA(At, 0, 1); PG8_STAGEB(PG8_SB(0, 0), b2, voffB); PG8_STAGEB(PG8_SB(0, 1), b2 + hstepB, voffB); PG8_STAGE(PG8_SA(0, 0), a2, voffA);
            PG8_WAIT_V(8); PG8_WAIT_L(0); PG8_BAR; PG8_MMA(1, 0, At, B0); PG8_MMA(1, 1, At, B1); PG8_BAR; PG8_SCHED;
            PG8_LDB(B0, 1, 0); PG8_LDB(B1, 1, 1); PG8_SCHED; PG8_LDA(At, 1, 0); PG8_STAGE(PG8_SA(0, 1), a2 + hstepA, voffA);
            PG8_WAIT_V(8); PG8_WAIT_L(0); PG8_BAR; PG8_MMA(0, 0, At, B0); PG8_MMA(0, 1, At, B1); PG8_BAR; PG8_SCHED;
            PG8_LDA(At, 1, 1); PG8_STAGEB(PG8_SB(1, 0), b3, voffB); PG8_STAGEB(PG8_SB(1, 1), b3 + hstepB, voffB); PG8_STAGE(PG8_SA(1, 0), a3, voffA);
            PG8_WAIT_V(8); PG8_WAIT_L(0); PG8_BAR; PG8_MMA(1, 0, At, B0); PG8_MMA(1, 1, At, B1); PG8_BAR; PG8_SCHED;
        }
        if (wr == 0) PG8_BAR;
        if constexpr (Epi::RSTD) { if (E.ssq && (cur.pm >> 2) != pm_r) { fill_rstd(E.ssq, E.np, cur.pm, lds, tid); pm_r = cur.pm >> 2; } }
        { int le_ = lane; asm volatile("" : "+v"(le_));
          E(acc, cur, wr, wc, le_ & 15, le_ >> 4, lds, (wid << 6) | le_); }
        if (!has_next) break;
        if constexpr (Epi::PRE) E.pre = false;
#pragma unroll
        for (int a = 0; a < 2; ++a)
#pragma unroll
            for (int b = 0; b < 2; ++b)
#pragma unroll
                for (int m = 0; m < 4; ++m)
#pragma unroll
                    for (int n = 0; n < 2; ++n) acc[a][b][m][n] = (f32x4){0.f, 0.f, 0.f, 0.f};
        cur = nxt; cA = nA; cB = nB; ++ui;
        if (wr == 1) PG8_BAR;
    }
    PG8_WAIT_V(0);
    PG8_BAR;
    if (pcnt) { unsigned* pc_ = pcnt; asm volatile("" : "+s"(pc_));
        if (wave == 0 && lane == 0) __hip_atomic_fetch_add(pc_, 1u, __ATOMIC_RELAXED, __HIP_MEMORY_SCOPE_AGENT); }
#undef PG8_SA
#undef PG8_SB
#undef PG8_STAGE
#undef PG8_STAGEB
#undef PG8_STAGE_
#undef PG8_LDA
#undef PG8_LDB
#undef PG8_MMA
#undef PG8_WAIT_V
#undef PG8_WAIT_L
#undef PG8_BAR
#undef PG8_SCHED
}
}
namespace att {
typedef unsigned short bf16;
typedef short bf16x8 __attribute__((ext_vector_type(8)));
typedef short s16x4 __attribute__((ext_vector_type(4)));
typedef float f32x16 __attribute__((ext_vector_type(16)));
typedef float f32x4 __attribute__((ext_vector_type(4)));
typedef unsigned u32x4 __attribute__((ext_vector_type(4)));
constexpr int D = 128, SEQ = 2048, OS = 2048;
constexpr float SCALE = 0.08838834764831845f, THR = 8.f;
constexpr int NW = 8, QBLK = 32, KVBLK = 64, QB = NW * QBLK;
constexpr int SHM_V = KVBLK * D * 2, SHM_K = KVBLK * D * 2;
constexpr int LDS_WS = 2 * SHM_V + 2 * SHM_K;
constexpr int LDS_BIAS = LDS_WS + NW * 64 * 4;
constexpr int LDS_NEG = LDS_BIAS + SEQ * 4;
constexpr int LDS_OST = 77824, OST_WAVE = 16 * 272;
constexpr int LDS_BYTES = LDS_OST + NW * OST_WAVE;
static_assert(LDS_OST >= LDS_NEG + 256, "attention LDS map");

#define KSWZ(row, colB) ((row) * 256 + ((colB) ^ (((row) & 7) << 4)))
#define SBAR() __builtin_amdgcn_sched_barrier(0)
__device__ __forceinline__ int v_st(int k, int c) { const int kk = (k & ~0xC) | ((k & 4) << 1) | ((k & 8) >> 1); return ((kk >> 3) * 4 + (c >> 5)) * 512 + ((kk & 7) * 32 + (c & 31)) * 2; }
__device__ __forceinline__ int v_rd_base(int lane) { return ((lane & 3) << 3) | (((lane >> 2) & 3) << 6) | (((lane >> 4) & 1) << 5) | (((lane >> 5) & 1) << 8); }
constexpr int v_rd_off(int d0, int ks, int half) { return d0 * 512 + ks * 4096 + half * 2048; }
__device__ __forceinline__ int crow(int r, int hi) { return (r & 3) + 8 * (r >> 2) + 4 * hi; }
__device__ __forceinline__ unsigned cvtpk(float lo, float hi) { unsigned r; asm volatile("v_cvt_pk_bf16_f32 %0, %1, %2" : "=v"(r) : "v"(lo), "v"(hi)); return r; }
__device__ __forceinline__ bf16x8 load8(const bf16* p) { return *reinterpret_cast<const bf16x8*>(p); }
__device__ __forceinline__ void mask_tile(f32x16& p0, f32x16& p1, int dq) {
    const float NEG = -__builtin_inff();
#pragma unroll
    for (int r = 0; r < 16; ++r) {
        const int c = (r & 3) + 8 * (r >> 2);
        if (dq - c < 0) p0[r] = NEG;
        if (dq - c - 32 < 0) p1[r] = NEG;
    }
}
__device__ __forceinline__ void partialSM(f32x16& p0, f32x16& p1, float& m_reg, float& mn, float& alpha) {
    float pmax = p0[0]; for (int r = 1; r < 16; ++r) pmax = fmaxf(pmax, p0[r]); for (int r = 0; r < 16; ++r) pmax = fmaxf(pmax, p1[r]);
    { auto rr = __builtin_amdgcn_permlane32_swap(__float_as_uint(pmax), __float_as_uint(pmax), false, false);
      pmax = fmaxf(__uint_as_float(rr[0]), __uint_as_float(rr[1])); }
    constexpr float C2 = 1.4426950408889634f * SCALE;
    if (__builtin_expect(__all((pmax - m_reg) * SCALE <= THR), 1)) { mn = m_reg; alpha = 1.f; }
    else { mn = fmaxf(m_reg, pmax); alpha = __builtin_amdgcn_exp2f((m_reg - mn) * C2); m_reg = mn; }
    const float mnL = -mn * C2;
    for (int r = 0; r < 16; ++r) p0[r] = fmaf(p0[r], C2, mnL); for (int r = 0; r < 16; ++r) p1[r] = fmaf(p1[r], C2, mnL);
    for (int r = 0; r < 16; ++r) p0[r] = __builtin_amdgcn_exp2f(p0[r]);
}
__device__ __forceinline__ void finishSM(f32x16& p0, f32x16& p1, float alpha, float& l_reg, bf16x8& pa0, bf16x8& pa1, bf16x8& pa2, bf16x8& pa3) {
    for (int r = 0; r < 16; ++r) p1[r] = __builtin_amdgcn_exp2f(p1[r]);
    float ps = 0; for (int r = 0; r < 16; ++r) ps += p0[r]; for (int r = 0; r < 16; ++r) ps += p1[r];
    { auto rr = __builtin_amdgcn_permlane32_swap(__float_as_uint(ps), __float_as_uint(ps), false, false);
      ps = __uint_as_float(rr[0]) + __uint_as_float(rr[1]); }
    l_reg = l_reg * alpha + ps;
#define PK4(P, B_, OUT) do { unsigned a0 = cvtpk(P[B_+0], P[B_+1]), a1 = cvtpk(P[B_+2], P[B_+3]);                          \
        unsigned b0 = cvtpk(P[B_+4], P[B_+5]), b1 = cvtpk(P[B_+6], P[B_+7]);                                             \
        auto r0 = __builtin_amdgcn_permlane32_swap(a0, b0, false, false); auto r1 = __builtin_amdgcn_permlane32_swap(a1, b1, false, false); \
        u32x4 w = {r0[0], r1[0], r0[1], r1[1]}; OUT = *reinterpret_cast<bf16x8*>(&w); } while (0)
    PK4(p0, 0, pa0); PK4(p0, 8, pa1); PK4(p1, 0, pa2); PK4(p1, 8, pa3);
#undef PK4
}
template <int KB, bool NOBIAS = false>
__device__ __forceinline__ void qkt(f32x16& p0, f32x16& p1, const char* K_lds, int r32, int hi, const bf16x8* qr, const __attribute__((address_space(3))) char* bp) {
    if (NOBIAS) { p0 = f32x16{}; p1 = f32x16{}; } else
    { unsigned bpa = (unsigned)(uintptr_t)bp; asm volatile("" : "+v"(bpa));
      const __attribute__((address_space(3))) f32x4* b4 = (const __attribute__((address_space(3))) f32x4*)(uintptr_t)bpa;
      const f32x4 x0 = b4[0], x1 = b4[2], x2 = b4[4], x3 = b4[6], y0 = b4[8], y1 = b4[10], y2 = b4[12], y3 = b4[14];
      p0 = (f32x16){x0[0], x0[1], x0[2], x0[3], x1[0], x1[1], x1[2], x1[3], x2[0], x2[1], x2[2], x2[3], x3[0], x3[1], x3[2], x3[3]};
      p1 = (f32x16){y0[0], y0[1], y0[2], y0[3], y1[0], y1[1], y1[2], y1[3], y2[0], y2[1], y2[2], y2[3], y3[0], y3[1], y3[2], y3[3]}; }
    const char* kb[4];
#pragma unroll
    for (int dd = 0; dd < 4; ++dd) kb[dd] = K_lds + KB * SHM_K + KSWZ(r32, (dd * 16 + hi * 8) * 2);
#pragma unroll
    for (int d0 = 0; d0 < 8; ++d0) { const char* a = kb[d0 & 3] + (d0 >> 2) * 128;
        bf16x8 b0 = *reinterpret_cast<const bf16x8*>(a);
        bf16x8 b1 = *reinterpret_cast<const bf16x8*>(a + 32 * 256);
        p0 = __builtin_amdgcn_mfma_f32_32x32x16_bf16(b0, qr[d0], p0, 0, 0, 0);
        p1 = __builtin_amdgcn_mfma_f32_32x32x16_bf16(b1, qr[d0], p1, 0, 0, 0); }
}
template <int VB>
__device__ __forceinline__ void pv_tile(f32x16* o, int vb0, bf16x8 pa0, bf16x8 pa1, bf16x8 pa2, bf16x8 pa3) {
#define TRRD(dst, off) asm volatile("ds_read_b64_tr_b16 %0, %1 offset:%2" : "=&v"(dst) : "v"(vb0), "i"(off) : "memory")
#define PV_D0(d0) do { s16x4 l0, l1, l2, l3, h0, h1, h2, h3; constexpr int b_ = VB * SHM_V + v_rd_off(d0, 0, 0); \
        TRRD(l0, b_); TRRD(h0, b_ + 2048); TRRD(l1, b_ + 4096); TRRD(h1, b_ + 6144); TRRD(l2, b_ + 8192); TRRD(h2, b_ + 10240); TRRD(l3, b_ + 12288); TRRD(h3, b_ + 14336); \
        asm volatile("s_waitcnt lgkmcnt(0)" ::: "memory"); SBAR();   \
        o[d0] = __builtin_amdgcn_mfma_f32_32x32x16_bf16(pa0, (bf16x8){l0[0], l0[1], l0[2], l0[3], h0[0], h0[1], h0[2], h0[3]}, o[d0], 0, 0, 0);   \
        o[d0] = __builtin_amdgcn_mfma_f32_32x32x16_bf16(pa1, (bf16x8){l1[0], l1[1], l1[2], l1[3], h1[0], h1[1], h1[2], h1[3]}, o[d0], 0, 0, 0);   \
        o[d0] = __builtin_amdgcn_mfma_f32_32x32x16_bf16(pa2, (bf16x8){l2[0], l2[1], l2[2], l2[3], h2[0], h2[1], h2[2], h2[3]}, o[d0], 0, 0, 0);   \
        o[d0] = __builtin_amdgcn_mfma_f32_32x32x16_bf16(pa3, (bf16x8){l3[0], l3[1], l3[2], l3[3], h3[0], h3[1], h3[2], h3[3]}, o[d0], 0, 0, 0); } while (0)
    PV_D0(0); PV_D0(1); PV_D0(2); PV_D0(3);
#undef PV_D0
#undef TRRD
}

struct BlockRef { const bf16* Q; const bf16* K; const bf16* V; bf16* O; int P0; int bh; };
struct Seam { bf16x8 qr[8]; bf16x8 st_v0, st_v1, st_k0, st_k1; };
#define ROW(p, k0, rr) ((const bf16*)((const char*)((p) + (size_t)(k0) * D) + (unsigned)(((rr) * D + sc) * 2)))
#define VMW() asm volatile("s_waitcnt vmcnt(0)" ::: "memory")
#define VMWN(n) asm volatile("s_waitcnt vmcnt(%0)" :: "i"(n) : "memory")
#define SLOAD_H(Kp, Vp, k0) do { S.st_v0 = load8(ROW(Vp, k0, sr)); S.st_v1 = load8(ROW(Vp, k0, 32 + sr));              \
                         S.st_k0 = load8(ROW(Kp, k0, sr)); S.st_k1 = load8(ROW(Kp, k0, 32 + sr)); } while (0)
#define SWRITE_HK(bf) do { *(bf16x8*)(K_lds + (bf) * SHM_K + kws) = S.st_k0; *(bf16x8*)(K_lds + (bf) * SHM_K + kws + 32 * 256) = S.st_k1; } while (0)
#define SWRITE_HV(bf) do { *(bf16x8*)(V_lds + (bf) * SHM_V + vst0) = S.st_v0; *(bf16x8*)(V_lds + (bf) * SHM_V + vst1) = S.st_v1; } while (0)
#define SWRITE_H(bf) do { SWRITE_HV(bf); SWRITE_HK(bf); } while (0)
__device__ __forceinline__ void attn_prime(const BlockRef& cur, char* lds, Seam& S, const int wave) {
    int tid_raw_ = MK_TID(); asm volatile("" : "+v"(tid_raw_)); const int tid = tid_raw_, wid = __builtin_amdgcn_readfirstlane(tid >> 6), lane = tid & 63, r32 = lane & 31, hi = lane >> 5;
    const int sr = tid >> 4, sc = (tid & 15) * 8, kws = KSWZ(sr, sc * 2); char* K_lds = lds + 2 * SHM_V;
    for (int d0 = 0; d0 < 8; ++d0) S.qr[d0] = load8((const bf16*)((const char*)(cur.Q + (size_t)(wid * QBLK) * D) + (unsigned)((r32 * D + hi * 8) * 2)) + d0 * 16);
    SLOAD_H(cur.K, cur.V, 0); VMW(); SWRITE_HK(0);
    __syncthreads();
}
template <bool MOBA, bool NOBIAS = false>
__device__ __forceinline__ void attn_block(const BlockRef& cur, const BlockRef& nxt, char* lds, Seam& S, const float* __restrict__ biasG  , const unsigned* __restrict__ selG  , const int wave) {
    int tid_raw_ = MK_TID(); asm volatile("" : "+v"(tid_raw_)); const int tid = tid_raw_, wid = __builtin_amdgcn_readfirstlane(tid >> 6), lane = tid & 63, r32 = lane & 31, hi = lane >> 5;
    const int NT = (cur.P0 + QB) / KVBLK;
    const int qlo = cur.P0 + wid * QBLK, qm = qlo + r32 - 4 * hi;
    char* V_lds = lds; char* K_lds = lds + 2 * SHM_V;
    float* ws = (float*)(lds + LDS_WS) + wid * 64; float* li_l = ws, * al_l = ws + 32;
    float* biasL = (float*)(lds + LDS_BIAS); float* negL = (float*)(lds + LDS_NEG);
    unsigned selmask = 0u; const int own = cur.P0 >> 8;
    { int te = tid; asm volatile("" : "+v"(te));
      if (te < 64) negL[te] = -__builtin_inff();
      if (MOBA || NOBIAS) {
        *(f32x4*)(biasL + 4 * te) = *(const f32x4*)(biasG + (size_t)cur.bh * SEQ + 4 * te);
        if (MOBA) selmask = selG[(size_t)cur.bh * SEQ + cur.P0 + (te >> 6) * QBLK + (te & 31)];
      } else {
        f32x4 v = *(const f32x4*)(biasG + (size_t)cur.bh * SEQ + 4 * te); v[1] += v[0]; v[2] += v[1]; v[3] += v[2];
        float sc = v[3];
#pragma unroll
        for (int o = 1; o < 64; o <<= 1) { const float t = __shfl_up(sc, o); if ((te & 63) >= o) sc += t; }
        float* wsum = (float*)(lds + LDS_WS);
        if ((te & 63) == 63) wsum[te >> 6] = sc;
        __syncthreads();
        float base = sc - v[3];
#pragma unroll
        for (int w = 0; w < 7; ++w) if (w < (te >> 6)) base += wsum[w];
        const float ns = -1.0f / SCALE;
        *(f32x4*)(biasL + 4 * te) = (f32x4){(v[0] + base) * ns, (v[1] + base) * ns, (v[2] + base) * ns, (v[3] + base) * ns};
      } }
    __syncthreads();
    typedef const __attribute__((address_space(3))) char* lcp; const lcp bias_b = (lcp)((const char*)biasL) + 16 * hi; const lcp neg_b = (lcp)((const char*)negL) + 16 * hi;
    float m_reg = biasL[cur.P0 + wid * QBLK + r32], l_reg = 0; f32x16 o[4] = {};
    const int sr = tid >> 4, sc = (tid & 15) * 8, vst0 = v_st(sr, sc), vst1 = v_st(32 + sr, sc), kws = KSWZ(sr, sc * 2);
    const int vb0 = (int)(uintptr_t)V_lds + v_rd_base(lane);
    const bf16* Kh = cur.K; const bf16* Vh = cur.V;
#define RESC(a) do { if (__any((a) < 1.f)) { if (hi == 0) al_l[r32] = (a); asm volatile("s_waitcnt lgkmcnt(0)" ::: "memory");              \
                     for (int d_ = 0; d_ < 4; ++d_) for (int r = 0; r < 16; ++r) o[d_][r] *= al_l[crow(r, hi)]; } } while (0)
#define KBASE(t) ((t) * KVBLK)
#define BP(t) ((!MOBA || (KBASE(t) >> 8) >= own || ((selmask >> (KBASE(t) >> 8)) & 1u)) ? (bias_b + KBASE(t) * 4) : neg_b)
#define MASKT(P0_, P1_, t) do { const int kb_ = KBASE(t); if (kb_ + KVBLK - 1 > qlo) mask_tile(P0_, P1_, qm - kb_); } while (0)
#define SEAM_K0() do { VMWN(8); SWRITE_HK(0); SBAR(); } while (0)
    f32x16 pA0, pA1, pB0, pB1; float mnA, mnB, alA, alB; bf16x8 pa0, pa1, pa2, pa3;
    SWRITE_HV(0); SBAR();
    SLOAD_H(Kh, Vh, KBASE(1));
    SBAR(); qkt<0, NOBIAS>(pA0, pA1, K_lds, r32, hi, S.qr, BP(0));
    MASKT(pA0, pA1, 0); partialSM(pA0, pA1, m_reg, mnA, alA);
    VMW(); SWRITE_H(1);
    __syncthreads();
#define HALF_STEP(PX0, PX1, mnX, alX, PY0, PY1, alY, t, KB, VB, SB) do {                                                      \
        SBAR(); qkt<KB, NOBIAS>(PX0, PX1, K_lds, r32, hi, S.qr, BP(t));                                                               \
        finishSM(PY0, PY1, alY, l_reg, pa0, pa1, pa2, pa3); SBAR();                                                           \
        if ((t) + 1 < NT) { SLOAD_H(Kh, Vh, KBASE((t) + 1)); SBAR(); }                                                        \
        pv_tile<VB>(o, vb0, pa0, pa1, pa2, pa3); MASKT(PX0, PX1, (t)); partialSM(PX0, PX1, m_reg, mnX, alX);                  \
        __syncthreads();                                                                                                      \
        if ((t) + 1 < NT) { VMW(); SWRITE_H(SB); }                                                                            \
        RESC(alX); __syncthreads(); } while (0)
    for (int t = 1; t + 1 < NT; t += 2) {
        HALF_STEP(pB0, pB1, mnB, alB, pA0, pA1, alA, t, 1, 0, 0);
        HALF_STEP(pA0, pA1, mnA, alA, pB0, pB1, alB, t + 1, 0, 1, 1);
    }
    { SBAR(); qkt<1, NOBIAS>(pB0, pB1, K_lds, r32, hi, S.qr, BP(NT - 1)); SBAR(); }
    SLOAD_H(nxt.K, nxt.V, 0); SBAR();
    { int lq = lane; asm volatile("" : "+v"(lq));
#pragma unroll
    for (int d0 = 0; d0 < 8; ++d0) S.qr[d0] = load8((const bf16*)((const char*)(nxt.Q + (size_t)(wid * QBLK) * D) + (unsigned)(((lq & 31) * D + (lq >> 5) * 8) * 2)) + d0 * 16); }
    SBAR();
    finishSM(pA0, pA1, alA, l_reg, pa0, pa1, pa2, pa3); SBAR();
    pv_tile<0>(o, vb0, pa0, pa1, pa2, pa3);
    { MASKT(pB0, pB1, NT - 1); partialSM(pB0, pB1, m_reg, mnB, alB); __syncthreads(); RESC(alB);
      finishSM(pB0, pB1, alB, l_reg, pa0, pa1, pa2, pa3); SBAR(); pv_tile<1>(o, vb0, pa0, pa1, pa2, pa3); }
    SBAR(); SEAM_K0();
    { int le = lane; asm volatile("" : "+v"(le)); const int r32e = le & 31, hie = le >> 5;
    if (hie == 0) li_l[r32e] = l_reg; asm volatile("s_waitcnt lgkmcnt(0)" ::: "memory");
    float rli[16];
#pragma unroll
    for (int r = 0; r < 16; ++r) rli[r] = __builtin_amdgcn_rcpf(li_l[crow(r, hie)]);
    bf16* Ow = cur.O + (size_t)(wid * QBLK) * OS; char* stg = lds + LDS_OST + wid * OST_WAVE;
#pragma unroll
    for (int p = 0; p < 2; ++p) {
#pragma unroll
        for (int j = 0; j < 8; ++j) { const int r = 8 * p + j, lrow = (j & 3) + 8 * (j >> 2) + 4 * hie;
#pragma unroll
            for (int d0 = 0; d0 < 4; ++d0) { const float v = o[d0][r] * rli[r]; *(unsigned short*)(stg + lrow * 272 + (32 * d0 + r32e) * 2) = (unsigned short)cvtpk(v, v); } }
        asm volatile("s_waitcnt lgkmcnt(0)" ::: "memory");
#pragma unroll
        for (int i = 0; i < 4; ++i) { const int row = (le >> 4) + 4 * i, c = le & 15; const u32x4 w = *(const u32x4*)(stg + row * 272 + c * 16);
#if defined(MK_ASMST) && MK_ASMST == 2
            asm volatile("global_store_dwordx4 %0, %1, off\n\ts_nop 1" :: "v"(Ow + (size_t)(16 * p + row) * OS + c * 8), "v"(w) : "memory"); }
#elif !defined(MK_ASMST) || MK_ASMST
            asm volatile("global_store_dwordx4 %0, %1, off sc1\n\ts_nop 1" :: "v"(Ow + (size_t)(16 * p + row) * OS + c * 8), "v"(w) : "memory"); }
#else
            *(u32x4*)(Ow + (size_t)(16 * p + row) * OS + c * 8) = w; }
#endif
        asm volatile("s_waitcnt lgkmcnt(0)" ::: "memory");
    } }
    __syncthreads();
#undef RESC
#undef KBASE
#undef BP
#undef MASKT
#undef SEAM_K0
#undef HALF_STEP
}
#undef ROW
#undef VMW
#undef VMWN
#undef SLOAD_H
#undef SWRITE_HK
#undef SWRITE_HV
#undef SWRITE_H

template <bool MOBA, bool NOBIAS = false>
__device__ __forceinline__ void attn_phase(char* lds, const bf16* Q, const bf16* K, const bf16* V, bf16* O, const float* biasG, const unsigned* selG, const int wave) {
    const int G = gridDim.x; int idx = blockIdx.x; if (idx >= 256) return;
    auto ref = [&](int id, int pass) { const int xcd = id & 7, k = id >> 3, bh = xcd * 8 + (k >> 2), y = k & 3, qb = pass ? 7 - y : y, b = bh >> 4, h = bh & 15;
        BlockRef r; r.Q = Q + ((size_t)bh * SEQ + (size_t)qb * QB) * D; r.K = K + (size_t)bh * SEQ * D; r.V = V + (size_t)bh * SEQ * D;
        r.O = O + ((size_t)b * SEQ + (size_t)qb * QB) * OS + h * D; r.P0 = qb * QB; r.bh = bh; return r; };
    int pass = 0; BlockRef cur = ref(idx, 0);
    Seam S;
    attn_prime(cur, lds, S, wave);
    for (;;) {
        const bool more_pass = pass == 0, more_item = idx + G < 256, last = !more_pass && !more_item;
        int idn = idx, passn = pass + 1; if (!more_pass) { passn = 0; idn = more_item ? idx + G : idx; }
        const BlockRef nxt = last ? cur : ref(idn, passn);
        attn_block<MOBA, NOBIAS>(cur, nxt, lds, S, biasG, selG, wave);
        if (last) break;
        cur = nxt; idx = idn; pass = passn;
    }
}
}
constexpr int NWAVES = 8;
constexpr int BATCH = 4, SEQ = 2048, DM = 2048, M = BATCH * SEQ, FF = 5632, NH = 16, HD = 128, PLE = 256, DEPTH = 4;
constexpr size_t MiB = 1u << 20;
constexpr size_t WS_CTL = 0, CTL_ZERO_BYTES = 32768;
constexpr size_t WS_WFI = 1 * MiB;
constexpr size_t WS_WFO = WS_WFI + 352 * MiB;
constexpr size_t WS_WPG = WS_WFO + 176 * MiB;
constexpr size_t WS_WPP = WS_WPG + 32 * MiB;
constexpr size_t WS_WQKV = WS_WPP + 4 * MiB;
constexpr size_t WS_WO = WS_WQKV + 72 * MiB;
constexpr size_t WS_WS5I = WS_WO + 24 * MiB;
constexpr size_t WS_WGLU = WS_WS5I + 8 * MiB;
constexpr size_t WS_S5TV = WS_WGLU + 16 * MiB;
constexpr size_t WS_S5W = WS_S5TV + 80 * MiB;
constexpr size_t WS_WFT = WS_S5W + 32 * MiB;
constexpr size_t WS_H = WS_WFT + 1 * MiB;
constexpr size_t WS_HB = WS_H + 64 * MiB;
constexpr size_t WS_ACT = WS_HB + 32 * MiB;
constexpr size_t WS_QKV = WS_ACT + 88 * MiB;
constexpr size_t WS_OB = WS_QKV + 96 * MiB;
constexpr size_t WS_SSQ = WS_OB + 32 * MiB;
constexpr size_t WS_PP = WS_SSQ + 1 * MiB;
constexpr size_t WS_PBF = WS_PP + 128 * MiB;
constexpr size_t WS_LOGF = WS_PBF + 16 * MiB;
constexpr size_t WS_KMEAN = WS_LOGF + 1 * MiB;
constexpr size_t WS_UH = WS_KMEAN + 1 * MiB;
constexpr size_t WS_HLOC = WS_UH + 40 * MiB;
constexpr size_t WS_YB = WS_HLOC + 16 * MiB;
constexpr size_t WS_HB2 = WS_YB + 32 * MiB;
constexpr size_t WS_H2 = WS_HB2 + 32 * MiB;
constexpr size_t WS_BIAS = WS_H2 + 64 * MiB;
constexpr size_t WS_SEL = WS_BIAS + 1 * MiB;
constexpr size_t WS_END = WS_SEL + 1 * MiB;
constexpr int CW_TAIL = 3072, CW_BATCH = 3328, CW_PP = 3584, CW_S5U = 3648, CW_S5G = 3776;
constexpr int CW_BAR = 4096;
constexpr int RING_OFF = 0, RING_BYTES = 131072, EPI_OFF = 131072, LDSCTL_OFF = 139264, MISC_OFF = LDSCTL_OFF + 320, LDS_BYTES = 147456;
static_assert(att::LDS_BYTES <= RING_BYTES && pg8::EPI_LDS_OFF == EPI_OFF, "LDS map");

#define GAS __attribute__((address_space(1)))
#define LAS __attribute__((address_space(3)))
typedef unsigned short bf16;
typedef unsigned v4u __attribute__((ext_vector_type(4)));
typedef unsigned v2u __attribute__((ext_vector_type(2)));
typedef float f32x4 __attribute__((ext_vector_type(4)));
typedef float f32x2 __attribute__((ext_vector_type(2)));
typedef GAS unsigned gu32;
#define RLX_AGENT __ATOMIC_RELAXED, __HIP_MEMORY_SCOPE_AGENT
#define LDS_WAIT() asm volatile("s_waitcnt lgkmcnt(0)" ::: "memory")
#define VM_WAIT() asm volatile("s_waitcnt vmcnt(0)" ::: "memory")
__device__ __forceinline__ unsigned f2bf(float f) { unsigned u = __builtin_bit_cast(unsigned, f); return (u + 0x7fffu + ((u >> 16) & 1u)) >> 16; }
__device__ __forceinline__ unsigned pk2(float lo, float hi) { return f2bf(lo) | (f2bf(hi) << 16); }
__device__ __forceinline__ float wave_sum(float v) {
#pragma unroll
    for (int o = 1; o < 64; o <<= 1) v += __shfl_xor(v, o);
    return v;
}

#define XB_TMO      128
#define XB_XCNT(j)  (256  + 64 * (j))
#define XB_XSUB(j)  (1280 + 64 * (j))
#define XB_XGEN(j)  (2304 + 64 * (j))
#define XB_TOP      3328
#define XB_TOPGEN   3392
#define XCD_BAR_WORDS 3456
#define XB_SPIN_CAP (1u << 18)

__device__ __forceinline__ unsigned xb_ld(unsigned* p)              { return __hip_atomic_load(p, __ATOMIC_RELAXED, __HIP_MEMORY_SCOPE_AGENT); }
__device__ __forceinline__ unsigned xb_add(unsigned* p, unsigned v) { return __hip_atomic_fetch_add(p, v, __ATOMIC_RELAXED, __HIP_MEMORY_SCOPE_AGENT); }
__device__ __forceinline__ unsigned xb_xcc_id() { return (unsigned)__builtin_amdgcn_s_getreg((3 << 11) | 20) & 0xFu; }
#define XB_SPIN(cond, bar) do { unsigned _sp = 0; while (cond) { __builtin_amdgcn_s_sleep(1); \
    if ((++_sp & 255u) == 0u) { if (xb_ld(&(bar)[XB_TMO])) break; if (_sp > XB_SPIN_CAP) { atomicAdd(&(bar)[XB_TMO], 1u); break; } } } } while (0)

struct XcdBarrier {
    unsigned* bar; unsigned x;
    volatile LAS unsigned* st;
};

__device__ __forceinline__ XcdBarrier xcd_barrier_post(unsigned* bar, volatile LAS unsigned* st, int wave) {
    XcdBarrier b; b.bar = bar; b.x = xb_xcc_id(); b.st = st;
    if (XB_TID == 0) (void)xb_add(&bar[XB_XCNT(b.x)], 1u);
    return b;
}
__device__ __forceinline__ void xcd_barrier_complete(unsigned* bar, unsigned x, unsigned& nloc, unsigned& nx) {
    const unsigned G = gridDim.x * gridDim.y * gridDim.z;
    unsigned sum, cnt, mine, sp = 0u;
    for (;;) {
        sum = 0u; cnt = 0u; mine = 0u;
#pragma unroll
        for (unsigned j = 0; j < 16; ++j) { const unsigned c = xb_ld(&bar[XB_XCNT(j)]); sum += c; cnt += (c > 0u) ? 1u : 0u; mine = (j == x) ? c : mine; }
        if (sum == G) break;
        __builtin_amdgcn_s_sleep(1);
        if ((++sp & 255u) == 0u) { if (xb_ld(&bar[XB_TMO])) break; if (sp > XB_SPIN_CAP) { atomicAdd(&bar[XB_TMO], 1u); break; } }
    }
    nloc = mine > 0u ? mine : 1u; nx = cnt > 0u ? cnt : 1u;
}

__device__ __forceinline__ void xcd_barrier(const XcdBarrier& b, int wave) {
    asm volatile("s_waitcnt vmcnt(0)" ::: "memory");
    __syncthreads();
    if (XB_TID == 0) {
        unsigned* bar = b.bar;
        __builtin_amdgcn_s_waitcnt(0);
        unsigned nloc = b.st[0], nx = b.st[1];
        if (nloc == 0u) { xcd_barrier_complete(bar, b.x, nloc, nx); b.st[0] = nloc; b.st[1] = nx; }
        const unsigned old = xb_add(&bar[XB_XSUB(b.x)], 1u);
        const unsigned gen = old / nloc;
        if (old + 1u == (gen + 1u) * nloc) {
            __builtin_amdgcn_fence(__ATOMIC_RELEASE, "agent");
            asm volatile("s_waitcnt vmcnt(0)" ::: "memory");
            const unsigned og = xb_add(&bar[XB_TOP], 1u);
            const unsigned tg = og / nx;
            if (og + 1u == (tg + 1u) * nx) xb_add(&bar[XB_TOPGEN], 1u);
            else XB_SPIN(xb_ld(&bar[XB_TOPGEN]) == tg, bar);
            __builtin_amdgcn_fence(__ATOMIC_ACQUIRE, "agent");
            xb_add(&bar[XB_XGEN(b.x)], 1u);
            asm volatile("s_waitcnt vmcnt(0)" ::: "memory");
        } else {
            XB_SPIN(xb_ld(&bar[XB_XGEN(b.x)]) == gen, bar);
            __builtin_amdgcn_fence(__ATOMIC_ACQUIRE, "agent");
            asm volatile("s_waitcnt vmcnt(0)" ::: "memory");
        }
    }
    __syncthreads();
}

struct Args { const float* in[23]; float* out; unsigned char* ws; int ph_lo, ph_hi; };

__device__ __forceinline__ void panel_wait(unsigned* cnt, unsigned target, unsigned* bar, int wave) {
    asm volatile("" : "+s"(wave));
    if (wave == 0) {
        unsigned sp = 0u;
        while ((unsigned)__builtin_amdgcn_readfirstlane((int)__hip_atomic_load(cnt, __ATOMIC_RELAXED, __HIP_MEMORY_SCOPE_AGENT)) < target) {
            __builtin_amdgcn_s_sleep(1);
            if ((++sp & 255u) == 0u) { if (xb_ld(&bar[XB_TMO])) break; if (sp > XB_SPIN_CAP) { atomicAdd(&bar[XB_TMO], 1u); break; } }
        }
        __builtin_amdgcn_fence(__ATOMIC_ACQUIRE, "agent");
        asm volatile("s_waitcnt vmcnt(0)" ::: "memory");
    }
    __syncthreads();
}

#ifndef MK_ASMST
#define MK_ASMST 1
#endif
#if MK_ASMST == 2
__device__ __forceinline__ void st_wt16(void* p, v4u v) { asm volatile("global_store_dwordx4 %0, %1, off\n\ts_nop 1" :: "v"(p), "v"(v) : "memory"); }
#elif MK_ASMST
__device__ __forceinline__ void st_wt16(void* p, v4u v) { asm volatile("global_store_dwordx4 %0, %1, off sc1\n\ts_nop 1" :: "v"(p), "v"(v) : "memory"); }
#else
__device__ __forceinline__ void st_wt16(void* p, v4u v) { *(v4u*)p = v; }
#endif
__device__ __forceinline__ void st_wt16_nt(void* p, v4u v) { asm volatile("global_store_dwordx4 %0, %1, off sc1 nt\n\ts_nop 1" :: "v"(p), "v"(v) : "memory"); }
__device__ __forceinline__ void st_wt4(void* p, unsigned v) { __hip_atomic_store((unsigned*)p, v, __ATOMIC_RELAXED, __HIP_MEMORY_SCOPE_AGENT); }
__device__ __forceinline__ void cnt_arrive(unsigned* cnt, int lane, int wave) {
    asm volatile("s_waitcnt vmcnt(0)" : "+s"(cnt), "+s"(wave) :: "memory");
    __syncthreads();
    if (wave == 0 && lane == 0) __hip_atomic_fetch_add(cnt, 1u, __ATOMIC_RELAXED, __HIP_MEMORY_SCOPE_AGENT);
}
struct TrD { const float* src; bf16* dst; const float* scale; int ld, K, n0, k0, drow0; };
__device__ __forceinline__ void tr_ld(const TrD& d, f32x4 (&v)[16], int lane) {
    asm volatile("" : "+v"(lane));
    const int kr = lane >> 4, n4 = lane & 15;
#pragma unroll
    for (int i = 0; i < 16; ++i) v[i] = __builtin_nontemporal_load((const f32x4*)(d.src + (size_t)(d.k0 + 4 * i + kr) * d.ld + d.n0 + 4 * n4));
}
template <bool WT>
__device__ __forceinline__ void tr_fin(const TrD& d, const f32x4 (&v)[16], LAS float* scr, int lane) {
    asm volatile("" : "+v"(lane));
    const int kr = lane >> 4, n4 = lane & 15; const int K = d.K, k0 = d.k0;
#pragma unroll
    for (int i = 0; i < 16; ++i) { LAS float* p = scr + (4 * i + kr) * 65 + 4 * n4; p[0] = v[i][0]; p[1] = v[i][1]; p[2] = v[i][2]; p[3] = v[i][3]; }
    LDS_WAIT(); asm volatile("" ::: "memory");
    const int c = lane & 7, nn = lane >> 3;
    f32x4 s0 = (f32x4){1.f, 1.f, 1.f, 1.f}, s1 = s0;
    if (d.scale) { s0 = *(const f32x4*)(d.scale + k0 + 8 * c); s1 = *(const f32x4*)(d.scale + k0 + 8 * c + 4); }
#pragma unroll
    for (int j = 0; j < 8; ++j) { const int n = nn + 8 * j; const LAS float* s = scr + (8 * c) * 65 + n;
        v4u o; o.x = pk2(s[0 * 65] * s0[0], s[1 * 65] * s0[1]); o.y = pk2(s[2 * 65] * s0[2], s[3 * 65] * s0[3]); o.z = pk2(s[4 * 65] * s1[0], s[5 * 65] * s1[1]); o.w = pk2(s[6 * 65] * s1[2], s[7 * 65] * s1[3]);
#ifndef MK_TAILFENCE
#define MK_TAILFENCE 0
#endif
        if (WT && !MK_TAILFENCE) st_wt16(d.dst + (size_t)(d.drow0 + n) * K + k0 + 8 * c, o); else __builtin_nontemporal_store(o, (v4u*)(d.dst + (size_t)(d.drow0 + n) * K + k0 + 8 * c)); }
    LDS_WAIT(); asm volatile("" ::: "memory");
}
template <bool WT>
__device__ __forceinline__ void tr_item(const float* __restrict__ src, int ld, int K, bf16* __restrict__ dst, const float* __restrict__ scale, int n0, int k0, int drow0, LAS float* scr, int lane) {
    const TrD d{src, dst, scale, ld, K, n0, k0, drow0}; f32x4 v[16]; tr_ld(d, v, lane); tr_fin<WT>(d, v, scr, lane);
}
template <bool WT = false, bool DESC = false>
__device__ __forceinline__ void tr_job(const float* src, int ld, int K, int N, bf16* dst, const float* scale, int ilv, int r, LAS float* scr, int lane, TrD* out = nullptr) {
#ifdef MK_CV18
    const int nb = N / 64, sb = r >> 3, j8 = r & 7; const bool k8 = ((K >> 6) & 7) == 0;
    const int kb = k8 ? (sb / nb) * 8 + j8 : (sb / (nb >> 1)) * 4 + (j8 >> 1), nbi = k8 ? sb % nb : (sb % (nb >> 1)) * 2 + (j8 & 1), n0 = nbi * 64;
#else
    const int nb = N / 64, sb = r >> 3, j8 = r & 7, kb = (sb / (nb >> 1)) * 4 + (j8 >> 1), nbi = (sb % (nb >> 1)) * 2 + (j8 & 1), n0 = nbi * 64;
#endif
    int drow0 = n0;
    if (ilv) { const int hsel = n0 >= ilv ? 1 : 0, nn = n0 - hsel * ilv; drow0 = (nn >> 7) * 256 + hsel * 128 + (nn & 127); }
    if (DESC) *out = TrD{src, dst, scale, ld, K, n0, kb * 64, drow0}; else tr_item<WT>(src, ld, K, dst, scale, n0, kb * 64, drow0, scr, lane);
}

__device__ __forceinline__ void s5_ops_group(const Args& a, int g, LAS float* L, int tid) {
    const float* a_re = a.in[14]; const float* a_im = a.in[15]; const float* log_dt = a.in[16]; const float* b_re = a.in[17]; const float* b_im = a.in[18];
    const float* c_re = a.in[19]; const float* c_im = a.in[20]; const float* dsk = a.in[21];
    LAS float* apr = L; LAS float* api = L + 2112; LAS float* qr = L + 4224; LAS float* qi = qr + 64; LAS float* Cr = qi + 64; LAS float* Ci = Cr + 1024;
    LAS float* Br = Ci + 1024; LAS float* Bi = Br + 1024; LAS float* Kt = Bi + 1024;
    bf16* TV = (bf16*)(a.ws + WS_S5TV) + (size_t)g * 512 * 640; bf16* W = (bf16*)(a.ws + WS_S5W) + (size_t)g * 256 * 512;
    const float dt = expf(log_dt[g]);
    for (int idx = tid; idx < 33 * 64; idx += 512) { const int tau = idx >> 6, p = idx & 63; const float ar = a_re[g * 64 + p], ai = a_im[g * 64 + p];
        const float mag = expf(ar * dt * (float)tau); float sn, cs; sincosf(ai * dt * (float)tau, &sn, &cs); apr[idx] = mag * cs; api[idx] = mag * sn; }
    if (tid < 64) { const float ar = a_re[g * 64 + tid], ai = a_im[g * 64 + tid]; const float er = expf(ar * dt); float sn, cs; sincosf(ai * dt, &sn, &cs);
        const float nr = er * cs - 1.f, ni = er * sn, den = ar * ar + ai * ai; qr[tid] = (nr * ar + ni * ai) / den; qi[tid] = (ni * ar - nr * ai) / den; }
    for (int idx = tid; idx < 1024; idx += 512) { Cr[idx] = c_re[(size_t)g * 1024 + idx]; Ci[idx] = c_im[(size_t)g * 1024 + idx]; }
    __syncthreads();
    for (int idx = tid; idx < 1024; idx += 512) { const int p = idx >> 4; const float br = b_re[(size_t)g * 1024 + idx], bi = b_im[(size_t)g * 1024 + idx];
        Br[idx] = qr[p] * br - qi[p] * bi; Bi[idx] = qr[p] * bi + qi[p] * br; }
    __syncthreads();
    for (int idx = tid; idx < 32 * 256; idx += 512) { const int tau = idx >> 8, c = (idx >> 4) & 15, cp = idx & 15; float s = 0.f;
        for (int p = 0; p < 64; ++p) { const float ar_ = apr[tau * 64 + p], ai_ = api[tau * 64 + p], br = Br[p * 16 + cp], bi = Bi[p * 16 + cp];
            const float xr = ar_ * br - ai_ * bi, xi = ar_ * bi + ai_ * br; s += Cr[c * 64 + p] * xr - Ci[c * 64 + p] * xi; }
        if (tau == 0 && c == cp) s += dsk[g * 16 + c];
        Kt[idx] = s; }
    __syncthreads();
    for (int idx = tid; idx < 512 * 80; idx += 512) { const int n = idx / 80, ch = idx % 80, j = n >> 4, c = n & 15; float o[8];
        if (ch < 64) { const int jp = ch >> 1, c0 = (ch & 1) * 8;
#pragma unroll
            for (int e = 0; e < 8; ++e) o[e] = (jp <= j) ? Kt[(j - jp) * 256 + c * 16 + c0 + e] : 0.f; }
        else { const int p0 = (ch - 64) * 4;
#pragma unroll
            for (int e = 0; e < 4; ++e) { const int p = p0 + e; const float ar_ = apr[(j + 1) * 64 + p], ai_ = api[(j + 1) * 64 + p], cr = Cr[c * 64 + p], ci = Ci[c * 64 + p];
                o[2 * e] = cr * ar_ - ci * ai_; o[2 * e + 1] = -(cr * ai_ + ci * ar_); } }
        v4u w; w.x = pk2(o[0], o[1]); w.y = pk2(o[2], o[3]); w.z = pk2(o[4], o[5]); w.w = pk2(o[6], o[7]);
        *(v4u*)(TV + (size_t)n * 640 + ch * 8) = w; }
    for (int idx = tid; idx < 128 * 64; idx += 512) { const int n = idx >> 6, ch = idx & 63, p = n >> 1, ri = n & 1, jp = ch >> 1, c0 = (ch & 1) * 8; float o[8];
        const float ar_ = apr[(31 - jp) * 64 + p], ai_ = api[(31 - jp) * 64 + p];
#pragma unroll
        for (int e = 0; e < 8; ++e) { const float br = Br[p * 16 + c0 + e], bi = Bi[p * 16 + c0 + e]; o[e] = ri ? (ar_ * bi + ai_ * br) : (ar_ * br - ai_ * bi); }
        v4u w; w.x = pk2(o[0], o[1]); w.y = pk2(o[2], o[3]); w.z = pk2(o[4], o[5]); w.w = pk2(o[6], o[7]);
        *(v4u*)(W + (size_t)n * 512 + ch * 8) = w; }
    __syncthreads();
}

namespace cv {
constexpr int I_FI = 32 * 176, I_FO = 88 * 32, I_PG = 32 * 32, I_QKV = 32 * 96, I_WO = 32 * 32, I_S5I = 32 * 32, I_GLU = 32 * 64, I_WF = 16;
constexpr int mix_items(int L) { return (L % 3 == 0) ? I_QKV + I_WO + I_WF : ((L % 3 == 1) ? I_QKV + I_WO : I_S5I + I_GLU); }
constexpr int layer_items(int L) { return 2 * I_FI + 2 * I_FO + I_PG + mix_items(L); }
constexpr int layer_start(int L) { int s = 0; for (int l = 0; l < L; ++l) s += layer_items(l); return s; }
constexpr int TOTAL = layer_start(4);
constexpr int pos_after(int L, int h) { return layer_start(L) + I_FI + (h ? I_FO + mix_items(L) + I_FI : 0); }
#ifndef MK_TAILQ
#define MK_TAILQ 7
#endif
constexpr int TAIL_WAVES = 128 * NWAVES, QTOT = MK_TAILQ * TAIL_WAVES;
constexpr int tail_b(int k) { int hi = TOTAL; for (int j = 7; j > k; --j) { const int pa = pos_after(j >> 1, j & 1); const int a = (hi - QTOT > pa) ? hi - QTOT : pa; hi = a < hi ? a : hi; } return hi; }
constexpr int tail_a(int k) { const int hi = tail_b(k), pa = pos_after(k >> 1, k & 1); const int a = (hi - QTOT > pa) ? hi - QTOT : pa; return a < hi ? a : hi; }
}
template <bool WT = false, bool DESC = false>
__device__ __forceinline__ bool cv_item(const Args& a, int idx, LAS float* scr, int lane, TrD* out = nullptr) {
    using namespace cv;
    const float* norm_g = a.in[2]; unsigned char* ws = a.ws;
    const int L = idx >= layer_start(3) ? 3 : (idx >= layer_start(2) ? 2 : (idx >= layer_start(1) ? 1 : 0));
    int r = idx - (L == 3 ? layer_start(3) : (L == 2 ? layer_start(2) : (L == 1 ? layer_start(1) : 0)));
    const int kind = L % 3, mixn = kind == 0 ? I_QKV + I_WO + I_WF : (kind == 1 ? I_QKV + I_WO : I_S5I + I_GLU);
    int half = 0;
    if (r >= I_FI + I_FO + mixn) { r -= I_FI + I_FO + mixn; half = 1; if (r >= I_FI + I_FO) {
            r -= I_FI + I_FO; tr_job<WT, DESC>(a.in[6] + (size_t)L * DM * DM, DM, DM, DM, (bf16*)(ws + WS_WPG) + (size_t)L * DM * DM, norm_g + (L * 4 + 3) * DM, 0, r, scr, lane, out); return true; } }
    else if (r >= I_FI + I_FO) { r -= I_FI + I_FO;
        if (kind < 2) { const int m = L == 0 ? 0 : (L == 1 ? 1 : 2);
            if (kind == 0) { if (r >= I_WF) r -= I_WF; else { if (DESC) return false;
                const int j = m >> 1, hd = r; const float* src = a.in[8] + (size_t)j * DM * (3 * DM + NH) + 3 * DM + hd; const float* g1 = norm_g + (L * 4 + 1) * DM;
                bf16* dst = (bf16*)(ws + WS_WFT) + (size_t)j * 2 * 16 * DM + (size_t)hd * DM;
                for (int k = 2 * lane; k < DM; k += 128) { const float w0 = g1[k] * src[(size_t)k * (3 * DM + NH)], w1 = g1[k + 1] * src[(size_t)(k + 1) * (3 * DM + NH)];
                    const unsigned h0 = f2bf(w0), h1 = f2bf(w1); const unsigned l0 = f2bf(w0 - __uint_as_float(h0 << 16)), l1 = f2bf(w1 - __uint_as_float(h1 << 16));
                    st_wt4(dst + k, h0 | (h1 << 16)); st_wt4(dst + 16 * DM + k, l0 | (l1 << 16)); }
                return true; } }
            if (r < I_QKV) { const float* src = m == 1 ? a.in[11] : a.in[8] + (size_t)(m >> 1) * DM * (3 * DM + NH); const int ld = m == 1 ? 3 * DM : 3 * DM + NH;
                tr_job<WT, DESC>(src, ld, DM, 3 * DM, (bf16*)(ws + WS_WQKV) + (size_t)m * 3 * DM * DM, norm_g + (L * 4 + 1) * DM, 0, r, scr, lane, out); return true; } r -= I_QKV;
            if (r < I_WO) { const float* src = m == 1 ? a.in[12] : a.in[10] + (size_t)(m >> 1) * DM * DM;
                tr_job<WT, DESC>(src, DM, DM, DM, (bf16*)(ws + WS_WO) + (size_t)m * DM * DM, nullptr, 0, r, scr, lane, out); return true; } }
        if (r < I_S5I) { tr_job<WT, DESC>(a.in[13], DM, DM, DM, (bf16*)(ws + WS_WS5I), norm_g + (2 * 4 + 1) * DM, 0, r, scr, lane, out); return true; } r -= I_S5I;
        tr_job<WT, DESC>(a.in[22], 2 * DM, DM, 2 * DM, (bf16*)(ws + WS_WGLU), nullptr, DM, r, scr, lane, out); return true; }
    const int m = L * 2 + half;
    if (r < I_FI) { tr_job<WT, DESC>(a.in[4] + (size_t)m * DM * 2 * FF, 2 * FF, DM, 2 * FF, (bf16*)(ws + WS_WFI) + (size_t)m * 2 * FF * DM, norm_g + (L * 4 + half * 2) * DM, FF, r, scr, lane, out); return true; }
    r -= I_FI;
    tr_job<WT, DESC>(a.in[5] + (size_t)m * FF * DM, DM, FF, DM, (bf16*)(ws + WS_WFO) + (size_t)m * DM * FF, nullptr, 0, r, scr, lane, out); return true;
}
#ifndef MK_CVPIPE
#define MK_CVPIPE 0
#endif
template <bool WT>
__device__ __forceinline__ void cv_range(const Args& a, int it, int hi, int step, LAS float* scr, int lane) {
#if MK_CVPIPE
    if (WT && MK_CVPIPE < 2) { for (; it < hi; it += step) cv_item<WT>(a, it, scr, lane); return; }
    if (it >= hi) return;
    TrD dc; f32x4 vc[16]; bool wfc = !cv_item<WT, true>(a, it, scr, lane, &dc);
    if (!wfc) tr_ld(dc, vc, lane);
    for (;;) {
        const int nx = it + step; const bool hn = nx < hi; TrD dn = dc; f32x4 vn[16]; bool wfn = false;
        if (hn) { wfn = !cv_item<WT, true>(a, nx, scr, lane, &dn); if (!wfn) tr_ld(dn, vn, lane); }
        if (wfc) cv_item<WT, false>(a, it, scr, lane); else tr_fin<WT>(dc, vc, scr, lane);
        if (!hn) break;
        dc = dn; wfc = wfn; it = nx;
#pragma unroll
        for (int i = 0; i < 16; ++i) vc[i] = vn[i];
    }
#else
    for (; it < hi; it += step) cv_item<WT>(a, it, scr, lane);
#endif
}
__device__ __forceinline__ void cv_tail(const Args& a, int k, LAS unsigned char* lds, int lane, int wave, int bx, int G) {
    if (G != 256 || bx < 128) return;
    int lo_ = 0, hi_ = 0;
    switch (k) { case 0: lo_ = cv::tail_a(0); hi_ = cv::tail_b(0); break; case 1: lo_ = cv::tail_a(1); hi_ = cv::tail_b(1); break; case 2: lo_ = cv::tail_a(2); hi_ = cv::tail_b(2); break;
                 case 3: lo_ = cv::tail_a(3); hi_ = cv::tail_b(3); break; case 4: lo_ = cv::tail_a(4); hi_ = cv::tail_b(4); break; case 5: lo_ = cv::tail_a(5); hi_ = cv::tail_b(5); break;
                 case 6: lo_ = cv::tail_a(6); hi_ = cv::tail_b(6); break; default: lo_ = cv::tail_a(7); hi_ = cv::tail_b(7); break; }
    LAS float* scr = (LAS float*)(lds + wave * 16640);
    cv_range<true>(a, lo_ + (bx - 128) * NWAVES + wave, hi_, cv::TAIL_WAVES, scr, lane);
#if MK_TAILFENCE
    { unsigned* cnt_ = (unsigned*)(a.ws + WS_CTL) + CW_TAIL + 32 * k; int w_ = wave; asm volatile("s_waitcnt vmcnt(0)" : "+s"(cnt_), "+s"(w_) :: "memory"); __syncthreads();
      if (w_ == 0) { __builtin_amdgcn_fence(__ATOMIC_RELEASE, "agent"); asm volatile("s_waitcnt vmcnt(0)" ::: "memory"); if (lane == 0) __hip_atomic_fetch_add(cnt_, 1u, __ATOMIC_RELAXED, __HIP_MEMORY_SCOPE_AGENT); } }
#else
    cnt_arrive((unsigned*)(a.ws + WS_CTL) + CW_TAIL + 32 * k, lane, wave);
#endif
}
__device__ __forceinline__ void moba_bias_phase(float* bias, int lane, int gw, int NGW) {
    for (int task = gw; task < 64 * 8; task += NGW) { const int bh = task >> 3, s0 = (task & 7) * 256 + 4 * lane;
        const float sl = exp2f(-0.5f * (float)((bh & 15) + 1)) * (1.0f / att::SCALE);
        *(f32x4*)(bias + (size_t)bh * SEQ + s0) = (f32x4){sl * (float)s0, sl * (float)(s0 + 1), sl * (float)(s0 + 2), sl * (float)(s0 + 3)}; }
}
__device__ __forceinline__ void p0_prologue(const Args& a, LAS unsigned char* lds, int tid, int lane, int wave, int vcu, int G) {
    const float* x = a.in[0]; const float* p = a.in[1];
    unsigned char* ws = a.ws;
    for (int g = vcu; g < 128; g += G) s5_ops_group(a, g, (LAS float*)lds, tid);
    moba_bias_phase((float*)(ws + WS_BIAS), lane, vcu * NWAVES + wave, G * NWAVES);
    LAS float* scr = (LAS float*)(lds + wave * 16640);
    const int gw = vcu * NWAVES + wave, NGW = G * NWAVES;
    constexpr int I_PPJ = 4 * 32, I_X = M, I_P = 4 * M * PLE / 512;
    const int n_cv = (G == 256) ? cv::tail_a(0) : cv::TOTAL;
    const int NITEMS = n_cv + 4 * I_PPJ + I_X + I_P;
#ifndef MK_S5SKIP
#define MK_S5SKIP 3
#endif
    if (G == 256 && MK_S5SKIP > 0 && n_cv > 2048 * MK_S5SKIP) {
        if (vcu >= 128) cv_range<false>(a, gw - 1024, 2048 * MK_S5SKIP, 1024, scr, lane);
        cv_range<false>(a, 2048 * MK_S5SKIP + gw, n_cv, NGW, scr, lane);
    } else cv_range<false>(a, gw, n_cv, NGW, scr, lane);
    for (int it = gw + ((n_cv - gw + NGW - 1) / NGW) * NGW; it < NITEMS; it += NGW) {
        int r = it - n_cv;
        if (r < 4 * I_PPJ) { const int m = r / I_PPJ;
            tr_job(a.in[7] + (size_t)m * PLE * DM, DM, PLE, DM, (bf16*)(ws + WS_WPP) + (size_t)m * DM * PLE, nullptr, 0, r % I_PPJ, scr, lane); continue; } r -= 4 * I_PPJ;
        if (r < I_X) {
            const f32x4* xr = (const f32x4*)(x + (size_t)r * DM) + lane; f32x4 v[8]; float s = 0.f;
#pragma unroll
            for (int j = 0; j < 8; ++j) { v[j] = xr[64 * j]; s += (v[j][0] * v[j][0] + v[j][1] * v[j][1]) + (v[j][2] * v[j][2] + v[j][3] * v[j][3]); }
            s = wave_sum(s);
            v2u* o = (v2u*)((bf16*)(ws + WS_HB) + (size_t)r * DM) + lane;
#pragma unroll
            for (int j = 0; j < 8; ++j) { v2u w; w.x = pk2(v[j][0], v[j][1]); w.y = pk2(v[j][2], v[j][3]); o[64 * j] = w; }
            if (lane < 4) ((f32x4*)((float*)(ws + WS_SSQ) + (size_t)r * 16))[lane] = (f32x4){lane == 0 ? s : 0.f, 0.f, 0.f, 0.f};
            continue; } r -= I_X;
        {
            const f32x4* src = (const f32x4*)(p + (size_t)r * 512) + 2 * lane; const f32x4 v0 = src[0], v1 = src[1];
            v4u w; w.x = pk2(v0[0], v0[1]); w.y = pk2(v0[2], v0[3]); w.z = pk2(v1[0], v1[1]); w.w = pk2(v1[2], v1[3]);
            ((v4u*)((bf16*)(ws + WS_PBF) + (size_t)r * 512))[lane] = w; }
    }
}

__device__ __forceinline__ void fox_gate_phase(const bf16* Hb, const bf16* WfB, const float* bfv, const float* ssq, int np, float* logf, LAS unsigned char* lds, int lane, int wave, int bx, int G) {
    typedef short bf16x8_t __attribute__((ext_vector_type(8)));
    asm volatile("" : "+s"(bx), "+s"(wave));
    const int kq = wave & 3, kg = lane >> 4;
    LAS f32x4* pl = (LAS f32x4*)lds + (wave & 4) * 64 + lane;
    for (int t = (G == 256) ? 0 : bx; t < ((G == 256) ? 1 : M / 32); t += G) {
        const int rb = (G == 256) ? (4 * (bx & 7) + ((bx >> 3) & 3)) * 16 + 2 * (bx >> 5) + (wave >> 2) : 2 * t + (wave >> 2);
        const int row = rb * 16 + (lane & 15);
        const v4u* ap = (const v4u*)(Hb + (size_t)row * DM + kq * 512 + kg * 8); const v4u* bh = (const v4u*)(WfB + (size_t)(lane & 15) * DM + kq * 512 + kg * 8); const v4u* bl = bh + 16 * DM / 8;
        f32x4 acc = (f32x4){0.f, 0.f, 0.f, 0.f};
#pragma unroll 8
        for (int s = 0; s < 16; ++s) { const v4u a = ap[4 * s], h = bh[4 * s], l = bl[4 * s];
            acc = __builtin_amdgcn_mfma_f32_16x16x32_bf16(__builtin_bit_cast(bf16x8_t, h), __builtin_bit_cast(bf16x8_t, a), acc, 0, 0, 0);
            acc = __builtin_amdgcn_mfma_f32_16x16x32_bf16(__builtin_bit_cast(bf16x8_t, l), __builtin_bit_cast(bf16x8_t, a), acc, 0, 0, 0); }
        pl[kq * 64] = acc;
        __syncthreads();
        if (kq == 0) {
            acc = (pl[0] + pl[64]) + (pl[128] + pl[192]);
            const f32x4* sp = (const f32x4*)(ssq + (size_t)row * 16); f32x4 s4 = sp[0] + sp[1]; if (np > 8) s4 += sp[2] + sp[3];
            const float rstd = 1.0f / sqrtf(((s4[0] + s4[1]) + (s4[2] + s4[3])) * (1.0f / DM) + 1e-6f);
            const int b = row >> 11, tt = row & 2047;
#pragma unroll
            for (int i = 0; i < 4; ++i) { const int hd = 4 * kg + i; const float xg = acc[i] * rstd + bfv[hd];
                st_wt4(logf + (size_t)(b * 16 + hd) * SEQ + tt, __float_as_uint(fminf(xg, 0.f) - __logf(1.0f + __expf(-fabsf(xg)))));
            }
        }
        __syncthreads();
    }
}
__device__ __forceinline__ void moba_kmean_phase(const bf16* Kh, float* km, int lane, int gw, int NGW) {
    for (int task = gw; task < 2048; task += NGW) {
        const int rg = lane >> 4, ch = lane & 15; const bf16* base = Kh + ((size_t)task * 64 + rg) * HD + ch * 8; float s[8] = {0.f, 0.f, 0.f, 0.f, 0.f, 0.f, 0.f, 0.f};
        v4u w[16];
#pragma unroll
        for (int i = 0; i < 16; ++i) w[i] = *(const v4u*)(base + (size_t)i * 4 * HD);
#pragma unroll
        for (int i = 0; i < 16; ++i) {
            s[0] += __uint_as_float(w[i].x << 16); s[1] += __uint_as_float(w[i].x & 0xffff0000u); s[2] += __uint_as_float(w[i].y << 16); s[3] += __uint_as_float(w[i].y & 0xffff0000u);
            s[4] += __uint_as_float(w[i].z << 16); s[5] += __uint_as_float(w[i].z & 0xffff0000u); s[6] += __uint_as_float(w[i].w << 16); s[7] += __uint_as_float(w[i].w & 0xffff0000u); }
#pragma unroll
        for (int e = 0; e < 8; ++e) { s[e] += __shfl_xor(s[e], 16); s[e] += __shfl_xor(s[e], 32); }
        if (rg == 0) { float* o = km + (size_t)task * HD + ch * 8;
            st_wt16(o, __builtin_bit_cast(v4u, (f32x4){s[0], s[1], s[2], s[3]} * (1.f / 256.f))); st_wt16(o + 4, __builtin_bit_cast(v4u, (f32x4){s[4], s[5], s[6], s[7]} * (1.f / 256.f))); }
    }
}
__device__ __forceinline__ void moba_select_phase(const bf16* Qh, const float* km, unsigned* sel, LAS unsigned char* lds, int lane, int wave, int gw, int NGW) {
    LAS float* kl = (LAS float*)(lds + wave * 4096);
    for (int task = gw; task < 64 * 32; task += NGW) {
        const int bh = task >> 5, t0 = (task & 31) * 64, own = t0 >> 8;
        const bf16* qrow = Qh + ((size_t)bh * SEQ + t0 + lane) * HD; const float* kmb = km + (size_t)bh * 8 * 4 * HD;
#pragma unroll
        for (int n = 0; n < 7; ++n) if (n < own) { const float* kq = kmb + (size_t)n * 4 * HD + 2 * lane;
            *(LAS f32x2*)(kl + n * HD + 2 * lane) = (*(const f32x2*)kq + *(const f32x2*)(kq + HD)) + (*(const f32x2*)(kq + 2 * HD) + *(const f32x2*)(kq + 3 * HD)); }
        LDS_WAIT(); asm volatile("" ::: "memory");
        float gt[8];
#pragma unroll
        for (int n = 0; n < 8; ++n) gt[n] = 0.f;
#pragma unroll 2
        for (int c = 0; c < 16; ++c) { const v4u w = *(const v4u*)(qrow + c * 8); float q[8];
            q[0] = __uint_as_float(w.x << 16); q[1] = __uint_as_float(w.x & 0xffff0000u); q[2] = __uint_as_float(w.y << 16); q[3] = __uint_as_float(w.y & 0xffff0000u);
            q[4] = __uint_as_float(w.z << 16); q[5] = __uint_as_float(w.z & 0xffff0000u); q[6] = __uint_as_float(w.w << 16); q[7] = __uint_as_float(w.w & 0xffff0000u);
#pragma unroll
            for (int n = 0; n < 7; ++n) if (n < own) { const f32x4 k0 = *(const LAS f32x4*)(kl + n * HD + c * 8), k1 = *(const LAS f32x4*)(kl + n * HD + c * 8 + 4);
#pragma unroll
                for (int j = 0; j < 4; ++j) { gt[n] = fmaf(q[j], k0[j], gt[n]); gt[n] = fmaf(q[4 + j], k1[j], gt[n]); } } }
        unsigned m = 0u;
#pragma unroll
        for (int r = 0; r < 3; ++r) { int best = -1; float bv = -__builtin_inff();
#pragma unroll
            for (int n = 0; n < 7; ++n) if (n < own && !((m >> n) & 1u) && gt[n] > bv) { bv = gt[n]; best = n; }
            if (best >= 0) m |= 1u << best; }
        st_wt4(sel + (size_t)bh * SEQ + t0 + lane, m);
        LDS_WAIT(); asm volatile("" ::: "memory");
    }
}
__device__ __forceinline__ void s5_scan_phase(const Args& a, int lane, int task0, int tstep) {
    const float* a_re = a.in[14]; const float* a_im = a.in[15]; const float* log_dt = a.in[16];
    const float* Hl = (const float*)(a.ws + WS_HLOC); bf16* UH = (bf16*)(a.ws + WS_UH);
    for (int task = task0; task < 512; task += tstep) {
        const int g = task >> 2, b = task & 3, p = lane; const float dt = expf(log_dt[g]);
        const float mag = expf(a_re[g * 64 + p] * dt * 32.f); float sn, cs; sincosf(a_im[g * 64 + p] * dt * 32.f, &sn, &cs); const float ar = mag * cs, ai = mag * sn;
        float hr = 0.f, hi = 0.f;
#pragma unroll 8
        for (int k = 0; k < 64; ++k) { const size_t row = (size_t)g * 256 + b * 64 + k;
            st_wt4(UH + row * 640 + 512 + 2 * p, pk2(hr, hi));
            const f32x2 hl = *(const f32x2*)(Hl + row * 128 + 2 * p);
            const float nr = ar * hr - ai * hi + hl[0], ni = ar * hi + ai * hr + hl[1]; hr = nr; hi = ni; }
    }
}
__device__ __forceinline__ void final_norm_phase(const bf16* Hb, const float* ssq, const float* fg, float* out, int lane, int r0, int rend, int rstep) {
    for (int r = r0; r < rend; r += rstep) {
        const f32x4* sp = (const f32x4*)(ssq + (size_t)r * 16); const f32x4 s4 = sp[0] + sp[1];
        const float rstd = 1.0f / sqrtf(((s4[0] + s4[1]) + (s4[2] + s4[3])) * (1.0f / DM) + 1e-6f);
        const v4u* xr = (const v4u*)(Hb + (size_t)r * DM) + lane; const f32x4* gr = (const f32x4*)fg + 2 * lane; f32x4* o = (f32x4*)(out + (size_t)r * DM) + 2 * lane;
#pragma unroll
        for (int j = 0; j < 4; ++j) { const v4u w = xr[64 * j]; const f32x4 g0 = gr[128 * j], g1 = gr[128 * j + 1];
            f32x4 a, b; a[0] = __uint_as_float(w.x << 16); a[1] = __uint_as_float(w.x & 0xffff0000u); a[2] = __uint_as_float(w.y << 16); a[3] = __uint_as_float(w.y & 0xffff0000u);
            b[0] = __uint_as_float(w.z << 16); b[1] = __uint_as_float(w.z & 0xffff0000u); b[2] = __uint_as_float(w.w << 16); b[3] = __uint_as_float(w.w & 0xffff0000u);
            o[128 * j] = a * g0 * rstd; o[128 * j + 1] = b * g1 * rstd; }
    }
}
__device__ __forceinline__ int tail_a_rt(int k) {
    switch (k) { case 0: return cv::tail_a(0); case 1: return cv::tail_a(1); case 2: return cv::tail_a(2); case 3: return cv::tail_a(3); case 4: return cv::tail_a(4); case 5: return cv::tail_a(5);
                 case 6: return cv::tail_a(6); default: return cv::tail_a(7); }
}
__global__ void __launch_bounds__(NWAVES * 64, 2) mk_fwd(Args args) {
    extern __shared__ __attribute__((aligned(16))) unsigned char lds[];
    LAS unsigned char* L = (LAS unsigned char*)lds;
    volatile LAS unsigned* MISC = (volatile LAS unsigned*)(L + MISC_OFF);
    const int wave = __builtin_amdgcn_readfirstlane((int)threadIdx.x >> 6);
    const int tid = MK_TID();
#define TIDL() ({ int t_ = MK_TID(); asm volatile("" : "+v"(t_)); t_; })
    const int G = gridDim.x; const int bx = blockIdx.x; const int vcu = (G % 8 == 0) ? (bx % 8) * (G / 8) + bx / 8 : bx;
    const int gw = vcu * NWAVES + wave, NGW = G * NWAVES;
    unsigned char* ws = args.ws;
    unsigned* ctl = (unsigned*)(ws + WS_CTL);
    for (int u = tid; u < (LDS_BYTES - LDSCTL_OFF) / 4; u += NWAVES * 64) ((LAS unsigned*)(L + LDSCTL_OFF))[u] = 0u;
    __syncthreads();
    const int lo = args.ph_lo, hi = args.ph_hi;
    const bool single = (hi - lo) > 1;
    XcdBarrier bar; bar.bar = ctl + CW_BAR; bar.x = 0; bar.st = nullptr;
    if (single) bar = xcd_barrier_post(ctl + CW_BAR, MISC + 8, wave);
    int pc = 0;
#ifndef MK_SITES
#define MK_SITES 0xffffffu
#endif
#define SITE(n) (((MK_SITES >> (n)) & 1u) != 0u)
#define RUN() (pc >= lo && pc < hi)
#ifndef MK_REP_SITE
#define MK_REP_SITE -1
#endif
#ifndef MK_REP_N
#define MK_REP_N 1
#endif
#define REP(n) for (int rep_ = 0; rep_ < ((n) == MK_REP_SITE ? MK_REP_N : 1); ++rep_)
#ifndef MK_PANEL
#define MK_PANEL 1
#endif
    const bool pan = MK_PANEL && single && (G == 256);
    unsigned* const pcw = ctl + 1024 + 64 * (4 * (bx & 7) + ((bx >> 3) & 3));
    unsigned pdone = 0u; bool pw = false;
#define PCNT() ((pan && rep_ == 0) ? pcw : (unsigned*)nullptr)
#define PSEAM() do { if (pan) { pw = true; ++pc; } else SEAM(); } while (0)
#ifdef MK_BROKEN_NOWAIT
#define PWAIT() do { pw = false; } while (0)
#else
#define PWAIT() do { if (pw) { panel_wait(pcw, 8u * pdone, ctl + CW_BAR, wave); pw = false; } } while (0)
#endif
#ifdef MK_DBLBAR
#define SEAM() do { if (pc >= lo && pc + 1 < hi) { xcd_barrier(bar, wave); xcd_barrier(bar, wave); } ++pc; } while (0)
#else
#define SEAM() do { if (pc >= lo && pc + 1 < hi) xcd_barrier(bar, wave); ++pc; } while (0)
#endif
    unsigned* const bcw = ctl + CW_BATCH + 64 * ((bx & 7) >> 1);
    unsigned bdone = 0u;
    const int blw = (bx & 1) * 32 + (bx >> 3);
#ifndef MK_BATCH
#define MK_BATCH 1
#endif
    const bool bat = MK_BATCH && pan;
#ifndef MK_S5CNT
#define MK_S5CNT 0
#endif
    const bool s5c = MK_S5CNT && bat;
#define BCNT() ((bat && rep_ == 0) ? bcw : (unsigned*)nullptr)
#define BARRIVE() do { if (bat) cnt_arrive(bcw, TIDL() & 63, wave); } while (0)
#define BSEAM() do { if (bat) { ++bdone; panel_wait(bcw, 64u * bdone, ctl + CW_BAR, wave); ++pc; } else SEAM(); } while (0)
    const bool tails = (G == 256); int tw = 0, npos = 0;
#ifdef MK_TWGRID
#define TWAIT(n) do { npos += (n); if (tails) while (tw < 8 && tail_a_rt(tw) < npos) { xcd_barrier(bar, wave); ++tw; } } while (0)
#else
#define TWAIT(n) do { npos += (n); if (tails) while (tw < 8 && tail_a_rt(tw) < npos) { panel_wait(ctl + CW_TAIL + 32 * tw, 128u, ctl + CW_BAR, wave); ++tw; } } while (0)
#endif
#define ACT ((bf16*)(ws + WS_ACT))
#define QKV ((bf16*)(ws + WS_QKV))
#define OB ((bf16*)(ws + WS_OB))
#define PP ((bf16*)(ws + WS_PP))
#define LOGF ((float*)(ws + WS_LOGF))
#define KMEAN ((float*)(ws + WS_KMEAN))
#define UH ((bf16*)(ws + WS_UH))
#define HLOC ((float*)(ws + WS_HLOC))
#define YB ((bf16*)(ws + WS_YB))

    if (SITE(0) && RUN()) REP(0) { const int t = TIDL(); p0_prologue(args, L, t, t & 63, wave, vcu, G); }
    SEAM();
    if (SITE(1) && RUN()) REP(1) { pg8::Gemm g{(const bf16*)(ws + WS_PBF), (const bf16*)(ws + WS_WPP), PLE, PLE, PLE}; pg8::PpOrder S; S.init(G, bx);
        pg8::EpiBf16 E{PP, DM, nullptr, 0}; pg8::gemm_phase(L + RING_OFF, g, S, E, wave, (pan && rep_ == 0) ? ctl + CW_PP : (unsigned*)nullptr); }
    int np = 8, sel = 0;
#define HBR ((const bf16*)(ws + (sel ? WS_HB2 : WS_HB)))
#define HBW ((bf16*)(ws + (sel ? WS_HB : WS_HB2)))
#define SSQR ((const float*)(ws + WS_SSQ) + (sel ? M * 16 : 0))
#define SSQW ((float*)(ws + WS_SSQ) + (sel ? 0 : M * 16))
    for (int layer = 0; layer < DEPTH; ++layer) {
        const int kind = layer % 3;
        for (int half = 0; half < 2; ++half) {
#if defined(MK_EXP) && (MK_EXP == 1 || MK_EXP == 2 || MK_EXP == 3 || MK_EXP == 5 || MK_EXP == 6 || MK_EXP == 8 || MK_EXP == 9)
            if (RUN()) { pg8::Gemm g{HBR, (const bf16*)(ws + WS_WFI) + (size_t)(layer * 2 + half) * 2 * FF * DM, DM, DM, DM}; pg8::StaticOrder S; S.init(M, 2 * FF, G, bx);
#if MK_EXP == 2 || MK_EXP == 5 || MK_EXP == 6 || MK_EXP == 8 || MK_EXP == 9
                S.lim = 1280;
#endif
#if MK_EXP == 5
                S.pbmask = 3;
#endif
                pg8::EpiNone E{(float*)(ws + WS_CTL), (int)(lo > 1000000)};
#if MK_EXP == 3
                S.lim = 1280; pg8::gemm_phase<pg8::EpiNone, pg8::StaticOrder, true>(L + RING_OFF, g, S, E, wave); }
#elif MK_EXP == 8 || MK_EXP == 9
                { pg8::EpiStoreOnly E2{(bf16*)(ws + WS_H)}; pg8::gemm_phase(L + RING_OFF, g, S, E2, wave); } }
#elif MK_EXP == 6
                pg8::gemm_phase<pg8::EpiNone, pg8::StaticOrder, false, true>(L + RING_OFF, g, S, E, wave); __syncthreads(); }
#else
                pg8::gemm_phase(L + RING_OFF, g, S, E, wave); }
#endif
#endif
#if defined(MK_CLKPROBE)
            unsigned long long c0_ = clock64(), r0_ = __builtin_amdgcn_s_memrealtime();
#endif
            if (SITE(2) && RUN()) REP(2) {
#ifdef MK_CVFIRST
                if (rep_ == 0) cv_tail(args, layer * 2 + half, L, TIDL() & 63, wave, bx, G);
#endif
                pg8::Gemm g{HBR, (const bf16*)(ws + WS_WFI) + (size_t)(layer * 2 + half) * 2 * FF * DM, DM, DM, DM}; pg8::StaticOrder S; S.init(M, 2 * FF, G, bx);
                pg8::EpiSwiglu E{ACT, FF, SSQR, np}; PWAIT(); if (rep_ == 0) TWAIT(cv::I_FI); pg8::gemm_phase(L + RING_OFF, g, S, E, wave, PCNT());
#ifndef MK_CVFIRST
                if (rep_ == 0) cv_tail(args, layer * 2 + half, L, TIDL() & 63, wave, bx, G);
#endif
                }
#if defined(MK_CLKPROBE)
            if (layer == 1 && half == 1 && bx == 0 && MK_TID() == 0) { const unsigned long long c1_ = clock64(), r1_ = __builtin_amdgcn_s_memrealtime();
                ((float*)(ws + WS_CTL))[1024] = floorf((float)(c1_ - c0_) / (float)(r1_ - r0_) * 0.1f * MK_CLKPROBE); }
#endif
            ++pdone; PSEAM();
            if (SITE(3) && RUN()) REP(3) { pg8::Gemm g{ACT, (const bf16*)(ws + WS_WFO) + (size_t)(layer * 2 + half) * DM * FF, FF, FF, FF}; pg8::StaticOrder S; S.init(M, DM, G, bx);
                pg8::EpiRes<0> E{HBR, (layer == 0 && half == 0) ? args.in[0] : nullptr, HBW, SSQW, 0.5f, nullptr, 0, nullptr, false}; PWAIT(); if (rep_ == 0) TWAIT(cv::I_FO); pg8::gemm_phase(L + RING_OFF, g, S, E, wave, PCNT()); }
            ++pdone; PSEAM();
            np = 8; sel ^= 1;
            if (half == 0) {
                if (kind < 2) {
                    const int wslot = layer == 0 ? 0 : (layer == 1 ? 1 : 2);
                    if (RUN()) {
                        if (SITE(4) && kind == 0) REP(4) { PWAIT(); if (rep_ == 0) TWAIT(cv::I_WF); fox_gate_phase(HBR, (const bf16*)(ws + WS_WFT) + (size_t)(layer / 3) * 2 * 16 * DM, args.in[9] + (layer / 3) * 16, SSQR, np, LOGF, L, TIDL() & 63, wave, bx, G); }
                        if (SITE(5)) REP(5) { pg8::Gemm g{HBR, (const bf16*)(ws + WS_WQKV) + (size_t)wslot * 3 * DM * DM, DM, DM, DM}; pg8::StaticOrder S; S.init(M, 3 * DM, G, bx);
                        pg8::EpiQkv E{QKV, SSQR, np}; PWAIT(); if (rep_ == 0) TWAIT(cv::I_QKV); pg8::gemm_phase(L + RING_OFF, g, S, E, wave, BCNT()); } }
                    BSEAM();
                    if (kind == 1) {
                        if (SITE(6) && RUN()) REP(6) { if (bat) moba_kmean_phase(QKV + (size_t)M * DM, KMEAN, TIDL() & 63, 512 * ((bx & 7) >> 1) + blw * NWAVES + wave, 1 << 20);
                                                       else { moba_kmean_phase(QKV + (size_t)M * DM, KMEAN, TIDL() & 63, gw, NGW); } }
                        BARRIVE(); BSEAM();
                        if (SITE(6) && RUN()) REP(6) { if (bat) moba_select_phase(QKV, KMEAN, (unsigned*)(ws + WS_SEL), L, TIDL() & 63, wave, 512 * ((bx & 7) >> 1) + blw * NWAVES + wave, 1 << 20);
                                                       else moba_select_phase(QKV, KMEAN, (unsigned*)(ws + WS_SEL), L, TIDL() & 63, wave, gw, NGW); }
                        BARRIVE(); BSEAM(); }
                    if (RUN()) {
#if defined(MK_EXP) && MK_EXP == 4
                        if (kind == 0) att::attn_phase<false, true>((char*)lds + RING_OFF, QKV, QKV + (size_t)M * DM, QKV + (size_t)2 * M * DM, OB, (const float*)(ws + WS_BIAS), nullptr, wave);
#endif
                        if (kind == 0) { if (SITE(7)) REP(7) att::attn_phase<false>((char*)lds + RING_OFF, QKV, QKV + (size_t)M * DM, QKV + (size_t)2 * M * DM, OB, LOGF, nullptr, wave); }
                        else if (SITE(8)) REP(8) att::attn_phase<true>((char*)lds + RING_OFF, QKV, QKV + (size_t)M * DM, QKV + (size_t)2 * M * DM, OB, (const float*)(ws + WS_BIAS), (const unsigned*)(ws + WS_SEL), wave); }
                    BARRIVE(); BSEAM();
                    if (SITE(9) && RUN()) REP(9) { pg8::Gemm g{OB, (const bf16*)(ws + WS_WO) + (size_t)wslot * DM * DM, DM, DM, DM}; pg8::StaticOrder S; S.init(M, DM, G, bx);
                        pg8::EpiRes<0> E{HBR, nullptr, HBW, SSQW, 1.0f, nullptr, 0, nullptr, false}; if (rep_ == 0) TWAIT(cv::I_WO); pg8::gemm_phase(L + RING_OFF, g, S, E, wave, PCNT()); }
                    ++pdone; PSEAM(); sel ^= 1;
                } else {
                    if (SITE(10) && RUN()) REP(10) { pg8::Gemm g{HBR, (const bf16*)(ws + WS_WS5I), DM, DM, DM}; pg8::StaticOrder S; S.init(M, DM, G, bx);
                        pg8::EpiS5U E{UH, SSQR, np}; PWAIT(); if (rep_ == 0) TWAIT(cv::I_S5I); pg8::gemm_phase(L + RING_OFF, g, S, E, wave, s5c ? ((rep_ == 0) ? ctl + CW_S5U + 16 * (bx >> 5) : (unsigned*)nullptr) : PCNT()); }
                    if (s5c) {
                        ++pc;
                        if (bx < 128) {
                            panel_wait(ctl + CW_S5U + 16 * (bx >> 4), 32u, ctl + CW_BAR, wave);
                            if (SITE(11) && RUN()) { pg8::Gemm g{UH, (const bf16*)(ws + WS_S5W), 640, 512, 512}; pg8::BatchOrder<1> S; S.init(G, bx);
                                pg8::EpiS5H E{HLOC}; pg8::gemm_phase(L + RING_OFF, g, S, E, wave); }
                            if (SITE(12) && RUN()) s5_scan_phase(args, TIDL() & 63, wave < 4 ? bx * 4 + wave : 512, 512);
                            cnt_arrive(ctl + CW_S5G + bx, TIDL() & 63, wave);
                        }
                        pc += 2;
                        panel_wait(ctl + CW_S5G + (bx >> 1), 1u, ctl + CW_BAR, wave);
                    } else {
                        ++pdone; SEAM();
                        if (SITE(11) && RUN()) REP(11) { pg8::Gemm g{UH, (const bf16*)(ws + WS_S5W), 640, 512, 512}; pg8::BatchOrder<1> S; S.init(G, bx);
                            pg8::EpiS5H E{HLOC}; pg8::gemm_phase(L + RING_OFF, g, S, E, wave); }
                        SEAM();
                        if (SITE(12) && RUN()) REP(12) s5_scan_phase(args, TIDL() & 63, wave * G + vcu, NWAVES * G);
                        SEAM();
                    }
                    if (SITE(13) && RUN()) REP(13) { pg8::Gemm g{UH, (const bf16*)(ws + WS_S5TV), 640, 640, 640}; pg8::BatchOrder<2> S; S.init(G, bx);
                        pg8::EpiS5Y E{YB}; pg8::gemm_phase(L + RING_OFF, g, S, E, wave); }
                    SEAM();
                    if (SITE(14) && RUN()) REP(14) { pg8::Gemm g{YB, (const bf16*)(ws + WS_WGLU), DM, DM, DM}; pg8::StaticOrder S; S.init(M, 2 * DM, G, bx);
                        pg8::EpiRes<2> E{HBR, nullptr, HBW, SSQW, 1.0f, nullptr, 0, nullptr, false}; if (rep_ == 0) TWAIT(cv::I_GLU); pg8::gemm_phase(L + RING_OFF, g, S, E, wave, PCNT()); }
                    ++pdone; PSEAM(); np = 16; sel ^= 1;
                }
            } else {
                if (SITE(15) && RUN()) REP(15) { pg8::Gemm g{HBR, (const bf16*)(ws + WS_WPG) + (size_t)layer * DM * DM, DM, DM, DM}; pg8::StaticOrder S; S.init(M, DM, G, bx);
                    pg8::EpiRes<1> E{HBR, nullptr, HBW, SSQW, 1.0f, SSQR, np, PP + (size_t)layer * M * DM, false}; PWAIT(); if (rep_ == 0) TWAIT(cv::I_PG);
                    if (pan && layer == 0 && rep_ == 0) panel_wait(ctl + CW_PP, 256u, ctl + CW_BAR, wave);
                    pg8::gemm_phase(L + RING_OFF, g, S, E, wave, PCNT()); }
                ++pdone; PSEAM(); sel ^= 1;
            }
        }
    }
#if defined(MK_CLKPROBE)
    { xcd_barrier(bar, wave); const float cv_ = __hip_atomic_load((float*)(ws + WS_CTL) + 1024, __ATOMIC_RELAXED, __HIP_MEMORY_SCOPE_AGENT);
      for (size_t i = (size_t)bx * 512 + MK_TID(); i < (size_t)M * DM; i += (size_t)G * 512) args.out[i] = cv_; return; }
#endif
    if (SITE(16) && RUN()) REP(16) { PWAIT();
        const int r0 = pan ? (4 * (bx & 7) + ((bx >> 3) & 3)) * 256 + 32 * (bx >> 5) + 4 * wave : gw;
        final_norm_phase(HBR, SSQR, args.in[3], args.out, TIDL() & 63, r0, pan ? r0 + 4 : M, pan ? 1 : NGW); }
#undef RUN
#undef SEAM
}
constexpr int N_PHASES = 1 + 4 * 5 + (4 + 5 + 4 + 5) + 1;

#ifndef MK_PER_PHASE
#define MK_PER_PHASE 0
#endif
static void mk_launch(void* const* d_in, float* d_out, void* d_ws, hipStream_t stream) {
    static int grid = 0;
    if (grid == 0) {
        int dev = 0, cus = 0, per_cu = 0;
        if (hipGetDevice(&dev) != hipSuccess || hipDeviceGetAttribute(&cus, hipDeviceAttributeMultiprocessorCount, dev) != hipSuccess) { fprintf(stderr, "mk_launch: device query failed\n"); grid = -1; return; }
        if (hipFuncSetAttribute((const void*)mk_fwd, hipFuncAttributeMaxDynamicSharedMemorySize, LDS_BYTES) != hipSuccess) { fprintf(stderr, "mk_launch: hipFuncSetAttribute failed\n"); grid = -1; return; }
        if (hipOccupancyMaxActiveBlocksPerMultiprocessor(&per_cu, (const void*)mk_fwd, NWAVES * 64, LDS_BYTES) != hipSuccess || per_cu < 1) fprintf(stderr, "mk_launch: occupancy query reports %d\n", per_cu);
        (void)hipGetLastError();
        grid = cus;
    }
    if (grid < 0) return;
    if (hipMemsetAsync((char*)d_ws + WS_CTL, 0, CTL_ZERO_BYTES, stream) != hipSuccess) { fprintf(stderr, "mk_launch: memset failed\n"); return; }
    Args a{};
    for (int i = 0; i < 23; ++i) a.in[i] = (const float*)d_in[i];
    a.out = d_out; a.ws = (unsigned char*)d_ws;
#if MK_PER_PHASE
    for (int ph = 0; ph < N_PHASES; ++ph) { a.ph_lo = ph; a.ph_hi = ph + 1; hipLaunchKernelGGL(mk_fwd, dim3(grid), dim3(NWAVES * 64), LDS_BYTES, stream, a); }
#else
    a.ph_lo = 0; a.ph_hi = 1 << 20;
    hipLaunchKernelGGL(mk_fwd, dim3(grid), dim3(NWAVES * 64), LDS_BYTES, stream, a);
#endif
    const hipError_t le = hipPeekAtLastError();
    if (le != hipSuccess) fprintf(stderr, "mk_launch: launch failed: %s\n", hipGetErrorName(le));
}

extern "C" void kernel_launch(void* const* d_in, const int* in_sizes, int n_in, void* d_out, int out_size, void* d_ws, size_t ws_size, hipStream_t stream) {
    if (n_in != 23 || out_size != M * DM || in_sizes[0] != M * DM || ws_size < WS_END) { fprintf(stderr, "kernel_launch: unexpected shapes n_in=%d out=%d ws=%zu\n", n_in, out_size, ws_size); return; }
    mk_launch(d_in, (float*)d_out, d_ws, stream);
}
```

```cpp
#define MK_CV18 1
#include <hip/hip_runtime.h>
#include <cstdio>
#include <cstdint>
#include <cmath>
#define MK_TID() ({ unsigned l_; asm volatile("v_mbcnt_lo_u32_b32 %0, -1, 0\n\tv_mbcnt_hi_u32_b32 %0, -1, %0" : "=v"(l_)); (int)(((unsigned)wave << 6) | l_); })
#define XB_TID ((unsigned)MK_TID())
namespace pg8 {
#define PG8_LAS __attribute__((address_space(3)))
typedef unsigned short bf16_t;
typedef short bf16x8 __attribute__((ext_vector_type(8)));
typedef float f32x4 __attribute__((ext_vector_type(4)));
typedef float f32x2 __attribute__((ext_vector_type(2)));
typedef unsigned u32x4 __attribute__((ext_vector_type(4)));
typedef unsigned u32x2 __attribute__((ext_vector_type(2)));
#ifndef MK_WGM
#define MK_WGM 4
#endif
constexpr int BM = 256, BK = 64, HALF = 128, HTB = HALF * BK * 2  , STAGE_BYTES = 8 * HTB, NXCD = 8, WGM = MK_WGM;
constexpr int EPI_LDS_OFF = STAGE_BYTES;
constexpr float RMS_EPS = 1e-6f;

__host__ __device__ __forceinline__ int lds_byte(int r, int c) { const int st = (r >> 4) * 2 + (c >> 5), rr = r & 15, cc = c & 31, ob = rr * 64 + cc * 2; return st * 1024 + (ob ^ (((ob >> 9) & 1) << 5)); }
__host__ __device__ __forceinline__ void stage_rc(int b, int& R, int& C) { const int st = b / 1024, sb = b % 1024, swz = sb ^ (((sb >> 9) & 1) << 5); R = (st >> 1) * 16 + swz / 64; C = (st & 1) * 32 + (swz % 64) / 2; }
__host__ __device__ __forceinline__ int perm32(int rho) { const int n = rho >> 4, i = rho & 15; return 8 * (i >> 2) + 4 * n + (i & 3); }

struct Unit { int pm, pn, pb; };
struct Gemm { const bf16_t* A; const bf16_t* Bt; int lda, ldb, K; };

struct StaticOrder {
    int nM, nN, nwg, G, c, lim, pbmask;
    __device__ void init(int M, int N, int G_, int c_) { asm volatile("" : "+s"(c_)); nM = M / BM; nN = N / BM; nwg = nM * nN; G = G_; c = c_; lim = nwg; pbmask = -1; }
    __device__ bool next(int i, Unit& u) const {
        const long L = (long)i * G + c; if (L >= lim) return false;
        int wgid = (int)L; { const int q = nwg / NXCD, r = nwg % NXCD, xcd = wgid % NXCD, off = wgid / NXCD; wgid = (xcd < r ? xcd * (q + 1) : r * (q + 1) + (xcd - r) * q) + off; }
        const int nig = WGM * nN, gid = wgid / nig, fm = gid * WGM, gsz = (nM - fm) < WGM ? (nM - fm) : WGM;
        u.pm = fm + ((wgid % nig) % gsz); u.pn = (wgid % nig) / gsz; u.pb = u.pn & pbmask; return true;
    }
};
struct PpOrder {
    StaticOrder s;
    __device__ void init(int G_, int c_) { s.init(4 * 8192, 2048, G_, c_); }
    __device__ bool next(int i, Unit& u) const { if (!s.next(i, u)) return false; u.pb = (u.pm >> 5) * 8 + u.pn; return true; }
};
template <int NT> struct BatchOrder {
    int G, c;
    __device__ void init(int G_, int c_) { G = G_; c = c_; }
    __device__ bool next(int i, Unit& u) const { const int L = i * G + c; if (L >= 128 * NT) return false; u.pm = L / NT; u.pn = L % NT; u.pb = L; return true; }
};

__device__ __forceinline__ unsigned cvt_pk_bf16(float lo, float hi) { unsigned r; asm volatile("v_cvt_pk_bf16_f32 %0, %1, %2" : "=v"(r) : "v"(lo), "v"(hi)); return r; }
__device__ __forceinline__ float fast_sigmoid(float x) { return __builtin_amdgcn_rcpf(1.0f + __builtin_amdgcn_exp2f(-1.4426950408889634f * x)); }
__device__ __forceinline__ float fast_silu(float x) { return x * fast_sigmoid(x); }
__device__ __forceinline__ float gelu_tanh(float v) {
    const float z = 0.7978845608028654f * (v + 0.044715f * v * v * v); return v * fast_sigmoid(2.0f * z);
}

#ifndef MK_WT
#define MK_WT 1
#endif
typedef __amdgpu_buffer_rsrc_t rsrc_t;
__device__ __forceinline__ rsrc_t out_rsrc(const void* base, unsigned nbytes) { return __builtin_amdgcn_make_buffer_rsrc((void*)base, 0, (int)nbytes, 0x00020000); }
__device__ __forceinline__ void st16(void* base, rsrc_t r, unsigned boff, u32x4 v) {
#if MK_WT
    (void)base; __builtin_amdgcn_raw_buffer_store_b128(v, r, boff, 0, 16);
#else
    (void)r; *(u32x4*)((char*)base + boff) = v;
#endif
}
typedef f32x4 Acc[2][2][4][2];

__device__ __forceinline__ void fill_rstd(const float* ssq, int np, int pm, PG8_LAS unsigned char* lds, int tid) {
    PG8_LAS float* R = (PG8_LAS float*)(lds + EPI_LDS_OFF + 4096);
#pragma unroll
    for (int h = 0; h < 2; ++h) { const int row = tid + 512 * h; const f32x4* sp = (const f32x4*)(ssq + ((size_t)(pm >> 2) * 4 * BM + row) * 16);
        f32x4 a = sp[0] + sp[1]; if (np > 8) a += sp[2] + sp[3];
        R[row] = __builtin_amdgcn_rsqf(((a[0] + a[1]) + (a[2] + a[3])) * (1.0f / 2048.0f) + RMS_EPS); }
    asm volatile("s_waitcnt lgkmcnt(0)" ::: "memory"); __builtin_amdgcn_s_barrier(); asm volatile("" ::: "memory");
}
__device__ __forceinline__ void row_rstd(int pm, int wr, int fr, float (&rs)[2][4], PG8_LAS unsigned char* lds) {
    const PG8_LAS float* R = (const PG8_LAS float*)(lds + EPI_LDS_OFF + 4096) + (pm & 3) * BM;
#pragma unroll
    for (int ai = 0; ai < 2; ++ai)
#pragma unroll
        for (int m = 0; m < 4; ++m) rs[ai][m] = R[ai * HALF + wr * 64 + m * 16 + fr];
}

struct EpiNone {
    static constexpr bool PRE = false; static constexpr bool RSTD = false; static constexpr bool PERM = true, BAR = false;
    float* sink; int never;
    __device__ __forceinline__ void operator()(const Acc& acc, const Unit& u, int wr, int wc, int fr, int fq, PG8_LAS unsigned char* lds, int tid) const {
        if (never) { f32x4 t = (f32x4){0.f, 0.f, 0.f, 0.f};
#pragma unroll
            for (int ai = 0; ai < 2; ++ai)
#pragma unroll
                for (int bj = 0; bj < 2; ++bj)
#pragma unroll
                    for (int m = 0; m < 4; ++m)
#pragma unroll
                        for (int n = 0; n < 2; ++n) t += acc[ai][bj][m][n];
            *(f32x4*)(sink + tid * 4) = t; }
    }
};
struct EpiStoreOnly {
    static constexpr bool PRE = false; static constexpr bool RSTD = false; static constexpr bool PERM = true, BAR = false;
    bf16_t* O;
    __device__ __forceinline__ void operator()(const Acc& acc, const Unit& u, int wr, int wc, int fr, int fq, PG8_LAS unsigned char* lds, int tid) const {
        const rsrc_t rs_o = out_rsrc(O, 8192u * 2048u * 4u);
#pragma unroll
        for (int ai = 0; ai < 2; ++ai)
#pragma unroll
            for (int m = 0; m < 4; ++m)
#pragma unroll
                for (int bj = 0; bj < 2; ++bj) { const f32x4 v0 = acc[ai][bj][m][0], v1 = acc[ai][bj][m][1];
                    u32x4 w; w.x = __float_as_uint(v0[0]) ^ __float_as_uint(v1[0]); w.y = __float_as_uint(v0[1]) ^ __float_as_uint(v1[1]); w.z = __float_as_uint(v0[2]) ^ __float_as_uint(v1[2]); w.w = __float_as_uint(v0[3]) ^ __float_as_uint(v1[3]);
                    st16(O, rs_o, (unsigned)((((size_t)((u.pm & 7) * BM + ai * HALF + wr * 64 + m * 16 + fr)) * 2048 + (u.pn & 7) * BM + bj * HALF + wc * 32 + 8 * fq) * 2), w); }
#if defined(MK_EXP) && MK_EXP == 9
        asm volatile("s_waitcnt vmcnt(0)" ::: "memory");
#endif
    }
};
struct EpiSwiglu {
    static constexpr bool PRE = false; static constexpr bool RSTD = true; static constexpr bool PERM = true, BAR = false;
    bf16_t* O; int ldo; const float* ssq; int np;
    __device__ __forceinline__ void operator()(const Acc& acc, const Unit& u, int wr, int wc, int fr, int fq, PG8_LAS unsigned char* lds, int tid) const {
        float rs[2][4]; row_rstd(u.pm, wr, fr, rs, lds);
        const rsrc_t rs_o = out_rsrc(O, 8192u * 5632u * 2u);
        const int col0 = u.pn * HALF + wc * 32 + 8 * fq;
#pragma unroll
        for (int ai = 0; ai < 2; ++ai)
#pragma unroll
            for (int m = 0; m < 4; ++m) { const float s = rs[ai][m]; float o[8];
#pragma unroll
                for (int n = 0; n < 2; ++n)
#pragma unroll
                    for (int i = 0; i < 4; ++i) o[n * 4 + i] = fast_silu(acc[ai][0][m][n][i] * s) * (acc[ai][1][m][n][i] * s);
                u32x4 w; w.x = cvt_pk_bf16(o[0], o[1]); w.y = cvt_pk_bf16(o[2], o[3]); w.z = cvt_pk_bf16(o[4], o[5]); w.w = cvt_pk_bf16(o[6], o[7]);
                st16(O, rs_o, (unsigned)(((size_t)(u.pm * BM + ai * HALF + wr * 64 + m * 16 + fr) * ldo + col0) * 2), w); }
    }
};
struct EpiBf16 {
    static constexpr bool PRE = false; static constexpr bool RSTD = true; static constexpr bool PERM = true, BAR = false;
    bf16_t* O; int ldo; const float* ssq; int np;
    __device__ __forceinline__ void operator()(const Acc& acc, const Unit& u, int wr, int wc, int fr, int fq, PG8_LAS unsigned char* lds, int tid) const {
        float rs[2][4];
        if (ssq) row_rstd(u.pm, wr, fr, rs, lds); else {
#pragma unroll
            for (int a = 0; a < 2; ++a)
#pragma unroll
                for (int m = 0; m < 4; ++m) rs[a][m] = 1.f; }
        const rsrc_t rs_o = out_rsrc(O, 32768u * 2048u * 2u);
        const int col0 = u.pn * BM + wc * 32 + 8 * fq;
#pragma unroll
        for (int ai = 0; ai < 2; ++ai)
#pragma unroll
            for (int m = 0; m < 4; ++m) { const float s = rs[ai][m];
#pragma unroll
                for (int bj = 0; bj < 2; ++bj) { const f32x4 v0 = acc[ai][bj][m][0] * s, v1 = acc[ai][bj][m][1] * s;
                    u32x4 w; w.x = cvt_pk_bf16(v0[0], v0[1]); w.y = cvt_pk_bf16(v0[2], v0[3]); w.z = cvt_pk_bf16(v1[0], v1[1]); w.w = cvt_pk_bf16(v1[2], v1[3]);
                    st16(O, rs_o, (unsigned)(((size_t)(u.pm * BM + ai * HALF + wr * 64 + m * 16 + fr) * ldo + col0 + bj * HALF) * 2), w); } }
    }
};
struct EpiQkv {
    static constexpr bool PRE = false; static constexpr bool RSTD = true; static constexpr bool PERM = true, BAR = false;
    bf16_t* O; const float* ssq; int np;
    __device__ __forceinline__ void operator()(const Acc& acc, const Unit& u, int wr, int wc, int fr, int fq, PG8_LAS unsigned char* lds, int tid) const {
        float rs[2][4]; row_rstd(u.pm, wr, fr, rs, lds);
        const rsrc_t rs_o = out_rsrc(O, 3u * 8192u * 2048u * 2u);
        const int which = u.pn >> 3, hd0 = (u.pn & 7) * 2, d0 = wc * 32 + 8 * fq;
#pragma unroll
        for (int ai = 0; ai < 2; ++ai)
#pragma unroll
            for (int m = 0; m < 4; ++m) { const float s = rs[ai][m]; const int r = u.pm * BM + ai * HALF + wr * 64 + m * 16 + fr, b = r >> 11, t = r & 2047;
#pragma unroll
                for (int bj = 0; bj < 2; ++bj) { const f32x4 v0 = acc[ai][bj][m][0] * s, v1 = acc[ai][bj][m][1] * s;
                    u32x4 w; w.x = cvt_pk_bf16(v0[0], v0[1]); w.y = cvt_pk_bf16(v0[2], v0[3]); w.z = cvt_pk_bf16(v1[0], v1[1]); w.w = cvt_pk_bf16(v1[2], v1[3]);
                    st16(O, rs_o, (unsigned)(((size_t)which * (8192 * 2048) + ((size_t)((b * 16 + hd0 + bj) * 2048 + t)) * 128 + d0) * 2), w); } }
    }
};
struct EpiS5U {
    static constexpr bool PRE = false; static constexpr bool RSTD = true; static constexpr bool PERM = true, BAR = false;
    bf16_t* UH; const float* ssq; int np;
    __device__ __forceinline__ void operator()(const Acc& acc, const Unit& u, int wr, int wc, int fr, int fq, PG8_LAS unsigned char* lds, int tid) const {
        const rsrc_t rs_o = out_rsrc(UH, 128u * 256u * 640u * 2u); float rs[2][4]; row_rstd(u.pm, wr, fr, rs, lds);
#pragma unroll
        for (int ai = 0; ai < 2; ++ai)
#pragma unroll
            for (int m = 0; m < 4; ++m) { const float s = rs[ai][m]; const int r = u.pm * BM + ai * HALF + wr * 64 + m * 16 + fr;
#pragma unroll
                for (int bj = 0; bj < 2; ++bj) { const int cg = u.pn * BM + bj * HALF + wc * 32 + 8 * fq, g = cg >> 4, c0 = cg & 15;
                    const f32x4 v0 = acc[ai][bj][m][0] * s, v1 = acc[ai][bj][m][1] * s;
                    u32x4 w; w.x = cvt_pk_bf16(v0[0], v0[1]); w.y = cvt_pk_bf16(v0[2], v0[3]); w.z = cvt_pk_bf16(v1[0], v1[1]); w.w = cvt_pk_bf16(v1[2], v1[3]);
                    st16(UH, rs_o, (unsigned)((((size_t)g * 256 + (r >> 5)) * 640 + (r & 31) * 16 + c0) * 2), w); } }
    }
};
struct EpiS5H {
    static constexpr bool PRE = false; static constexpr bool RSTD = false; static constexpr bool PERM = false, BAR = false;
    float* Hl;
    __device__ __forceinline__ void operator()(const Acc& acc, const Unit& u, int wr, int wc, int fr, int fq, PG8_LAS unsigned char* lds, int tid) const {
        const rsrc_t rs_o = out_rsrc(Hl, 128u * 256u * 128u * 4u);
#pragma unroll
        for (int ai = 0; ai < 2; ++ai)
#pragma unroll
            for (int m = 0; m < 4; ++m) {
#pragma unroll
                for (int n = 0; n < 2; ++n) st16(Hl, rs_o, (unsigned)((((size_t)u.pm * 256 + ai * HALF + wr * 64 + m * 16 + fr) * 128 + wc * 32 + 4 * fq + n * 16) * 4), __builtin_bit_cast(u32x4, acc[ai][0][m][n])); }
    }
};
struct EpiS5Y {
    static constexpr bool PRE = false; static constexpr bool RSTD = false; static constexpr bool PERM = true, BAR = false;
    bf16_t* Y;
    __device__ __forceinline__ void operator()(const Acc& acc, const Unit& u, int wr, int wc, int fr, int fq, PG8_LAS unsigned char* lds, int tid) const {
        const rsrc_t rs_o = out_rsrc(Y, 8192u * 2048u * 2u);
#pragma unroll
        for (int ai = 0; ai < 2; ++ai)
#pragma unroll
            for (int m = 0; m < 4; ++m) { const int crow = ai * HALF + wr * 64 + m * 16 + fr;
#pragma unroll
                for (int bj = 0; bj < 2; ++bj) { const int col = u.pn * BM + bj * HALF + wc * 32 + 8 * fq, j = col >> 4, c0 = col & 15;
                    float o[8];
#pragma unroll
                    for (int n = 0; n < 2; ++n)
#pragma unroll
                        for (int i = 0; i < 4; ++i) o[n * 4 + i] = gelu_tanh(acc[ai][bj][m][n][i]);
                    u32x4 w; w.x = cvt_pk_bf16(o[0], o[1]); w.y = cvt_pk_bf16(o[2], o[3]); w.z = cvt_pk_bf16(o[4], o[5]); w.w = cvt_pk_bf16(o[6], o[7]);
                    st16(Y, rs_o, (unsigned)((((size_t)crow * 32 + j) * 2048 + u.pm * 16 + c0) * 2), w); } }
    }
};
template <int MODE> struct EpiRes {
    static constexpr bool RSTD = (MODE == 1); static constexpr bool PERM = true, BAR = true; static constexpr bool PRE = false;
    const bf16_t* hin; const float* hin32; bf16_t* hout; float* ssq_out; float alpha; const float* ssq; int np; const bf16_t* pp;
    __device__ __forceinline__ void preload(Acc& acc, const Unit& u, int wr, int wc, int fr, int fq) const {
        const float ia = 1.0f / alpha;
#pragma unroll
        for (int ai = 0; ai < 2; ++ai)
#pragma unroll
            for (int m = 0; m < 4; ++m) { const size_t r = (size_t)u.pm * BM + ai * HALF + wr * 64 + m * 16 + fr;
#pragma unroll
                for (int bj = 0; bj < 2; ++bj) { const size_t off = r * 2048 + u.pn * BM + bj * HALF + wc * 32 + 8 * fq;
                    if (hin32) { acc[ai][bj][m][0] = *(const f32x4*)(hin32 + off) * ia; acc[ai][bj][m][1] = *(const f32x4*)(hin32 + off + 4) * ia; }
                    else { const u32x4 hw = *(const u32x4*)(hin + off);
                        acc[ai][bj][m][0] = (f32x4){__uint_as_float(hw.x << 16), __uint_as_float(hw.x & 0xffff0000u), __uint_as_float(hw.y << 16), __uint_as_float(hw.y & 0xffff0000u)} * ia;
                        acc[ai][bj][m][1] = (f32x4){__uint_as_float(hw.z << 16), __uint_as_float(hw.z & 0xffff0000u), __uint_as_float(hw.w << 16), __uint_as_float(hw.w & 0xffff0000u)} * ia; } } }
    }
    bool pre;
    __device__ __forceinline__ void operator()(const Acc& acc, const Unit& u, int wr, int wc, int fr, int fq, PG8_LAS unsigned char* lds, int tid) const {
        float rs[2][4];
        if (MODE == 1) row_rstd(u.pm, wr, fr, rs, lds);
        PG8_LAS float* P = (PG8_LAS float*)(lds + EPI_LDS_OFF);
        const rsrc_t rs_o = out_rsrc(hout, 8192u * 2048u * 2u);
        constexpr int NBJ = (MODE == 2) ? 1 : 2; constexpr int CW = (MODE == 2) ? HALF : BM;
#pragma unroll
        for (int ai = 0; ai < 2; ++ai)
#pragma unroll
            for (int m = 0; m < 4; ++m) { const int rl = ai * HALF + wr * 64 + m * 16 + fr; const size_t r = (size_t)u.pm * BM + rl; float sq = 0.f;
#pragma unroll
                for (int bj = 0; bj < NBJ; ++bj) { const int col = u.pn * CW + bj * HALF + wc * 32 + 8 * fq; const size_t off = r * 2048 + col;
                    float f[8], h[8];
                    if (MODE == 0) {
#pragma unroll
                        for (int e = 0; e < 8; ++e) f[e] = acc[ai][bj][m][e >> 2][e & 3] * alpha; }
                    else if (MODE == 1) { const u32x4 pw = *(const u32x4*)(pp + off); const float s = rs[ai][m];
#pragma unroll
                        for (int e = 0; e < 8; ++e) { const unsigned w = pw[e >> 1]; const float pv = __uint_as_float((e & 1) ? (w & 0xffff0000u) : (w << 16)); f[e] = fast_sigmoid(acc[ai][bj][m][e >> 2][e & 3] * s) * pv; } }
                    else {
#pragma unroll
                        for (int e = 0; e < 8; ++e) f[e] = acc[ai][0][m][e >> 2][e & 3] * fast_sigmoid(acc[ai][1][m][e >> 2][e & 3]); }
                    if (MODE == 0 && pre) {
#pragma unroll
                        for (int e = 0; e < 8; ++e) h[e] = 0.f; }
                    else if (hin32) { const f32x4 a = *(const f32x4*)(hin32 + off), b = *(const f32x4*)(hin32 + off + 4);
#pragma unroll
                        for (int e = 0; e < 4; ++e) { h[e] = a[e]; h[4 + e] = b[e]; } }
                    else { const u32x4 hw = *(const u32x4*)(hin + off);
#pragma unroll
                        for (int e = 0; e < 8; ++e) { const unsigned w = hw[e >> 1]; h[e] = __uint_as_float((e & 1) ? (w & 0xffff0000u) : (w << 16)); } }
                    float o[8];
#pragma unroll
                    for (int e = 0; e < 8; ++e) { o[e] = h[e] + f[e]; sq = fmaf(o[e], o[e], sq); }
                    u32x4 w; w.x = cvt_pk_bf16(o[0], o[1]); w.y = cvt_pk_bf16(o[2], o[3]); w.z = cvt_pk_bf16(o[4], o[5]); w.w = cvt_pk_bf16(o[6], o[7]);
                    st16(hout, rs_o, (unsigned)(off * 2), w); }
                sq += __shfl_xor(sq, 16); sq += __shfl_xor(sq, 32);
                if (fq == 0) P[rl * 4 + wc] = sq;
                if (m & 1) asm volatile("" ::: "memory"); }
        asm volatile("s_waitcnt lgkmcnt(0)" ::: "memory"); __builtin_amdgcn_s_barrier(); asm volatile("" ::: "memory");
        if (tid < 256) { const f32x4 p4 = *(const PG8_LAS f32x4*)(P + tid * 4); const float sv = (p4[0] + p4[1]) + (p4[2] + p4[3]);
#if MK_WT
            __hip_atomic_store(ssq_out + ((size_t)u.pm * BM + tid) * 16 + u.pn, sv, __ATOMIC_RELAXED, __HIP_MEMORY_SCOPE_AGENT);
#else
            ssq_out[((size_t)u.pm * BM + tid) * 16 + u.pn] = sv;
#endif
        }
    }
};

template <class Epi, class Sched, bool NOMMA = false, bool MMAONLY = false>
__device__ __forceinline__ void gemm_phase(PG8_LAS unsigned char* lds, const Gemm g, const Sched& S, Epi E, const int wave, unsigned* pcnt = nullptr) {
    int tid_raw_ = MK_TID(); asm volatile("" : "+v"(tid_raw_)); const int tid = tid_raw_, wid = __builtin_amdgcn_readfirstlane(tid >> 6), lane = tid & 63, wr = wid >> 2, wc = wid & 3, fr = lane & 15, fq = lane >> 4;
    int K_ = g.K; asm volatile("" : "+s"(K_)); const int K = K_, nt = K / BK;
    unsigned voffA[2], voffB[2];
#pragma unroll
    for (int i = 0; i < 2; ++i) { int R, C; stage_rc(tid * 16 + i * 8192, R, C); const int Rb = Epi::PERM ? ((R & ~31) + perm32(R & 31)) : R;
        voffA[i] = (unsigned)(R * g.lda + C) * 2u; voffB[i] = (unsigned)(Rb * g.ldb + C) * 2u; }
    const size_t kstep = (size_t)(BK * 2);
    const size_t hstepA = (size_t)HALF * g.lda * 2, hstepB = (size_t)HALF * g.ldb * 2;
    const size_t tstepA = 2 * hstepA, tstepB = 2 * hstepB;
    const unsigned ldsw = (unsigned)wid * 1024u;
    const int aoff = lds_byte(wr * 64 + fr, fq * 8), boff = lds_byte(wc * 32 + fr, fq * 8);
#define PG8_SA(b, h) (((b) * 2 + (h)) * HTB)
#define PG8_SB(b, h) ((4 + (b) * 2 + (h)) * HTB)
#ifndef MK_BNT
#define MK_BNT 0
#endif
#define PG8_STAGE_(bufoff, gbase, voff, aux) do { if (MMAONLY) break; _Pragma("unroll") for (int _i = 0; _i < 2; ++_i) \
        __builtin_amdgcn_global_load_lds((const unsigned*)((const char*)(gbase) + (voff)[_i]), (PG8_LAS unsigned*)(lds + (bufoff) + ldsw + _i * 8192), 16, 0, aux); } while (0)
#define PG8_STAGE(bufoff, gbase, voff) PG8_STAGE_(bufoff, gbase, voff, 0)
#define PG8_STAGEB(bufoff, gbase, voff) PG8_STAGE_(bufoff, gbase, voff, MK_BNT)
#define PG8_LDA(dst, b, h) do { if (MMAONLY) { asm volatile("" : "+v"(dst[0][0]), "+v"(dst[1][0]), "+v"(dst[2][0]), "+v"(dst[3][0])); break; } _Pragma("unroll") for (int m = 0; m < 4; ++m) _Pragma("unroll") for (int k = 0; k < 2; ++k) dst[m][k] = *(const PG8_LAS bf16x8*)(lds + PG8_SA(b, h) + aoff + m * 2048 + k * 1024); } while (0)
#define PG8_LDB(dst, b, h) do { if (MMAONLY) { asm volatile("" : "+v"(dst[0][0]), "+v"(dst[1][0])); break; } _Pragma("unroll") for (int n = 0; n < 2; ++n) _Pragma("unroll") for (int k = 0; k < 2; ++k) dst[n][k] = *(const PG8_LAS bf16x8*)(lds + PG8_SB(b, h) + boff + n * 2048 + k * 1024); } while (0)
#define PG8_MMA(ai, bj, At, Bt) do { if (NOMMA) { asm volatile("" :: "v"(At[0][0]), "v"(At[0][1]), "v"(At[1][0]), "v"(At[1][1]), "v"(At[2][0]), "v"(At[2][1]), "v"(At[3][0]), "v"(At[3][1]), "v"(Bt[0][0]), "v"(Bt[0][1]), "v"(Bt[1][0]), "v"(Bt[1][1])); break; } __builtin_amdgcn_s_setprio(1); _Pragma("unroll") for (int m = 0; m < 4; ++m) _Pragma("unroll") for (int n = 0; n < 2; ++n) _Pragma("unroll") for (int k = 0; k < 2; ++k) \
        acc[ai][bj][m][n] = __builtin_amdgcn_mfma_f32_16x16x32_bf16(Bt[n][k], At[m][k], acc[ai][bj][m][n], 0, 0, 0); __builtin_amdgcn_s_setprio(0); } while (0)
#define PG8_WAIT_V(n) asm volatile("s_waitcnt vmcnt(" #n ")" ::: "memory")
#define PG8_WAIT_L(n) asm volatile("s_waitcnt lgkmcnt(" #n ")" ::: "memory")
#define PG8_BAR do { if (!MMAONLY) __builtin_amdgcn_s_barrier(); } while (0)
#define PG8_SCHED __builtin_amdgcn_sched_barrier(0)
    Unit cur, nxt; int ui = 0;
    if (!S.next(0, cur)) return;
    int pm_r = -1;
    if constexpr (Epi::RSTD) { if (E.ssq) { fill_rstd(E.ssq, E.np, cur.pm, lds, tid); pm_r = cur.pm >> 2; } }
    f32x4 acc[2][2][4][2];
#pragma unroll
    for (int a = 0; a < 2; ++a)
#pragma unroll
        for (int b = 0; b < 2; ++b)
#pragma unroll
            for (int m = 0; m < 4; ++m)
#pragma unroll
                for (int n = 0; n < 2; ++n) acc[a][b][m][n] = (f32x4){0.f, 0.f, 0.f, 0.f};
    if constexpr (Epi::PRE) { int lp_ = lane; asm volatile("" : "+v"(lp_)); E.preload(acc, cur, wr, wc, lp_ & 15, lp_ >> 4); E.pre = true; }
    bf16x8 At[4][2], B0[2][2], B1[2][2];
    if (MMAONLY) {
#pragma unroll
        for (int m = 0; m < 4; ++m)
#pragma unroll
            for (int k = 0; k < 2; ++k) At[m][k] = (bf16x8){(short)(0x3f80 + lane), 0x3f00, 0x4000, 0x3e80, 0x3f80, 0x3f00, 0x4000, 0x3e80};
#pragma unroll
        for (int n = 0; n < 2; ++n)
#pragma unroll
            for (int k = 0; k < 2; ++k) { B0[n][k] = At[n][k]; B1[n][k] = At[n + 2][k]; } }
    const char* cA = (const char*)g.A + (size_t)cur.pm * tstepA; const char* cB = (const char*)g.Bt + (size_t)cur.pb * tstepB;
    PG8_STAGEB(PG8_SB(0, 0), cB, voffB); PG8_STAGEB(PG8_SB(0, 1), cB + hstepB, voffB); PG8_STAGE(PG8_SA(0, 0), cA, voffA); PG8_STAGE(PG8_SA(0, 1), cA + hstepA, voffA);
    if (wr == 1) PG8_BAR;
    PG8_WAIT_V(2); PG8_BAR;
    PG8_STAGEB(PG8_SB(1, 0), cB + kstep, voffB); PG8_STAGE(PG8_SA(1, 0), cA + kstep, voffA); PG8_STAGEB(PG8_SB(1, 1), cB + hstepB + kstep, voffB);
    PG8_WAIT_V(6); PG8_BAR;
    for (;;) {
        const bool has_next = S.next(ui + 1, nxt);
        const char* nA = has_next ? (const char*)g.A + (size_t)nxt.pm * tstepA : cA; const char* nB = has_next ? (const char*)g.Bt + (size_t)nxt.pb * tstepB : cB;
        for (int t = 0; t < nt; t += 2) {
            const bool last = (t == nt - 2);
            const char* a1 = cA + (size_t)(t + 1) * kstep;
            const char* a2 = last ? nA : cA + (size_t)(t + 2) * kstep; const char* b2 = last ? nB : cB + (size_t)(t + 2) * kstep;
            const char* a3 = a2 + kstep; const char* b3 = b2 + kstep;
            PG8_LDB(B0, 0, 0); PG8_LDB(B1, 0, 1); PG8_SCHED; PG8_LDA(At, 0, 0); PG8_STAGE(PG8_SA(1, 1), a1 + hstepA, voffA);
            PG8_WAIT_V(8); PG8_WAIT_L(0); PG8_BAR; PG8_MMA(0, 0, At, B0); PG8_MMA(0, 1, At, B1); PG8_BAR; PG8_SCHED;
            PG8_LDA(At, 0, 1); PG8_STAGEB(PG8_SB(0, 0), b2, voffB); PG8_STAGEB(PG8_SB(0, 1), b2 + hstepB, voffB); PG8_STAGE(PG8_SA(0, 0), a2, voffA);
            PG8_WAIT_V(8); PG8_WAIT_L(0); PG8_BAR; PG8_MMA(1, 0, At, B0); PG8_MMA(1, 1, At, B1); PG8_BAR; PG8_SCHED;
            PG8_LDB(B0, 1, 0); PG8_LDB(B1, 1, 1); PG8_SCHED; PG8_LDA(At, 1, 0); PG8_STAGE(PG8_SA(0, 1), a2 + hstepA, voffA);
            PG8_WAIT_V(8); PG8_WAIT_L(0); PG8_BAR; PG8_MMA(0, 0, At, B0); PG8_MMA(0, 1, At, B1); PG8_BAR; PG8_SCHED;
            PG8_LDA(At, 1, 1); PG8_STAGEB(PG8_SB(1, 0), b3, voffB); PG8_STAGEB(PG8_SB(1, 1), b3 + hstepB, voffB); PG8_STAGE(PG8_SA(1, 0), a3, voffA);
            PG8_WAIT_V(8); PG8_WAIT_L(0); PG8_BAR; PG8_MMA(1, 0, At, B0); PG8_MMA(1, 1, At, B1); PG8_BAR; PG8_SCHED;
        }
        if (wr == 0) PG8_BAR;
        if constexpr (Epi::RSTD) { if (E.ssq && (cur.pm >> 2) != pm_r) { fill_rstd(E.ssq, E.np, cur.pm, lds, tid); pm_r = cur.pm >> 2; } }
        { int le_ = lane; asm volatile("" : "+v"(le_));
          E(acc, cur, wr, wc, le_ & 15, le_ >> 4, lds, (wid << 6) | le_); }
        if (!has_next) break;
        if constexpr (Epi::PRE) E.pre = false;
#pragma unroll
        for (int a = 0; a < 2; ++a)
#pragma unroll
            for (int b = 0; b < 2; ++b)
#pragma unroll
                for (int m = 0; m < 4; ++m)
#pragma unroll
                    for (int n = 0; n < 2; ++n) acc[a][b][m][n] = (f32x4){0.f, 0.f, 0.f, 0.f};
        cur = nxt; cA = nA; cB = nB; ++ui;
        if (wr == 1) PG8_BAR;
    }
    PG8_WAIT_V(0);
    PG8_BAR;
    if (pcnt) { unsigned* pc_ = pcnt; asm volatile("" : "+s"(pc_));
        if (wave == 0 && lane == 0) __hip_atomic_fetch_add(pc_, 1u, __ATOMIC_RELAXED, __HIP_MEMORY_SCOPE_AGENT); }
#undef PG8_SA
#undef PG8_SB
#undef PG8_STAGE
#undef PG8_STAGEB
#undef PG8_STAGE_
#undef PG8_LDA
#undef PG8_LDB
#undef PG8_MMA
#undef PG8_WAIT_V
#undef PG8_WAIT_L
#undef PG8_BAR
#undef PG8_SCHED
}
}
namespace att {
typedef unsigned short bf16;
typedef short bf16x8 __attribute__((ext_vector_type(8)));
typedef short s16x4 __attribute__((ext_vector_type(4)));
typedef float f32x16 __attribute__((ext_vector_type(16)));
typedef float f32x4 __attribute__((ext_vector_type(4)));
typedef unsigned u32x4 __attribute__((ext_vector_type(4)));
constexpr int D = 128, SEQ = 2048, OS = 2048;
constexpr float SCALE = 0.08838834764831845f, THR = 8.f;
constexpr int NW = 8, QBLK = 32, KVBLK = 64, QB = NW * QBLK;
constexpr int SHM_V = KVBLK * D * 2, SHM_K = KVBLK * D * 2;
constexpr int LDS_WS = 2 * SHM_V + 2 * SHM_K;
constexpr int LDS_BIAS = LDS_WS + NW * 64 * 4;
constexpr int LDS_NEG = LDS_BIAS + SEQ * 4;
constexpr int LDS_OST = 77824, OST_WAVE = 16 * 272;
constexpr int LDS_BYTES = LDS_OST + NW * OST_WAVE;
static_assert(LDS_OST >= LDS_NEG + 256, "attention LDS map");

#define KSWZ(row, colB) ((row) * 256 + ((colB) ^ (((row) & 7) << 4)))
#define SBAR() __builtin_amdgcn_sched_barrier(0)
__device__ __forceinline__ int v_st(int k, int c) { const int kk = (k & ~0xC) | ((k & 4) << 1) | ((k & 8) >> 1); return ((kk >> 3) * 4 + (c >> 5)) * 512 + ((kk & 7) * 32 + (c & 31)) * 2; }
__device__ __forceinline__ int v_rd_base(int lane) { return ((lane & 3) << 3) | (((lane >> 2) & 3) << 6) | (((lane >> 4) & 1) << 5) | (((lane >> 5) & 1) << 8); }
constexpr int v_rd_off(int d0, int ks, int half) { return d0 * 512 + ks * 4096 + half * 2048; }
__device__ __forceinline__ int crow(int r, int hi) { return (r & 3) + 8 * (r >> 2) + 4 * hi; }
__device__ __forceinline__ unsigned cvtpk(float lo, float hi) { unsigned r; asm volatile("v_cvt_pk_bf16_f32 %0, %1, %2" : "=v"(r) : "v"(lo), "v"(hi)); return r; }
__device__ __forceinline__ bf16x8 load8(const bf16* p) { return *reinterpret_cast<const bf16x8*>(p); }
__device__ __forceinline__ void mask_tile(f32x16& p0, f32x16& p1, int dq) {
    const float NEG = -__builtin_inff();
#pragma unroll
    for (int r = 0; r < 16; ++r) {
        const int c = (r & 3) + 8 * (r >> 2);
        if (dq - c < 0) p0[r] = NEG;
        if (dq - c - 32 < 0) p1[r] = NEG;
    }
}
__device__ __forceinline__ void partialSM(f32x16& p0, f32x16& p1, float& m_reg, float& mn, float& alpha) {
    float pmax = p0[0]; for (int r = 1; r < 16; ++r) pmax = fmaxf(pmax, p0[r]); for (int r = 0; r < 16; ++r) pmax = fmaxf(pmax, p1[r]);
    { auto rr = __builtin_amdgcn_permlane32_swap(__float_as_uint(pmax), __float_as_uint(pmax), false, false);
      pmax = fmaxf(__uint_as_float(rr[0]), __uint_as_float(rr[1])); }
    constexpr float C2 = 1.4426950408889634f * SCALE;
    if (__builtin_expect(__all((pmax - m_reg) * SCALE <= THR), 1)) { mn = m_reg; alpha = 1.f; }
    else { mn = fmaxf(m_reg, pmax); alpha = __builtin_amdgcn_exp2f((m_reg - mn) * C2); m_reg = mn; }
    const float mnL = -mn * C2;
    for (int r = 0; r < 16; ++r) p0[r] = fmaf(p0[r], C2, mnL); for (int r = 0; r < 16; ++r) p1[r] = fmaf(p1[r], C2, mnL);
    for (int r = 0; r < 16; ++r) p0[r] = __builtin_amdgcn_exp2f(p0[r]);
}
__device__ __forceinline__ void finishSM(f32x16& p0, f32x16& p1, float alpha, float& l_reg, bf16x8& pa0, bf16x8& pa1, bf16x8& pa2, bf16x8& pa3) {
    for (int r = 0; r < 16; ++r) p1[r] = __builtin_amdgcn_exp2f(p1[r]);
    float ps = 0; for (int r = 0; r < 16; ++r) ps += p0[r]; for (int r = 0; r < 16; ++r) ps += p1[r];
    { auto rr = __builtin_amdgcn_permlane32_swap(__float_as_uint(ps), __float_as_uint(ps), false, false);
      ps = __uint_as_float(rr[0]) + __uint_as_float(rr[1]); }
    l_reg = l_reg * alpha + ps;
#define PK4(P, B_, OUT) do { unsigned a0 = cvtpk(P[B_+0], P[B_+1]), a1 = cvtpk(P[B_+2], P[B_+3]);                          \
        unsigned b0 = cvtpk(P[B_+4], P[B_+5]), b1 = cvtpk(P[B_+6], P[B_+7]);                                             \
        auto r0 = __builtin_amdgcn_permlane32_swap(a0, b0, false, false); auto r1 = __builtin_amdgcn_permlane32_swap(a1, b1, false, false); \
        u32x4 w = {r0[0], r1[0], r0[1], r1[1]}; OUT = *reinterpret_cast<bf16x8*>(&w); } while (0)
    PK4(p0, 0, pa0); PK4(p0, 8, pa1); PK4(p1, 0, pa2); PK4(p1, 8, pa3);
#undef PK4
}
template <int KB, bool NOBIAS = false>
__device__ __forceinline__ void qkt(f32x16& p0, f32x16& p1, const char* K_lds, int r32, int hi, const bf16x8* qr, const __attribute__((address_space(3))) char* bp) {
    if (NOBIAS) { p0 = f32x16{}; p1 = f32x16{}; } else
    { unsigned bpa = (unsigned)(uintptr_t)bp; asm volatile("" : "+v"(bpa));
      const __attribute__((address_space(3))) f32x4* b4 = (const __attribute__((address_space(3))) f32x4*)(uintptr_t)bpa;
      const f32x4 x0 = b4[0], x1 = b4[2], x2 = b4[4], x3 = b4[6], y0 = b4[8], y1 = b4[10], y2 = b4[12], y3 = b4[14];
      p0 = (f32x16){x0[0], x0[1], x0[2], x0[3], x1[0], x1[1], x1[2], x1[3], x2[0], x2[1], x2[2], x2[3], x3[0], x3[1], x3[2], x3[3]};
      p1 = (f32x16){y0[0], y0[1], y0[2], y0[3], y1[0], y1[1], y1[2], y1[3], y2[0], y2[1], y2[2], y2[3], y3[0], y3[1], y3[2], y3[3]}; }
    const char* kb[4];
#pragma unroll
    for (int dd = 0; dd < 4; ++dd) kb[dd] = K_lds + KB * SHM_K + KSWZ(r32, (dd * 16 + hi * 8) * 2);
#pragma unroll
    for (int d0 = 0; d0 < 8; ++d0) { const char* a = kb[d0 & 3] + (d0 >> 2) * 128;
        bf16x8 b0 = *reinterpret_cast<const bf16x8*>(a);
        bf16x8 b1 = *reinterpret_cast<const bf16x8*>(a + 32 * 256);
        p0 = __builtin_amdgcn_mfma_f32_32x32x16_bf16(b0, qr[d0], p0, 0, 0, 0);
        p1 = __builtin_amdgcn_mfma_f32_32x32x16_bf16(b1, qr[d0], p1, 0, 0, 0); }
}
template <int VB>
__device__ __forceinline__ void pv_tile(f32x16* o, int vb0, bf16x8 pa0, bf16x8 pa1, bf16x8 pa2, bf16x8 pa3) {
#define TRRD(dst, off) asm volatile("ds_read_b64_tr_b16 %0, %1 offset:%2" : "=&v"(dst) : "v"(vb0), "i"(off) : "memory")
#define PV_D0(d0) do { s16x4 l0, l1, l2, l3, h0, h1, h2, h3; constexpr int b_ = VB * SHM_V + v_rd_off(d0, 0, 0); \
        TRRD(l0, b_); TRRD(h0, b_ + 2048); TRRD(l1, b_ + 4096); TRRD(h1, b_ + 6144); TRRD(l2, b_ + 8192); TRRD(h2, b_ + 10240); TRRD(l3, b_ + 12288); TRRD(h3, b_ + 14336); \
        asm volatile("s_waitcnt lgkmcnt(0)" ::: "memory"); SBAR();   \
        o[d0] = __builtin_amdgcn_mfma_f32_32x32x16_bf16(pa0, (bf16x8){l0[0], l0[1], l0[2], l0[3], h0[0], h0[1], h0[2], h0[3]}, o[d0], 0, 0, 0);   \
        o[d0] = __builtin_amdgcn_mfma_f32_32x32x16_bf16(pa1, (bf16x8){l1[0], l1[1], l1[2], l1[3], h1[0], h1[1], h1[2], h1[3]}, o[d0], 0, 0, 0);   \
        o[d0] = __builtin_amdgcn_mfma_f32_32x32x16_bf16(pa2, (bf16x8){l2[0], l2[1], l2[2], l2[3], h2[0], h2[1], h2[2], h2[3]}, o[d0], 0, 0, 0);   \
        o[d0] = __builtin_amdgcn_mfma_f32_32x32x16_bf16(pa3, (bf16x8){l3[0], l3[1], l3[2], l3[3], h3[0], h3[1], h3[2], h3[3]}, o[d0], 0, 0, 0); } while (0)
    PV_D0(0); PV_D0(1); PV_D0(2); PV_D0(3);
#undef PV_D0
#undef TRRD
}

struct BlockRef { const bf16* Q; const bf16* K; const bf16* V; bf16* O; int P0; int bh; };
struct Seam { bf16x8 qr[8]; bf16x8 st_v0, st_v1, st_k0, st_k1; };
#define ROW(p, k0, rr) ((const bf16*)((const char*)((p) + (size_t)(k0) * D) + (unsigned)(((rr) * D + sc) * 2)))
#define VMW() asm volatile("s_waitcnt vmcnt(0)" ::: "memory")
#define VMWN(n) asm volatile("s_waitcnt vmcnt(%0)" :: "i"(n) : "memory")
#define SLOAD_H(Kp, Vp, k0) do { S.st_v0 = load8(ROW(Vp, k0, sr)); S.st_v1 = load8(ROW(Vp, k0, 32 + sr));              \
                         S.st_k0 = load8(ROW(Kp, k0, sr)); S.st_k1 = load8(ROW(Kp, k0, 32 + sr)); } while (0)
#define SWRITE_HK(bf) do { *(bf16x8*)(K_lds + (bf) * SHM_K + kws) = S.st_k0; *(bf16x8*)(K_lds + (bf) * SHM_K + kws + 32 * 256) = S.st_k1; } while (0)
#define SWRITE_HV(bf) do { *(bf16x8*)(V_lds + (bf) * SHM_V + vst0) = S.st_v0; *(bf16x8*)(V_lds + (bf) * SHM_V + vst1) = S.st_v1; } while (0)
#define SWRITE_H(bf) do { SWRITE_HV(bf); SWRITE_HK(bf); } while (0)
__device__ __forceinline__ void attn_prime(const BlockRef& cur, char* lds, Seam& S, const int wave) {
    int tid_raw_ = MK_TID(); asm volatile("" : "+v"(tid_raw_)); const int tid = tid_raw_, wid = __builtin_amdgcn_readfirstlane(tid >> 6), lane = tid & 63, r32 = lane & 31, hi = lane >> 5;
    const int sr = tid >> 4, sc = (tid & 15) * 8, kws = KSWZ(sr, sc * 2); char* K_lds = lds + 2 * SHM_V;
    for (int d0 = 0; d0 < 8; ++d0) S.qr[d0] = load8((const bf16*)((const char*)(cur.Q + (size_t)(wid * QBLK) * D) + (unsigned)((r32 * D + hi * 8) * 2)) + d0 * 16);
    SLOAD_H(cur.K, cur.V, 0); VMW(); SWRITE_HK(0);
    __syncthreads();
}
template <bool MOBA, bool NOBIAS = false>
__device__ __forceinline__ void attn_block(const BlockRef& cur, const BlockRef& nxt, char* lds, Seam& S, const float* __restrict__ biasG  , const unsigned* __restrict__ selG  , const int wave) {
    int tid_raw_ = MK_TID(); asm volatile("" : "+v"(tid_raw_)); const int tid = tid_raw_, wid = __builtin_amdgcn_readfirstlane(tid >> 6), lane = tid & 63, r32 = lane & 31, hi = lane >> 5;
    const int NT = (cur.P0 + QB) / KVBLK;
    const int qlo = cur.P0 + wid * QBLK, qm = qlo + r32 - 4 * hi;
    char* V_lds = lds; char* K_lds = lds + 2 * SHM_V;
    float* ws = (float*)(lds + LDS_WS) + wid * 64; float* li_l = ws, * al_l = ws + 32;
    float* biasL = (float*)(lds + LDS_BIAS); float* negL = (float*)(lds + LDS_NEG);
    unsigned selmask = 0u; const int own = cur.P0 >> 8;
    { int te = tid; asm volatile("" : "+v"(te));
      if (te < 64) negL[te] = -__builtin_inff();
      if (MOBA || NOBIAS) {
        *(f32x4*)(biasL + 4 * te) = *(const f32x4*)(biasG + (size_t)cur.bh * SEQ + 4 * te);
        if (MOBA) selmask = selG[(size_t)cur.bh * SEQ + cur.P0 + (te >> 6) * QBLK + (te & 31)];
      } else {
        f32x4 v = *(const f32x4*)(biasG + (size_t)cur.bh * SEQ + 4 * te); v[1] += v[0]; v[2] += v[1]; v[3] += v[2];
        float sc = v[3];
#pragma unroll
        for (int o = 1; o < 64; o <<= 1) { const float t = __shfl_up(sc, o); if ((te & 63) >= o) sc += t; }
        float* wsum = (float*)(lds + LDS_WS);
        if ((te & 63) == 63) wsum[te >> 6] = sc;
        __syncthreads();
        float base = sc - v[3];
#pragma unroll
        for (int w = 0; w < 7; ++w) if (w < (te >> 6)) base += wsum[w];
        const float ns = -1.0f / SCALE;
        *(f32x4*)(biasL + 4 * te) = (f32x4){(v[0] + base) * ns, (v[1] + base) * ns, (v[2] + base) * ns, (v[3] + base) * ns};
      } }
    __syncthreads();
    typedef const __attribute__((address_space(3))) char* lcp; const lcp bias_b = (lcp)((const char*)biasL) + 16 * hi; const lcp neg_b = (lcp)((const char*)negL) + 16 * hi;
    float m_reg = biasL[cur.P0 + wid * QBLK + r32], l_reg = 0; f32x16 o[4] = {};
    const int sr = tid >> 4, sc = (tid & 15) * 8, vst0 = v_st(sr, sc), vst1 = v_st(32 + sr, sc), kws = KSWZ(sr, sc * 2);
    const int vb0 = (int)(uintptr_t)V_lds + v_rd_base(lane);
    const bf16* Kh = cur.K; const bf16* Vh = cur.V;
#define RESC(a) do { if (__any((a) < 1.f)) { if (hi == 0) al_l[r32] = (a); asm volatile("s_waitcnt lgkmcnt(0)" ::: "memory");              \
                     for (int d_ = 0; d_ < 4; ++d_) for (int r = 0; r < 16; ++r) o[d_][r] *= al_l[crow(r, hi)]; } } while (0)
#define KBASE(t) ((t) * KVBLK)
#define BP(t) ((!MOBA || (KBASE(t) >> 8) >= own || ((selmask >> (KBASE(t) >> 8)) & 1u)) ? (bias_b + KBASE(t) * 4) : neg_b)
#define MASKT(P0_, P1_, t) do { const int kb_ = KBASE(t); if (kb_ + KVBLK - 1 > qlo) mask_tile(P0_, P1_, qm - kb_); } while (0)
#define SEAM_K0() do { VMWN(8); SWRITE_HK(0); SBAR(); } while (0)
    f32x16 pA0, pA1, pB0, pB1; float mnA, mnB, alA, alB; bf16x8 pa0, pa1, pa2, pa3;
    SWRITE_HV(0); SBAR();
    SLOAD_H(Kh, Vh, KBASE(1));
    SBAR(); qkt<0, NOBIAS>(pA0, pA1, K_lds, r32, hi, S.qr, BP(0));
    MASKT(pA0, pA1, 0); partialSM(pA0, pA1, m_reg, mnA, alA);
    VMW(); SWRITE_H(1);
    __syncthreads();
#define HALF_STEP(PX0, PX1, mnX, alX, PY0, PY1, alY, t, KB, VB, SB) do {                                                      \
        SBAR(); qkt<KB, NOBIAS>(PX0, PX1, K_lds, r32, hi, S.qr, BP(t));                                                               \
        finishSM(PY0, PY1, alY, l_reg, pa0, pa1, pa2, pa3); SBAR();                                                           \
        if ((t) + 1 < NT) { SLOAD_H(Kh, Vh, KBASE((t) + 1)); SBAR(); }                                                        \
        pv_tile<VB>(o, vb0, pa0, pa1, pa2, pa3); MASKT(PX0, PX1, (t)); partialSM(PX0, PX1, m_reg, mnX, alX);                  \
        __syncthreads();                                                                                                      \
        if ((t) + 1 < NT) { VMW(); SWRITE_H(SB); }                                                                            \
        RESC(alX); __syncthreads(); } while (0)
    for (int t = 1; t + 1 < NT; t += 2) {
        HALF_STEP(pB0, pB1, mnB, alB, pA0, pA1, alA, t, 1, 0, 0);
        HALF_STEP(pA0, pA1, mnA, alA, pB0, pB1, alB, t + 1, 0, 1, 1);
    }
    { SBAR(); qkt<1, NOBIAS>(pB0, pB1, K_lds, r32, hi, S.qr, BP(NT - 1)); SBAR(); }
    SLOAD_H(nxt.K, nxt.V, 0); SBAR();
    { int lq = lane; asm volatile("" : "+v"(lq));
#pragma unroll
    for (int d0 = 0; d0 < 8; ++d0) S.qr[d0] = load8((const bf16*)((const char*)(nxt.Q + (size_t)(wid * QBLK) * D) + (unsigned)(((lq & 31) * D + (lq >> 5) * 8) * 2)) + d0 * 16); }
    SBAR();
    finishSM(pA0, pA1, alA, l_reg, pa0, pa1, pa2, pa3); SBAR();
    pv_tile<0>(o, vb0, pa0, pa1, pa2, pa3);
    { MASKT(pB0, pB1, NT - 1); partialSM(pB0, pB1, m_reg, mnB, alB); __syncthreads(); RESC(alB);
      finishSM(pB0, pB1, alB, l_reg, pa0, pa1, pa2, pa3); SBAR(); pv_tile<1>(o, vb0, pa0, pa1, pa2, pa3); }
    SBAR(); SEAM_K0();
    { int le = lane; asm volatile("" : "+v"(le)); const int r32e = le & 31, hie = le >> 5;
    if (hie == 0) li_l[r32e] = l_reg; asm volatile("s_waitcnt lgkmcnt(0)" ::: "memory");
    float rli[16];
#pragma unroll
    for (int r = 0; r < 16; ++r) rli[r] = __builtin_amdgcn_rcpf(li_l[crow(r, hie)]);
    bf16* Ow = cur.O + (size_t)(wid * QBLK) * OS; char* stg = lds + LDS_OST + wid * OST_WAVE;
#pragma unroll
    for (int p = 0; p < 2; ++p) {
#pragma unroll
        for (int j = 0; j < 8; ++j) { const int r = 8 * p + j, lrow = (j & 3) + 8 * (j >> 2) + 4 * hie;
#pragma unroll
            for (int d0 = 0; d0 < 4; ++d0) { const float v = o[d0][r] * rli[r]; *(unsigned short*)(stg + lrow * 272 + (32 * d0 + r32e) * 2) = (unsigned short)cvtpk(v, v); } }
        asm volatile("s_waitcnt lgkmcnt(0)" ::: "memory");
#pragma unroll
        for (int i = 0; i < 4; ++i) { const int row = (le >> 4) + 4 * i, c = le & 15; const u32x4 w = *(const u32x4*)(stg + row * 272 + c * 16);
#if defined(MK_ASMST) && MK_ASMST == 2
            asm volatile("global_store_dwordx4 %0, %1, off\n\ts_nop 1" :: "v"(Ow + (size_t)(16 * p + row) * OS + c * 8), "v"(w) : "memory"); }
#elif !defined(MK_ASMST) || MK_ASMST
            asm volatile("global_store_dwordx4 %0, %1, off sc1\n\ts_nop 1" :: "v"(Ow + (size_t)(16 * p + row) * OS + c * 8), "v"(w) : "memory"); }
#else
            *(u32x4*)(Ow + (size_t)(16 * p + row) * OS + c * 8) = w; }
#endif
        asm volatile("s_waitcnt lgkmcnt(0)" ::: "memory");
    } }
    __syncthreads();
#undef RESC
#undef KBASE
#undef BP
#undef MASKT
#undef SEAM_K0
#undef HALF_STEP
}
#undef ROW
#undef VMW
#undef VMWN
#undef SLOAD_H
#undef SWRITE_HK
#undef SWRITE_HV
#undef SWRITE_H

template <bool MOBA, bool NOBIAS = false>
__device__ __forceinline__ void attn_phase(char* lds, const bf16* Q, const bf16* K, const bf16* V, bf16* O, const float* biasG, const unsigned* selG, const int wave) {
    const int G = gridDim.x; int idx = blockIdx.x; if (idx >= 256) return;
    auto ref = [&](int id, int pass) { const int xcd = id & 7, k = id >> 3, bh = xcd * 8 + (k >> 2), y = k & 3, qb = pass ? 7 - y : y, b = bh >> 4, h = bh & 15;
        BlockRef r; r.Q = Q + ((size_t)bh * SEQ + (size_t)qb * QB) * D; r.K = K + (size_t)bh * SEQ * D; r.V = V + (size_t)bh * SEQ * D;
        r.O = O + ((size_t)b * SEQ + (size_t)qb * QB) * OS + h * D; r.P0 = qb * QB; r.bh = bh; return r; };
    int pass = 0; BlockRef cur = ref(idx, 0);
    Seam S;
    attn_prime(cur, lds, S, wave);
    for (;;) {
        const bool more_pass = pass == 0, more_item = idx + G < 256, last = !more_pass && !more_item;
        int idn = idx, passn = pass + 1; if (!more_pass) { passn = 0; idn = more_item ? idx + G : idx; }
        const BlockRef nxt = last ? cur : ref(idn, passn);
        attn_block<MOBA, NOBIAS>(cur, nxt, lds, S, biasG, selG, wave);
        if (last) break;
        cur = nxt; idx = idn; pass = passn;
    }
}
}
constexpr int NWAVES = 8;
constexpr int BATCH = 4, SEQ = 2048, DM = 2048, M = BATCH * SEQ, FF = 5632, NH = 16, HD = 128, PLE = 256, DEPTH = 4;
constexpr size_t MiB = 1u << 20;
constexpr size_t WS_CTL = 0, CTL_ZERO_BYTES = 32768;
constexpr size_t WS_WFI = 1 * MiB;
constexpr size_t WS_WFO = WS_WFI + 352 * MiB;
constexpr size_t WS_WPG = WS_WFO + 176 * MiB;
constexpr size_t WS_WPP = WS_WPG + 32 * MiB;
constexpr size_t WS_WQKV = WS_WPP + 4 * MiB;
constexpr size_t WS_WO = WS_WQKV + 72 * MiB;
constexpr size_t WS_WS5I = WS_WO + 24 * MiB;
constexpr size_t WS_WGLU = WS_WS5I + 8 * MiB;
constexpr size_t WS_S5TV = WS_WGLU + 16 * MiB;
constexpr size_t WS_S5W = WS_S5TV + 80 * MiB;
constexpr size_t WS_WFT = WS_S5W + 32 * MiB;
constexpr size_t WS_H = WS_WFT + 1 * MiB;
constexpr size_t WS_HB = WS_H + 64 * MiB;
constexpr size_t WS_ACT = WS_HB + 32 * MiB;
constexpr size_t WS_QKV = WS_ACT + 88 * MiB;
constexpr size_t WS_OB = WS_QKV + 96 * MiB;
constexpr size_t WS_SSQ = WS_OB + 32 * MiB;
constexpr size_t WS_PP = WS_SSQ + 1 * MiB;
constexpr size_t WS_PBF = WS_PP + 128 * MiB;
constexpr size_t WS_LOGF = WS_PBF + 16 * MiB;
constexpr size_t WS_KMEAN = WS_LOGF + 1 * MiB;
constexpr size_t WS_UH = WS_KMEAN + 1 * MiB;
constexpr size_t WS_HLOC = WS_UH + 40 * MiB;
constexpr size_t WS_YB = WS_HLOC + 16 * MiB;
constexpr size_t WS_HB2 = WS_YB + 32 * MiB;
constexpr size_t WS_H2 = WS_HB2 + 32 * MiB;
constexpr size_t WS_BIAS = WS_H2 + 64 * MiB;
constexpr size_t WS_SEL = WS_BIAS + 1 * MiB;
constexpr size_t WS_END = WS_SEL + 1 * MiB;
constexpr int CW_TAIL = 3072, CW_BATCH = 3328, CW_PP = 3584, CW_S5U = 3648, CW_S5G = 3776;
constexpr int CW_BAR = 4096;
constexpr int RING_OFF = 0, RING_BYTES = 131072, EPI_OFF = 131072, LDSCTL_OFF = 139264, MISC_OFF = LDSCTL_OFF + 320, LDS_BYTES = 147456;
static_assert(att::LDS_BYTES <= RING_BYTES && pg8::EPI_LDS_OFF == EPI_OFF, "LDS map");

#define GAS __attribute__((address_space(1)))
#define LAS __attribute__((address_space(3)))
typedef unsigned short bf16;
typedef unsigned v4u __attribute__((ext_vector_type(4)));
typedef unsigned v2u __attribute__((ext_vector_type(2)));
typedef float f32x4 __attribute__((ext_vector_type(4)));
typedef float f32x2 __attribute__((ext_vector_type(2)));
typedef GAS unsigned gu32;
#define RLX_AGENT __ATOMIC_RELAXED, __HIP_MEMORY_SCOPE_AGENT
#define LDS_WAIT() asm volatile("s_waitcnt lgkmcnt(0)" ::: "memory")
#define VM_WAIT() asm volatile("s_waitcnt vmcnt(0)" ::: "memory")
__device__ __forceinline__ unsigned f2bf(float f) { unsigned u = __builtin_bit_cast(unsigned, f); return (u + 0x7fffu + ((u >> 16) & 1u)) >> 16; }
__device__ __forceinline__ unsigned pk2(float lo, float hi) { return f2bf(lo) | (f2bf(hi) << 16); }
__device__ __forceinline__ float wave_sum(float v) {
#pragma unroll
    for (int o = 1; o < 64; o <<= 1) v += __shfl_xor(v, o);
    return v;
}

#define XB_TMO      128
#define XB_XCNT(j)  (256  + 64 * (j))
#define XB_XSUB(j)  (1280 + 64 * (j))
#define XB_XGEN(j)  (2304 + 64 * (j))
#define XB_TOP      3328
#define XB_TOPGEN   3392
#define XCD_BAR_WORDS 3456
#define XB_SPIN_CAP (1u << 18)

__device__ __forceinline__ unsigned xb_ld(unsigned* p)              { return __hip_atomic_load(p, __ATOMIC_RELAXED, __HIP_MEMORY_SCOPE_AGENT); }
__device__ __forceinline__ unsigned xb_add(unsigned* p, unsigned v) { return __hip_atomic_fetch_add(p, v, __ATOMIC_RELAXED, __HIP_MEMORY_SCOPE_AGENT); }
__device__ __forceinline__ unsigned xb_xcc_id() { return (unsigned)__builtin_amdgcn_s_getreg((3 << 11) | 20) & 0xFu; }
#define XB_SPIN(cond, bar) do { unsigned _sp = 0; while (cond) { __builtin_amdgcn_s_sleep(1); \
    if ((++_sp & 255u) == 0u) { if (xb_ld(&(bar)[XB_TMO])) break; if (_sp > XB_SPIN_CAP) { atomicAdd(&(bar)[XB_TMO], 1u); break; } } } } while (0)

struct XcdBarrier {
    unsigned* bar; unsigned x;
    volatile LAS unsigned* st;
};

__device__ __forceinline__ XcdBarrier xcd_barrier_post(unsigned* bar, volatile LAS unsigned* st, int wave) {
    XcdBarrier b; b.bar = bar; b.x = xb_xcc_id(); b.st = st;
    if (XB_TID == 0) (void)xb_add(&bar[XB_XCNT(b.x)], 1u);
    return b;
}
__device__ __forceinline__ void xcd_barrier_complete(unsigned* bar, unsigned x, unsigned& nloc, unsigned& nx) {
    const unsigned G = gridDim.x * gridDim.y * gridDim.z;
    unsigned sum, cnt, mine, sp = 0u;
    for (;;) {
        sum = 0u; cnt = 0u; mine = 0u;
#pragma unroll
        for (unsigned j = 0; j < 16; ++j) { const unsigned c = xb_ld(&bar[XB_XCNT(j)]); sum += c; cnt += (c > 0u) ? 1u : 0u; mine = (j == x) ? c : mine; }
        if (sum == G) break;
        __builtin_amdgcn_s_sleep(1);
        if ((++sp & 255u) == 0u) { if (xb_ld(&bar[XB_TMO])) break; if (sp > XB_SPIN_CAP) { atomicAdd(&bar[XB_TMO], 1u); break; } }
    }
    nloc = mine > 0u ? mine : 1u; nx = cnt > 0u ? cnt : 1u;
}

__device__ __forceinline__ void xcd_barrier(const XcdBarrier& b, int wave) {
    asm volatile("s_waitcnt vmcnt(0)" ::: "memory");
    __syncthreads();
    if (XB_TID == 0) {
        unsigned* bar = b.bar;
        __builtin_amdgcn_s_waitcnt(0);
        unsigned nloc = b.st[0], nx = b.st[1];
        if (nloc == 0u) { xcd_barrier_complete(bar, b.x, nloc, nx); b.st[0] = nloc; b.st[1] = nx; }
        const unsigned old = xb_add(&bar[XB_XSUB(b.x)], 1u);
        const unsigned gen = old / nloc;
        if (old + 1u == (gen + 1u) * nloc) {
            __builtin_amdgcn_fence(__ATOMIC_RELEASE, "agent");
            asm volatile("s_waitcnt vmcnt(0)" ::: "memory");
            const unsigned og = xb_add(&bar[XB_TOP], 1u);
            const unsigned tg = og / nx;
            if (og + 1u == (tg + 1u) * nx) xb_add(&bar[XB_TOPGEN], 1u);
            else XB_SPIN(xb_ld(&bar[XB_TOPGEN]) == tg, bar);
            __builtin_amdgcn_fence(__ATOMIC_ACQUIRE, "agent");
            xb_add(&bar[XB_XGEN(b.x)], 1u);
            asm volatile("s_waitcnt vmcnt(0)" ::: "memory");
        } else {
            XB_SPIN(xb_ld(&bar[XB_XGEN(b.x)]) == gen, bar);
            __builtin_amdgcn_fence(__ATOMIC_ACQUIRE, "agent");
            asm volatile("s_waitcnt vmcnt(0)" ::: "memory");
        }
    }
    __syncthreads();
}

struct Args { const float* in[23]; float* out; unsigned char* ws; int ph_lo, ph_hi; };

__device__ __forceinline__ void panel_wait(unsigned* cnt, unsigned target, unsigned* bar, int wave) {
    asm volatile("" : "+s"(wave));
#ifndef MK_EARLYINV
#define MK_EARLYINV 1
#endif
    if (wave == 0) {
        unsigned sp = 0u;
#if MK_EARLYINV
        asm volatile("buffer_inv sc1" ::: "memory");
#endif
        while ((unsigned)__builtin_amdgcn_readfirstlane((int)__hip_atomic_load(cnt, __ATOMIC_RELAXED, __HIP_MEMORY_SCOPE_AGENT)) < target) {
            __builtin_amdgcn_s_sleep(1);
            if ((++sp & 255u) == 0u) { if (xb_ld(&bar[XB_TMO])) break; if (sp > XB_SPIN_CAP) { atomicAdd(&bar[XB_TMO], 1u); break; } }
        }
#if !MK_EARLYINV
        __builtin_amdgcn_fence(__ATOMIC_ACQUIRE, "agent");
#endif
        asm volatile("s_waitcnt vmcnt(0)" ::: "memory");
    }
    __syncthreads();
}

#ifndef MK_ASMST
#define MK_ASMST 1
#endif
#if MK_ASMST == 2
__device__ __forceinline__ void st_wt16(void* p, v4u v) { asm volatile("global_store_dwordx4 %0, %1, off\n\ts_nop 1" :: "v"(p), "v"(v) : "memory"); }
#elif MK_ASMST
__device__ __forceinline__ void st_wt16(void* p, v4u v) { asm volatile("global_store_dwordx4 %0, %1, off sc1\n\ts_nop 1" :: "v"(p), "v"(v) : "memory"); }
#else
__device__ __forceinline__ void st_wt16(void* p, v4u v) { *(v4u*)p = v; }
#endif
__device__ __forceinline__ void st_wt16_nt(void* p, v4u v) { asm volatile("global_store_dwordx4 %0, %1, off sc1 nt\n\ts_nop 1" :: "v"(p), "v"(v) : "memory"); }
__device__ __forceinline__ void st_wt4(void* p, unsigned v) { __hip_atomic_store((unsigned*)p, v, __ATOMIC_RELAXED, __HIP_MEMORY_SCOPE_AGENT); }
__device__ __forceinline__ void cnt_arrive(unsigned* cnt, int lane, int wave) {
    asm volatile("s_waitcnt vmcnt(0)" : "+s"(cnt), "+s"(wave) :: "memory");
    __syncthreads();
    if (wave == 0 && lane == 0) __hip_atomic_fetch_add(cnt, 1u, __ATOMIC_RELAXED, __HIP_MEMORY_SCOPE_AGENT);
}
struct TrD { const float* src; bf16* dst; const float* scale; int ld, K, n0, k0, drow0; };
__device__ __forceinline__ void tr_ld(const TrD& d, f32x4 (&v)[16], int lane) {
    asm volatile("" : "+v"(lane));
    const int kr = lane >> 4, n4 = lane & 15;
#pragma unroll
    for (int i = 0; i < 16; ++i) v[i] = __builtin_nontemporal_load((const f32x4*)(d.src + (size_t)(d.k0 + 4 * i + kr) * d.ld + d.n0 + 4 * n4));
}
template <bool WT>
__device__ __forceinline__ void tr_fin(const TrD& d, const f32x4 (&v)[16], LAS float* scr, int lane) {
    asm volatile("" : "+v"(lane));
    const int kr = lane >> 4, n4 = lane & 15; const int K = d.K, k0 = d.k0;
#pragma unroll
    for (int i = 0; i < 16; ++i) { LAS float* p = scr + (4 * i + kr) * 65 + 4 * n4; p[0] = v[i][0]; p[1] = v[i][1]; p[2] = v[i][2]; p[3] = v[i][3]; }
    LDS_WAIT(); asm volatile("" ::: "memory");
    const int c = lane & 7, nn = lane >> 3;
    f32x4 s0 = (f32x4){1.f, 1.f, 1.f, 1.f}, s1 = s0;
    if (d.scale) { s0 = *(const f32x4*)(d.scale + k0 + 8 * c); s1 = *(const f32x4*)(d.scale + k0 + 8 * c + 4); }
#pragma unroll
    for (int j = 0; j < 8; ++j) { const int n = nn + 8 * j; const LAS float* s = scr + (8 * c) * 65 + n;
        v4u o; o.x = pk2(s[0 * 65] * s0[0], s[1 * 65] * s0[1]); o.y = pk2(s[2 * 65] * s0[2], s[3 * 65] * s0[3]); o.z = pk2(s[4 * 65] * s1[0], s[5 * 65] * s1[1]); o.w = pk2(s[6 * 65] * s1[2], s[7 * 65] * s1[3]);
#ifndef MK_TAILFENCE
#define MK_TAILFENCE 0
#endif
        if (WT && !MK_TAILFENCE) st_wt16(d.dst + (size_t)(d.drow0 + n) * K + k0 + 8 * c, o); else __builtin_nontemporal_store(o, (v4u*)(d.dst + (size_t)(d.drow0 + n) * K + k0 + 8 * c)); }
    LDS_WAIT(); asm volatile("" ::: "memory");
}
template <bool WT>
__device__ __forceinline__ void tr_item(const float* __restrict__ src, int ld, int K, bf16* __restrict__ dst, const float* __restrict__ scale, int n0, int k0, int drow0, LAS float* scr, int lane) {
    const TrD d{src, dst, scale, ld, K, n0, k0, drow0}; f32x4 v[16]; tr_ld(d, v, lane); tr_fin<WT>(d, v, scr, lane);
}
template <bool WT = false, bool DESC = false>
__device__ __forceinline__ void tr_job(const float* src, int ld, int K, int N, bf16* dst, const float* scale, int ilv, int r, LAS float* scr, int lane, TrD* out = nullptr) {
#ifdef MK_CV18
    const int nb = N / 64, sb = r >> 3, j8 = r & 7; const bool k8 = ((K >> 6) & 7) == 0;
    const int kb = k8 ? (sb / nb) * 8 + j8 : (sb / (nb >> 1)) * 4 + (j8 >> 1), nbi = k8 ? sb % nb : (sb % (nb >> 1)) * 2 + (j8 & 1), n0 = nbi * 64;
#else
    const int nb = N / 64, sb = r >> 3, j8 = r & 7, kb = (sb / (nb >> 1)) * 4 + (j8 >> 1), nbi = (sb % (nb >> 1)) * 2 + (j8 & 1), n0 = nbi * 64;
#endif
    int drow0 = n0;
    if (ilv) { const int hsel = n0 >= ilv ? 1 : 0, nn = n0 - hsel * ilv; drow0 = (nn >> 7) * 256 + hsel * 128 + (nn & 127); }
    if (DESC) *out = TrD{src, dst, scale, ld, K, n0, kb * 64, drow0}; else tr_item<WT>(src, ld, K, dst, scale, n0, kb * 64, drow0, scr, lane);
}

__device__ __forceinline__ void s5_ops_group(const Args& a, int g, LAS float* L, int tid) {
    const float* a_re = a.in[14]; const float* a_im = a.in[15]; const float* log_dt = a.in[16]; const float* b_re = a.in[17]; const float* b_im = a.in[18];
    const float* c_re = a.in[19]; const float* c_im = a.in[20]; const float* dsk = a.in[21];
    LAS float* apr = L; LAS float* api = L + 2112; LAS float* qr = L + 4224; LAS float* qi = qr + 64; LAS float* Cr = qi + 64; LAS float* Ci = Cr + 1024;
    LAS float* Br = Ci + 1024; LAS float* Bi = Br + 1024; LAS float* Kt = Bi + 1024;
    bf16* TV = (bf16*)(a.ws + WS_S5TV) + (size_t)g * 512 * 640; bf16* W = (bf16*)(a.ws + WS_S5W) + (size_t)g * 256 * 512;
    const float dt = expf(log_dt[g]);
    for (int idx = tid; idx < 33 * 64; idx += 512) { const int tau = idx >> 6, p = idx & 63; const float ar = a_re[g * 64 + p], ai = a_im[g * 64 + p];
        const float mag = expf(ar * dt * (float)tau); float sn, cs; sincosf(ai * dt * (float)tau, &sn, &cs); apr[idx] = mag * cs; api[idx] = mag * sn; }
    if (tid < 64) { const float ar = a_re[g * 64 + tid], ai = a_im[g * 64 + tid]; const float er = expf(ar * dt); float sn, cs; sincosf(ai * dt, &sn, &cs);
        const float nr = er * cs - 1.f, ni = er * sn, den = ar * ar + ai * ai; qr[tid] = (nr * ar + ni * ai) / den; qi[tid] = (ni * ar - nr * ai) / den; }
    for (int idx = tid; idx < 1024; idx += 512) { Cr[idx] = c_re[(size_t)g * 1024 + idx]; Ci[idx] = c_im[(size_t)g * 1024 + idx]; }
    __syncthreads();
    for (int idx = tid; idx < 1024; idx += 512) { const int p = idx >> 4; const float br = b_re[(size_t)g * 1024 + idx], bi = b_im[(size_t)g * 1024 + idx];
        Br[idx] = qr[p] * br - qi[p] * bi; Bi[idx] = qr[p] * bi + qi[p] * br; }
    __syncthreads();
    for (int idx = tid; idx < 32 * 256; idx += 512) { const int tau = idx >> 8, c = (idx >> 4) & 15, cp = idx & 15; float s = 0.f;
        for (int p = 0; p < 64; ++p) { const float ar_ = apr[tau * 64 + p], ai_ = api[tau * 64 + p], br = Br[p * 16 + cp], bi = Bi[p * 16 + cp];
            const float xr = ar_ * br - ai_ * bi, xi = ar_ * bi + ai_ * br; s += Cr[c * 64 + p] * xr - Ci[c * 64 + p] * xi; }
        if (tau == 0 && c == cp) s += dsk[g * 16 + c];
        Kt[idx] = s; }
    __syncthreads();
    for (int idx = tid; idx < 512 * 80; idx += 512) { const int n = idx / 80, ch = idx % 80, j = n >> 4, c = n & 15; float o[8];
        if (ch < 64) { const int jp = ch >> 1, c0 = (ch & 1) * 8;
#pragma unroll
            for (int e = 0; e < 8; ++e) o[e] = (jp <= j) ? Kt[(j - jp) * 256 + c * 16 + c0 + e] : 0.f; }
        else { const int p0 = (ch - 64) * 4;
#pragma unroll
            for (int e = 0; e < 4; ++e) { const int p = p0 + e; const float ar_ = apr[(j + 1) * 64 + p], ai_ = api[(j + 1) * 64 + p], cr = Cr[c * 64 + p], ci = Ci[c * 64 + p];
                o[2 * e] = cr * ar_ - ci * ai_; o[2 * e + 1] = -(cr * ai_ + ci * ar_); } }
        v4u w; w.x = pk2(o[0], o[1]); w.y = pk2(o[2], o[3]); w.z = pk2(o[4], o[5]); w.w = pk2(o[6], o[7]);
        *(v4u*)(TV + (size_t)n * 640 + ch * 8) = w; }
    for (int idx = tid; idx < 128 * 64; idx += 512) { const int n = idx >> 6, ch = idx & 63, p = n >> 1, ri = n & 1, jp = ch >> 1, c0 = (ch & 1) * 8; float o[8];
        const float ar_ = apr[(31 - jp) * 64 + p], ai_ = api[(31 - jp) * 64 + p];
#pragma unroll
        for (int e = 0; e < 8; ++e) { const float br = Br[p * 16 + c0 + e], bi = Bi[p * 16 + c0 + e]; o[e] = ri ? (ar_ * bi + ai_ * br) : (ar_ * br - ai_ * bi); }
        v4u w; w.x = pk2(o[0], o[1]); w.y = pk2(o[2], o[3]); w.z = pk2(o[4], o[5]); w.w = pk2(o[6], o[7]);
        *(v4u*)(W + (size_t)n * 512 + ch * 8) = w; }
    __syncthreads();
}

namespace cv {
constexpr int I_FI = 32 * 176, I_FO = 88 * 32, I_PG = 32 * 32, I_QKV = 32 * 96, I_WO = 32 * 32, I_S5I = 32 * 32, I_GLU = 32 * 64, I_WF = 16;
constexpr int mix_items(int L) { return (L % 3 == 0) ? I_QKV + I_WO + I_WF : ((L % 3 == 1) ? I_QKV + I_WO : I_S5I + I_GLU); }
constexpr int layer_items(int L) { return 2 * I_FI + 2 * I_FO + I_PG + mix_items(L); }
constexpr int layer_start(int L) { int s = 0; for (int l = 0; l < L; ++l) s += layer_items(l); return s; }
constexpr int TOTAL = layer_start(4);
constexpr int pos_after(int L, int h) { return layer_start(L) + I_FI + (h ? I_FO + mix_items(L) + I_FI : 0); }
#ifndef MK_TAILQ
#define MK_TAILQ 7
#endif
constexpr int TAIL_WAVES = 128 * NWAVES, QTOT = MK_TAILQ * TAIL_WAVES;
constexpr int tail_b(int k) { int hi = TOTAL; for (int j = 7; j > k; --j) { const int pa = pos_after(j >> 1, j & 1); const int a = (hi - QTOT > pa) ? hi - QTOT : pa; hi = a < hi ? a : hi; } return hi; }
constexpr int tail_a(int k) { const int hi = tail_b(k), pa = pos_after(k >> 1, k & 1); const int a = (hi - QTOT > pa) ? hi - QTOT : pa; return a < hi ? a : hi; }
}
template <bool WT = false, bool DESC = false>
__device__ __forceinline__ bool cv_item(const Args& a, int idx, LAS float* scr, int lane, TrD* out = nullptr) {
    using namespace cv;
    const float* norm_g = a.in[2]; unsigned char* ws = a.ws;
    const int L = idx >= layer_start(3) ? 3 : (idx >= layer_start(2) ? 2 : (idx >= layer_start(1) ? 1 : 0));
    int r = idx - (L == 3 ? layer_start(3) : (L == 2 ? layer_start(2) : (L == 1 ? layer_start(1) : 0)));
    const int kind = L % 3, mixn = kind == 0 ? I_QKV + I_WO + I_WF : (kind == 1 ? I_QKV + I_WO : I_S5I + I_GLU);
    int half = 0;
    if (r >= I_FI + I_FO + mixn) { r -= I_FI + I_FO + mixn; half = 1; if (r >= I_FI + I_FO) {
            r -= I_FI + I_FO; tr_job<WT, DESC>(a.in[6] + (size_t)L * DM * DM, DM, DM, DM, (bf16*)(ws + WS_WPG) + (size_t)L * DM * DM, norm_g + (L * 4 + 3) * DM, 0, r, scr, lane, out); return true; } }
    else if (r >= I_FI + I_FO) { r -= I_FI + I_FO;
        if (kind < 2) { const int m = L == 0 ? 0 : (L == 1 ? 1 : 2);
            if (kind == 0) { if (r >= I_WF) r -= I_WF; else { if (DESC) return false;
                const int j = m >> 1, hd = r; const float* src = a.in[8] + (size_t)j * DM * (3 * DM + NH) + 3 * DM + hd; const float* g1 = norm_g + (L * 4 + 1) * DM;
                bf16* dst = (bf16*)(ws + WS_WFT) + (size_t)j * 2 * 16 * DM + (size_t)hd * DM;
                for (int k = 2 * lane; k < DM; k += 128) { const float w0 = g1[k] * src[(size_t)k * (3 * DM + NH)], w1 = g1[k + 1] * src[(size_t)(k + 1) * (3 * DM + NH)];
                    const unsigned h0 = f2bf(w0), h1 = f2bf(w1); const unsigned l0 = f2bf(w0 - __uint_as_float(h0 << 16)), l1 = f2bf(w1 - __uint_as_float(h1 << 16));
                    st_wt4(dst + k, h0 | (h1 << 16)); st_wt4(dst + 16 * DM + k, l0 | (l1 << 16)); }
                return true; } }
            if (r < I_QKV) { const float* src = m == 1 ? a.in[11] : a.in[8] + (size_t)(m >> 1) * DM * (3 * DM + NH); const int ld = m == 1 ? 3 * DM : 3 * DM + NH;
                tr_job<WT, DESC>(src, ld, DM, 3 * DM, (bf16*)(ws + WS_WQKV) + (size_t)m * 3 * DM * DM, norm_g + (L * 4 + 1) * DM, 0, r, scr, lane, out); return true; } r -= I_QKV;
            if (r < I_WO) { const float* src = m == 1 ? a.in[12] : a.in[10] + (size_t)(m >> 1) * DM * DM;
                tr_job<WT, DESC>(src, DM, DM, DM, (bf16*)(ws + WS_WO) + (size_t)m * DM * DM, nullptr, 0, r, scr, lane, out); return true; } }
        if (r < I_S5I) { tr_job<WT, DESC>(a.in[13], DM, DM, DM, (bf16*)(ws + WS_WS5I), norm_g + (2 * 4 + 1) * DM, 0, r, scr, lane, out); return true; } r -= I_S5I;
        tr_job<WT, DESC>(a.in[22], 2 * DM, DM, 2 * DM, (bf16*)(ws + WS_WGLU), nullptr, DM, r, scr, lane, out); return true; }
    const int m = L * 2 + half;
    if (r < I_FI) { tr_job<WT, DESC>(a.in[4] + (size_t)m * DM * 2 * FF, 2 * FF, DM, 2 * FF, (bf16*)(ws + WS_WFI) + (size_t)m * 2 * FF * DM, norm_g + (L * 4 + half * 2) * DM, FF, r, scr, lane, out); return true; }
    r -= I_FI;
    tr_job<WT, DESC>(a.in[5] + (size_t)m * FF * DM, DM, FF, DM, (bf16*)(ws + WS_WFO) + (size_t)m * DM * FF, nullptr, 0, r, scr, lane, out); return true;
}
#ifndef MK_CVPIPE
#define MK_CVPIPE 0
#endif
template <bool WT>
__device__ __forceinline__ void cv_range(const Args& a, int it, int hi, int step, LAS float* scr, int lane) {
#if MK_CVPIPE
    if (WT && MK_CVPIPE < 2) { for (; it < hi; it += step) cv_item<WT>(a, it, scr, lane); return; }
    if (it >= hi) return;
    TrD dc; f32x4 vc[16]; bool wfc = !cv_item<WT, true>(a, it, scr, lane, &dc);
    if (!wfc) tr_ld(dc, vc, lane);
    for (;;) {
        const int nx = it + step; const bool hn = nx < hi; TrD dn = dc; f32x4 vn[16]; bool wfn = false;
        if (hn) { wfn = !cv_item<WT, true>(a, nx, scr, lane, &dn); if (!wfn) tr_ld(dn, vn, lane); }
        if (wfc) cv_item<WT, false>(a, it, scr, lane); else tr_fin<WT>(dc, vc, scr, lane);
        if (!hn) break;
        dc = dn; wfc = wfn; it = nx;
#pragma unroll
        for (int i = 0; i < 16; ++i) vc[i] = vn[i];
    }
#else
    for (; it < hi; it += step) cv_item<WT>(a, it, scr, lane);
#endif
}
__device__ __forceinline__ void cv_tail(const Args& a, int k, LAS unsigned char* lds, int lane, int wave, int bx, int G) {
    if (G != 256 || bx < 128) return;
    int lo_ = 0, hi_ = 0;
    switch (k) { case 0: lo_ = cv::tail_a(0); hi_ = cv::tail_b(0); break; case 1: lo_ = cv::tail_a(1); hi_ = cv::tail_b(1); break; case 2: lo_ = cv::tail_a(2); hi_ = cv::tail_b(2); break;
                 case 3: lo_ = cv::tail_a(3); hi_ = cv::tail_b(3); break; case 4: lo_ = cv::tail_a(4); hi_ = cv::tail_b(4); break; case 5: lo_ = cv::tail_a(5); hi_ = cv::tail_b(5); break;
                 case 6: lo_ = cv::tail_a(6); hi_ = cv::tail_b(6); break; default: lo_ = cv::tail_a(7); hi_ = cv::tail_b(7); break; }
    LAS float* scr = (LAS float*)(lds + wave * 16640);
    cv_range<true>(a, lo_ + (bx - 128) * NWAVES + wave, hi_, cv::TAIL_WAVES, scr, lane);
#if MK_TAILFENCE
    { unsigned* cnt_ = (unsigned*)(a.ws + WS_CTL) + CW_TAIL + 32 * k; int w_ = wave; asm volatile("s_waitcnt vmcnt(0)" : "+s"(cnt_), "+s"(w_) :: "memory"); __syncthreads();
      if (w_ == 0) { __builtin_amdgcn_fence(__ATOMIC_RELEASE, "agent"); asm volatile("s_waitcnt vmcnt(0)" ::: "memory"); if (lane == 0) __hip_atomic_fetch_add(cnt_, 1u, __ATOMIC_RELAXED, __HIP_MEMORY_SCOPE_AGENT); } }
#else
    cnt_arrive((unsigned*)(a.ws + WS_CTL) + CW_TAIL + 32 * k, lane, wave);
#endif
}
__device__ __forceinline__ void moba_bias_phase(float* bias, int lane, int gw, int NGW) {
    for (int task = gw; task < 64 * 8; task += NGW) { const int bh = task >> 3, s0 = (task & 7) * 256 + 4 * lane;
        const float sl = exp2f(-0.5f * (float)((bh & 15) + 1)) * (1.0f / att::SCALE);
        *(f32x4*)(bias + (size_t)bh * SEQ + s0) = (f32x4){sl * (float)s0, sl * (float)(s0 + 1), sl * (float)(s0 + 2), sl * (float)(s0 + 3)}; }
}
__device__ __forceinline__ void p0_prologue(const Args& a, LAS unsigned char* lds, int tid, int lane, int wave, int vcu, int G) {
    const float* x = a.in[0]; const float* p = a.in[1];
    unsigned char* ws = a.ws;
    for (int g = vcu; g < 128; g += G) s5_ops_group(a, g, (LAS float*)lds, tid);
    moba_bias_phase((float*)(ws + WS_BIAS), lane, vcu * NWAVES + wave, G * NWAVES);
    LAS float* scr = (LAS float*)(lds + wave * 16640);
    const int gw = vcu * NWAVES + wave, NGW = G * NWAVES;
    constexpr int I_PPJ = 4 * 32, I_X = M, I_P = 4 * M * PLE / 512;
    const int n_cv = (G == 256) ? cv::tail_a(0) : cv::TOTAL;
    const int NITEMS = n_cv + 4 * I_PPJ + I_X + I_P;
#ifndef MK_S5SKIP
#define MK_S5SKIP 3
#endif
    if (G == 256 && MK_S5SKIP > 0 && n_cv > 2048 * MK_S5SKIP) {
        if (vcu >= 128) cv_range<false>(a, gw - 1024, 2048 * MK_S5SKIP, 1024, scr, lane);
        cv_range<false>(a, 2048 * MK_S5SKIP + gw, n_cv, NGW, scr, lane);
    } else cv_range<false>(a, gw, n_cv, NGW, scr, lane);
    for (int it = gw + ((n_cv - gw + NGW - 1) / NGW) * NGW; it < NITEMS; it += NGW) {
        int r = it - n_cv;
        if (r < 4 * I_PPJ) { const int m = r / I_PPJ;
            tr_job(a.in[7] + (size_t)m * PLE * DM, DM, PLE, DM, (bf16*)(ws + WS_WPP) + (size_t)m * DM * PLE, nullptr, 0, r % I_PPJ, scr, lane); continue; } r -= 4 * I_PPJ;
        if (r < I_X) {
            const f32x4* xr = (const f32x4*)(x + (size_t)r * DM) + lane; f32x4 v[8]; float s = 0.f;
#pragma unroll
            for (int j = 0; j < 8; ++j) { v[j] = xr[64 * j]; s += (v[j][0] * v[j][0] + v[j][1] * v[j][1]) + (v[j][2] * v[j][2] + v[j][3] * v[j][3]); }
            s = wave_sum(s);
            v2u* o = (v2u*)((bf16*)(ws + WS_HB) + (size_t)r * DM) + lane;
#pragma unroll
            for (int j = 0; j < 8; ++j) { v2u w; w.x = pk2(v[j][0], v[j][1]); w.y = pk2(v[j][2], v[j][3]); o[64 * j] = w; }
            if (lane < 4) ((f32x4*)((float*)(ws + WS_SSQ) + (size_t)r * 16))[lane] = (f32x4){lane == 0 ? s : 0.f, 0.f, 0.f, 0.f};
            continue; } r -= I_X;
        {
            const f32x4* src = (const f32x4*)(p + (size_t)r * 512) + 2 * lane; const f32x4 v0 = src[0], v1 = src[1];
            v4u w; w.x = pk2(v0[0], v0[1]); w.y = pk2(v0[2], v0[3]); w.z = pk2(v1[0], v1[1]); w.w = pk2(v1[2], v1[3]);
            ((v4u*)((bf16*)(ws + WS_PBF) + (size_t)r * 512))[lane] = w; }
    }
}

__device__ __forceinline__ void fox_gate_phase(const bf16* Hb, const bf16* WfB, const float* bfv, const float* ssq, int np, float* logf, LAS unsigned char* lds, int lane, int wave, int bx, int G) {
    typedef short bf16x8_t __attribute__((ext_vector_type(8)));
    asm volatile("" : "+s"(bx), "+s"(wave));
    const int kq = wave & 3, kg = lane >> 4;
    LAS f32x4* pl = (LAS f32x4*)lds + (wave & 4) * 64 + lane;
    for (int t = (G == 256) ? 0 : bx; t < ((G == 256) ? 1 : M / 32); t += G) {
        const int rb = (G == 256) ? (4 * (bx & 7) + ((bx >> 3) & 3)) * 16 + 2 * (bx >> 5) + (wave >> 2) : 2 * t + (wave >> 2);
        const int row = rb * 16 + (lane & 15);
        const v4u* ap = (const v4u*)(Hb + (size_t)row * DM + kq * 512 + kg * 8); const v4u* bh = (const v4u*)(WfB + (size_t)(lane & 15) * DM + kq * 512 + kg * 8); const v4u* bl = bh + 16 * DM / 8;
        f32x4 acc = (f32x4){0.f, 0.f, 0.f, 0.f};
#pragma unroll 8
        for (int s = 0; s < 16; ++s) { const v4u a = ap[4 * s], h = bh[4 * s], l = bl[4 * s];
            acc = __builtin_amdgcn_mfma_f32_16x16x32_bf16(__builtin_bit_cast(bf16x8_t, h), __builtin_bit_cast(bf16x8_t, a), acc, 0, 0, 0);
            acc = __builtin_amdgcn_mfma_f32_16x16x32_bf16(__builtin_bit_cast(bf16x8_t, l), __builtin_bit_cast(bf16x8_t, a), acc, 0, 0, 0); }
        pl[kq * 64] = acc;
        __syncthreads();
        if (kq == 0) {
            acc = (pl[0] + pl[64]) + (pl[128] + pl[192]);
            const f32x4* sp = (const f32x4*)(ssq + (size_t)row * 16); f32x4 s4 = sp[0] + sp[1]; if (np > 8) s4 += sp[2] + sp[3];
            const float rstd = 1.0f / sqrtf(((s4[0] + s4[1]) + (s4[2] + s4[3])) * (1.0f / DM) + 1e-6f);
            const int b = row >> 11, tt = row & 2047;
#pragma unroll
            for (int i = 0; i < 4; ++i) { const int hd = 4 * kg + i; const float xg = acc[i] * rstd + bfv[hd];
                st_wt4(logf + (size_t)(b * 16 + hd) * SEQ + tt, __float_as_uint(fminf(xg, 0.f) - __logf(1.0f + __expf(-fabsf(xg)))));
            }
        }
        __syncthreads();
    }
}
__device__ __forceinline__ void moba_kmean_phase(const bf16* Kh, float* km, int lane, int gw, int NGW) {
    for (int task = gw; task < 2048; task += NGW) {
        const int rg = lane >> 4, ch = lane & 15; const bf16* base = Kh + ((size_t)task * 64 + rg) * HD + ch * 8; float s[8] = {0.f, 0.f, 0.f, 0.f, 0.f, 0.f, 0.f, 0.f};
        v4u w[16];
#pragma unroll
        for (int i = 0; i < 16; ++i) w[i] = *(const v4u*)(base + (size_t)i * 4 * HD);
#pragma unroll
        for (int i = 0; i < 16; ++i) {
            s[0] += __uint_as_float(w[i].x << 16); s[1] += __uint_as_float(w[i].x & 0xffff0000u); s[2] += __uint_as_float(w[i].y << 16); s[3] += __uint_as_float(w[i].y & 0xffff0000u);
            s[4] += __uint_as_float(w[i].z << 16); s[5] += __uint_as_float(w[i].z & 0xffff0000u); s[6] += __uint_as_float(w[i].w << 16); s[7] += __uint_as_float(w[i].w & 0xffff0000u); }
#pragma unroll
        for (int e = 0; e < 8; ++e) { s[e] += __shfl_xor(s[e], 16); s[e] += __shfl_xor(s[e], 32); }
        if (rg == 0) { float* o = km + (size_t)task * HD + ch * 8;
            st_wt16(o, __builtin_bit_cast(v4u, (f32x4){s[0], s[1], s[2], s[3]} * (1.f / 256.f))); st_wt16(o + 4, __builtin_bit_cast(v4u, (f32x4){s[4], s[5], s[6], s[7]} * (1.f / 256.f))); }
    }
}
__device__ __forceinline__ void moba_select_phase(const bf16* Qh, const float* km, unsigned* sel, LAS unsigned char* lds, int lane, int wave, int gw, int NGW) {
    LAS float* kl = (LAS float*)(lds + wave * 4096);
    for (int task = gw; task < 64 * 32; task += NGW) {
        const int bh = task >> 5, t0 = (task & 31) * 64, own = t0 >> 8;
        const bf16* qrow = Qh + ((size_t)bh * SEQ + t0 + lane) * HD; const float* kmb = km + (size_t)bh * 8 * 4 * HD;
#pragma unroll
        for (int n = 0; n < 7; ++n) if (n < own) { const float* kq = kmb + (size_t)n * 4 * HD + 2 * lane;
            *(LAS f32x2*)(kl + n * HD + 2 * lane) = (*(const f32x2*)kq + *(const f32x2*)(kq + HD)) + (*(const f32x2*)(kq + 2 * HD) + *(const f32x2*)(kq + 3 * HD)); }
        LDS_WAIT(); asm volatile("" ::: "memory");
        float gt[8];
#pragma unroll
        for (int n = 0; n < 8; ++n) gt[n] = 0.f;
#pragma unroll 2
        for (int c = 0; c < 16; ++c) { const v4u w = *(const v4u*)(qrow + c * 8); float q[8];
            q[0] = __uint_as_float(w.x << 16); q[1] = __uint_as_float(w.x & 0xffff0000u); q[2] = __uint_as_float(w.y << 16); q[3] = __uint_as_float(w.y & 0xffff0000u);
            q[4] = __uint_as_float(w.z << 16); q[5] = __uint_as_float(w.z & 0xffff0000u); q[6] = __uint_as_float(w.w << 16); q[7] = __uint_as_float(w.w & 0xffff0000u);
#pragma unroll
            for (int n = 0; n < 7; ++n) if (n < own) { const f32x4 k0 = *(const LAS f32x4*)(kl + n * HD + c * 8), k1 = *(const LAS f32x4*)(kl + n * HD + c * 8 + 4);
#pragma unroll
                for (int j = 0; j < 4; ++j) { gt[n] = fmaf(q[j], k0[j], gt[n]); gt[n] = fmaf(q[4 + j], k1[j], gt[n]); } } }
        unsigned m = 0u;
#pragma unroll
        for (int r = 0; r < 3; ++r) { int best = -1; float bv = -__builtin_inff();
#pragma unroll
            for (int n = 0; n < 7; ++n) if (n < own && !((m >> n) & 1u) && gt[n] > bv) { bv = gt[n]; best = n; }
            if (best >= 0) m |= 1u << best; }
        st_wt4(sel + (size_t)bh * SEQ + t0 + lane, m);
        LDS_WAIT(); asm volatile("" ::: "memory");
    }
}
__device__ __forceinline__ void s5_scan_phase(const Args& a, int lane, int task0, int tstep) {
    const float* a_re = a.in[14]; const float* a_im = a.in[15]; const float* log_dt = a.in[16];
    const float* Hl = (const float*)(a.ws + WS_HLOC); bf16* UH = (bf16*)(a.ws + WS_UH);
    for (int task = task0; task < 512; task += tstep) {
        const int g = task >> 2, b = task & 3, p = lane; const float dt = expf(log_dt[g]);
        const float mag = expf(a_re[g * 64 + p] * dt * 32.f); float sn, cs; sincosf(a_im[g * 64 + p] * dt * 32.f, &sn, &cs); const float ar = mag * cs, ai = mag * sn;
        float hr = 0.f, hi = 0.f;
#pragma unroll 8
        for (int k = 0; k < 64; ++k) { const size_t row = (size_t)g * 256 + b * 64 + k;
            *(unsigned*)(UH + row * 640 + 512 + 2 * p) = pk2(hr, hi);
            const f32x2 hl = *(const f32x2*)(Hl + row * 128 + 2 * p);
            const float nr = ar * hr - ai * hi + hl[0], ni = ar * hi + ai * hr + hl[1]; hr = nr; hi = ni; }
    }
}
__device__ __forceinline__ void final_norm_phase(const bf16* Hb, const float* ssq, const float* fg, float* out, int lane, int r0, int rend, int rstep) {
    for (int r = r0; r < rend; r += rstep) {
        const f32x4* sp = (const f32x4*)(ssq + (size_t)r * 16); const f32x4 s4 = sp[0] + sp[1];
        const float rstd = 1.0f / sqrtf(((s4[0] + s4[1]) + (s4[2] + s4[3])) * (1.0f / DM) + 1e-6f);
        const v4u* xr = (const v4u*)(Hb + (size_t)r * DM) + lane; const f32x4* gr = (const f32x4*)fg + 2 * lane; f32x4* o = (f32x4*)(out + (size_t)r * DM) + 2 * lane;
#pragma unroll
        for (int j = 0; j < 4; ++j) { const v4u w = xr[64 * j]; const f32x4 g0 = gr[128 * j], g1 = gr[128 * j + 1];
            f32x4 a, b; a[0] = __uint_as_float(w.x << 16); a[1] = __uint_as_float(w.x & 0xffff0000u); a[2] = __uint_as_float(w.y << 16); a[3] = __uint_as_float(w.y & 0xffff0000u);
            b[0] = __uint_as_float(w.z << 16); b[1] = __uint_as_float(w.z & 0xffff0000u); b[2] = __uint_as_float(w.w << 16); b[3] = __uint_as_float(w.w & 0xffff0000u);
            o[128 * j] = a * g0 * rstd; o[128 * j + 1] = b * g1 * rstd; }
    }
}
__device__ __forceinline__ int tail_a_rt(int k) {
    switch (k) { case 0: return cv::tail_a(0); case 1: return cv::tail_a(1); case 2: return cv::tail_a(2); case 3: return cv::tail_a(3); case 4: return cv::tail_a(4); case 5: return cv::tail_a(5);
                 case 6: return cv::tail_a(6); default: return cv::tail_a(7); }
}
__global__ void __launch_bounds__(NWAVES * 64, 2) mk_fwd(Args args) {
    extern __shared__ __attribute__((aligned(16))) unsigned char lds[];
    LAS unsigned char* L = (LAS unsigned char*)lds;
    volatile LAS unsigned* MISC = (volatile LAS unsigned*)(L + MISC_OFF);
    const int wave = __builtin_amdgcn_readfirstlane((int)threadIdx.x >> 6);
    const int tid = MK_TID();
#define TIDL() ({ int t_ = MK_TID(); asm volatile("" : "+v"(t_)); t_; })
    const int G = gridDim.x; const int bx = blockIdx.x; const int vcu = (G % 8 == 0) ? (bx % 8) * (G / 8) + bx / 8 : bx;
    const int gw = vcu * NWAVES + wave, NGW = G * NWAVES;
    unsigned char* ws = args.ws;
    unsigned* ctl = (unsigned*)(ws + WS_CTL);
    for (int u = tid; u < (LDS_BYTES - LDSCTL_OFF) / 4; u += NWAVES * 64) ((LAS unsigned*)(L + LDSCTL_OFF))[u] = 0u;
    __syncthreads();
    const int lo = args.ph_lo, hi = args.ph_hi;
    const bool single = (hi - lo) > 1;
    XcdBarrier bar; bar.bar = ctl + CW_BAR; bar.x = 0; bar.st = nullptr;
    if (single) bar = xcd_barrier_post(ctl + CW_BAR, MISC + 8, wave);
    int pc = 0;
#ifndef MK_SITES
#define MK_SITES 0xffffffu
#endif
#define SITE(n) (((MK_SITES >> (n)) & 1u) != 0u)
#define RUN() (pc >= lo && pc < hi)
#ifndef MK_REP_SITE
#define MK_REP_SITE -1
#endif
#ifndef MK_REP_N
#define MK_REP_N 1
#endif
#define REP(n) for (int rep_ = 0; rep_ < ((n) == MK_REP_SITE ? MK_REP_N : 1); ++rep_)
#ifndef MK_PANEL
#define MK_PANEL 1
#endif
    const bool pan = MK_PANEL && single && (G == 256);
    unsigned* const pcw = ctl + 1024 + 64 * (4 * (bx & 7) + ((bx >> 3) & 3));
    unsigned pdone = 0u; bool pw = false;
#define PCNT() ((pan && rep_ == 0) ? pcw : (unsigned*)nullptr)
#define PSEAM() do { if (pan) { pw = true; ++pc; } else SEAM(); } while (0)
#ifdef MK_BROKEN_NOWAIT
#define PWAIT() do { pw = false; } while (0)
#else
#define PWAIT() do { if (pw) { panel_wait(pcw, 8u * pdone, ctl + CW_BAR, wave); pw = false; } } while (0)
#endif
#ifdef MK_DBLBAR
#define SEAM() do { if (pc >= lo && pc + 1 < hi) { xcd_barrier(bar, wave); xcd_barrier(bar, wave); } ++pc; } while (0)
#else
#define SEAM() do { if (pc >= lo && pc + 1 < hi) xcd_barrier(bar, wave); ++pc; } while (0)
#endif
    unsigned* const bcw = ctl + CW_BATCH + 64 * ((bx & 7) >> 1);
    unsigned bdone = 0u;
    const int blw = (bx & 1) * 32 + (bx >> 3);
#ifndef MK_BATCH
#define MK_BATCH 1
#endif
    const bool bat = MK_BATCH && pan;
#ifndef MK_S5CNT
#define MK_S5CNT 0
#endif
    const bool s5c = MK_S5CNT && bat;
#define BCNT() ((bat && rep_ == 0) ? bcw : (unsigned*)nullptr)
#define BARRIVE() do { if (bat) cnt_arrive(bcw, TIDL() & 63, wave); } while (0)
#define BSEAM() do { if (bat) { ++bdone; panel_wait(bcw, 64u * bdone, ctl + CW_BAR, wave); ++pc; } else SEAM(); } while (0)
    const bool tails = (G == 256); int tw = 0, npos = 0;
#ifdef MK_TWGRID
#define TWAIT(n) do { npos += (n); if (tails) while (tw < 8 && tail_a_rt(tw) < npos) { xcd_barrier(bar, wave); ++tw; } } while (0)
#else
#define TWAIT(n) do { npos += (n); if (tails) while (tw < 8 && tail_a_rt(tw) < npos) { panel_wait(ctl + CW_TAIL + 32 * tw, 128u, ctl + CW_BAR, wave); ++tw; } } while (0)
#endif
#define ACT ((bf16*)(ws + WS_ACT))
#define QKV ((bf16*)(ws + WS_QKV))
#define OB ((bf16*)(ws + WS_OB))
#define PP ((bf16*)(ws + WS_PP))
#define LOGF ((float*)(ws + WS_LOGF))
#define KMEAN ((float*)(ws + WS_KMEAN))
#define UH ((bf16*)(ws + WS_UH))
#define HLOC ((float*)(ws + WS_HLOC))
#define YB ((bf16*)(ws + WS_YB))

    if (SITE(0) && RUN()) REP(0) { const int t = TIDL(); p0_prologue(args, L, t, t & 63, wave, vcu, G); }
    SEAM();
    if (SITE(1) && RUN()) REP(1) { pg8::Gemm g{(const bf16*)(ws + WS_PBF), (const bf16*)(ws + WS_WPP), PLE, PLE, PLE}; pg8::PpOrder S; S.init(G, bx);
        pg8::EpiBf16 E{PP, DM, nullptr, 0}; pg8::gemm_phase(L + RING_OFF, g, S, E, wave, (pan && rep_ == 0) ? ctl + CW_PP : (unsigned*)nullptr); }
    int np = 8, sel = 0;
#define HBR ((const bf16*)(ws + (sel ? WS_HB2 : WS_HB)))
#define HBW ((bf16*)(ws + (sel ? WS_HB : WS_HB2)))
#define SSQR ((const float*)(ws + WS_SSQ) + (sel ? M * 16 : 0))
#define SSQW ((float*)(ws + WS_SSQ) + (sel ? 0 : M * 16))
    for (int layer = 0; layer < DEPTH; ++layer) {
        const int kind = layer % 3;
        for (int half = 0; half < 2; ++half) {
#if defined(MK_EXP) && (MK_EXP == 1 || MK_EXP == 2 || MK_EXP == 3 || MK_EXP == 5 || MK_EXP == 6 || MK_EXP == 8 || MK_EXP == 9)
            if (RUN()) { pg8::Gemm g{HBR, (const bf16*)(ws + WS_WFI) + (size_t)(layer * 2 + half) * 2 * FF * DM, DM, DM, DM}; pg8::StaticOrder S; S.init(M, 2 * FF, G, bx);
#if MK_EXP == 2 || MK_EXP == 5 || MK_EXP == 6 || MK_EXP == 8 || MK_EXP == 9
                S.lim = 1280;
#endif
#if MK_EXP == 5
                S.pbmask = 3;
#endif
                pg8::EpiNone E{(float*)(ws + WS_CTL), (int)(lo > 1000000)};
#if MK_EXP == 3
                S.lim = 1280; pg8::gemm_phase<pg8::EpiNone, pg8::StaticOrder, true>(L + RING_OFF, g, S, E, wave); }
#elif MK_EXP == 8 || MK_EXP == 9
                { pg8::EpiStoreOnly E2{(bf16*)(ws + WS_H)}; pg8::gemm_phase(L + RING_OFF, g, S, E2, wave); } }
#elif MK_EXP == 6
                pg8::gemm_phase<pg8::EpiNone, pg8::StaticOrder, false, true>(L + RING_OFF, g, S, E, wave); __syncthreads(); }
#else
                pg8::gemm_phase(L + RING_OFF, g, S, E, wave); }
#endif
#endif
#if defined(MK_CLKPROBE)
            unsigned long long c0_ = clock64(), r0_ = __builtin_amdgcn_s_memrealtime();
#endif
            if (SITE(2) && RUN()) REP(2) {
#ifdef MK_CVFIRST
                if (rep_ == 0) cv_tail(args, layer * 2 + half, L, TIDL() & 63, wave, bx, G);
#endif
                pg8::Gemm g{HBR, (const bf16*)(ws + WS_WFI) + (size_t)(layer * 2 + half) * 2 * FF * DM, DM, DM, DM}; pg8::StaticOrder S; S.init(M, 2 * FF, G, bx);
                pg8::EpiSwiglu E{ACT, FF, SSQR, np}; PWAIT(); if (rep_ == 0) TWAIT(cv::I_FI); pg8::gemm_phase(L + RING_OFF, g, S, E, wave, PCNT());
#ifndef MK_CVFIRST
                if (rep_ == 0) cv_tail(args, layer * 2 + half, L, TIDL() & 63, wave, bx, G);
#endif
                }
#if defined(MK_CLKPROBE)
            if (layer == 1 && half == 1 && bx == 0 && MK_TID() == 0) { const unsigned long long c1_ = clock64(), r1_ = __builtin_amdgcn_s_memrealtime();
                ((float*)(ws + WS_CTL))[1024] = floorf((float)(c1_ - c0_) / (float)(r1_ - r0_) * 0.1f * MK_CLKPROBE); }
#endif
            ++pdone; PSEAM();
            if (SITE(3) && RUN()) REP(3) { pg8::Gemm g{ACT, (const bf16*)(ws + WS_WFO) + (size_t)(layer * 2 + half) * DM * FF, FF, FF, FF}; pg8::StaticOrder S; S.init(M, DM, G, bx);
                pg8::EpiRes<0> E{HBR, (layer == 0 && half == 0) ? args.in[0] : nullptr, HBW, SSQW, 0.5f, nullptr, 0, nullptr, false}; PWAIT(); if (rep_ == 0) TWAIT(cv::I_FO); pg8::gemm_phase(L + RING_OFF, g, S, E, wave, PCNT()); }
            ++pdone; PSEAM();
            np = 8; sel ^= 1;
            if (half == 0) {
                if (kind < 2) {
                    const int wslot = layer == 0 ? 0 : (layer == 1 ? 1 : 2);
                    if (RUN()) {
                        if (SITE(4) && kind == 0) REP(4) { PWAIT(); if (rep_ == 0) TWAIT(cv::I_WF); fox_gate_phase(HBR, (const bf16*)(ws + WS_WFT) + (size_t)(layer / 3) * 2 * 16 * DM, args.in[9] + (layer / 3) * 16, SSQR, np, LOGF, L, TIDL() & 63, wave, bx, G); }
                        if (SITE(5)) REP(5) { pg8::Gemm g{HBR, (const bf16*)(ws + WS_WQKV) + (size_t)wslot * 3 * DM * DM, DM, DM, DM}; pg8::StaticOrder S; S.init(M, 3 * DM, G, bx);
                        pg8::EpiQkv E{QKV, SSQR, np}; PWAIT(); if (rep_ == 0) TWAIT(cv::I_QKV); pg8::gemm_phase(L + RING_OFF, g, S, E, wave, BCNT()); } }
                    BSEAM();
                    if (kind == 1) {
                        if (SITE(6) && RUN()) REP(6) { if (bat) moba_kmean_phase(QKV + (size_t)M * DM, KMEAN, TIDL() & 63, 512 * ((bx & 7) >> 1) + blw * NWAVES + wave, 1 << 20);
                                                       else { moba_kmean_phase(QKV + (size_t)M * DM, KMEAN, TIDL() & 63, gw, NGW); } }
                        BARRIVE(); BSEAM();
                        if (SITE(6) && RUN()) REP(6) { if (bat) moba_select_phase(QKV, KMEAN, (unsigned*)(ws + WS_SEL), L, TIDL() & 63, wave, 512 * ((bx & 7) >> 1) + blw * NWAVES + wave, 1 << 20);
                                                       else moba_select_phase(QKV, KMEAN, (unsigned*)(ws + WS_SEL), L, TIDL() & 63, wave, gw, NGW); }
                        BARRIVE(); BSEAM(); }
                    if (RUN()) {
#if defined(MK_EXP) && MK_EXP == 4
                        if (kind == 0) att::attn_phase<false, true>((char*)lds + RING_OFF, QKV, QKV + (size_t)M * DM, QKV + (size_t)2 * M * DM, OB, (const float*)(ws + WS_BIAS), nullptr, wave);
#endif
                        if (kind == 0) { if (SITE(7)) REP(7) att::attn_phase<false>((char*)lds + RING_OFF, QKV, QKV + (size_t)M * DM, QKV + (size_t)2 * M * DM, OB, LOGF, nullptr, wave); }
                        else if (SITE(8)) REP(8) att::attn_phase<true>((char*)lds + RING_OFF, QKV, QKV + (size_t)M * DM, QKV + (size_t)2 * M * DM, OB, (const float*)(ws + WS_BIAS), (const unsigned*)(ws + WS_SEL), wave); }
                    BARRIVE(); BSEAM();
                    if (SITE(9) && RUN()) REP(9) { pg8::Gemm g{OB, (const bf16*)(ws + WS_WO) + (size_t)wslot * DM * DM, DM, DM, DM}; pg8::StaticOrder S; S.init(M, DM, G, bx);
                        pg8::EpiRes<0> E{HBR, nullptr, HBW, SSQW, 1.0f, nullptr, 0, nullptr, false}; if (rep_ == 0) TWAIT(cv::I_WO); pg8::gemm_phase(L + RING_OFF, g, S, E, wave, PCNT()); }
                    ++pdone; PSEAM(); sel ^= 1;
                } else {
                    if (SITE(10) && RUN()) REP(10) { pg8::Gemm g{HBR, (const bf16*)(ws + WS_WS5I), DM, DM, DM}; pg8::StaticOrder S; S.init(M, DM, G, bx);
                        pg8::EpiS5U E{UH, SSQR, np}; PWAIT(); if (rep_ == 0) TWAIT(cv::I_S5I); pg8::gemm_phase(L + RING_OFF, g, S, E, wave, s5c ? ((rep_ == 0) ? ctl + CW_S5U + 16 * (bx >> 5) : (unsigned*)nullptr) : PCNT()); }
                    if (s5c) {
                        ++pc;
                        if (bx < 128) {
                            panel_wait(ctl + CW_S5U + 16 * (bx >> 4), 32u, ctl + CW_BAR, wave);
                            if (SITE(11) && RUN()) { pg8::Gemm g{UH, (const bf16*)(ws + WS_S5W), 640, 512, 512}; pg8::BatchOrder<1> S; S.init(G, bx);
                                pg8::EpiS5H E{HLOC}; pg8::gemm_phase(L + RING_OFF, g, S, E, wave); }
                            if (SITE(12) && RUN()) s5_scan_phase(args, TIDL() & 63, wave < 4 ? bx * 4 + wave : 512, 512);
                            cnt_arrive(ctl + CW_S5G + bx, TIDL() & 63, wave);
                        }
                        pc += 2;
                        panel_wait(ctl + CW_S5G + (bx >> 1), 1u, ctl + CW_BAR, wave);
                    } else {
                        ++pdone; SEAM();
                        if (SITE(11) && RUN()) REP(11) { pg8::Gemm g{UH, (const bf16*)(ws + WS_S5W), 640, 512, 512}; pg8::BatchOrder<1> S; S.init(G, bx);
                            pg8::EpiS5H E{HLOC}; pg8::gemm_phase(L + RING_OFF, g, S, E, wave); }
                        SEAM();
                        if (SITE(12) && RUN()) REP(12) s5_scan_phase(args, TIDL() & 63, wave * G + vcu, NWAVES * G);
                        SEAM();
                    }
                    if (SITE(13) && RUN()) REP(13) { pg8::Gemm g{UH, (const bf16*)(ws + WS_S5TV), 640, 640, 640}; pg8::BatchOrder<2> S; S.init(G, bx);
                        pg8::EpiS5Y E{YB}; pg8::gemm_phase(L + RING_OFF, g, S, E, wave); }
                    SEAM();
                    if (SITE(14) && RUN()) REP(14) { pg8::Gemm g{YB, (const bf16*)(ws + WS_WGLU), DM, DM, DM}; pg8::StaticOrder S; S.init(M, 2 * DM, G, bx);
                        pg8::EpiRes<2> E{HBR, nullptr, HBW, SSQW, 1.0f, nullptr, 0, nullptr, false}; if (rep_ == 0) TWAIT(cv::I_GLU); pg8::gemm_phase(L + RING_OFF, g, S, E, wave, PCNT()); }
                    ++pdone; PSEAM(); np = 16; sel ^= 1;
                }
            } else {
                if (SITE(15) && RUN()) REP(15) { pg8::Gemm g{HBR, (const bf16*)(ws + WS_WPG) + (size_t)layer * DM * DM, DM, DM, DM}; pg8::StaticOrder S; S.init(M, DM, G, bx);
                    pg8::EpiRes<1> E{HBR, nullptr, HBW, SSQW, 1.0f, SSQR, np, PP + (size_t)layer * M * DM, false}; PWAIT(); if (rep_ == 0) TWAIT(cv::I_PG);
                    if (pan && layer == 0 && rep_ == 0) panel_wait(ctl + CW_PP, 256u, ctl + CW_BAR, wave);
                    pg8::gemm_phase(L + RING_OFF, g, S, E, wave, PCNT()); }
                ++pdone; PSEAM(); sel ^= 1;
            }
        }
    }
#if defined(MK_CLKPROBE)
    { xcd_barrier(bar, wave); const float cv_ = __hip_atomic_load((float*)(ws + WS_CTL) + 1024, __ATOMIC_RELAXED, __HIP_MEMORY_SCOPE_AGENT);
      for (size_t i = (size_t)bx * 512 + MK_TID(); i < (size_t)M * DM; i += (size_t)G * 512) args.out[i] = cv_; return; }
#endif
    if (SITE(16) && RUN()) REP(16) { PWAIT();
        const int r0 = pan ? (4 * (bx & 7) + ((bx >> 3) & 3)) * 256 + 32 * (bx >> 5) + 4 * wave : gw;
        final_norm_phase(HBR, SSQR, args.in[3], args.out, TIDL() & 63, r0, pan ? r0 + 4 : M, pan ? 1 : NGW); }
#undef RUN
#undef SEAM
}
constexpr int N_PHASES = 1 + 4 * 5 + (4 + 5 + 4 + 5) + 1;

#ifndef MK_PER_PHASE
#define MK_PER_PHASE 0
#endif
static void mk_launch(void* const* d_in, float* d_out, void* d_ws, hipStream_t stream) {
    static int grid = 0;
    if (grid == 0) {
        int dev = 0, cus = 0, per_cu = 0;
        if (hipGetDevice(&dev) != hipSuccess || hipDeviceGetAttribute(&cus, hipDeviceAttributeMultiprocessorCount, dev) != hipSuccess) { fprintf(stderr, "mk_launch: device query failed\n"); grid = -1; return; }
        if (hipFuncSetAttribute((const void*)mk_fwd, hipFuncAttributeMaxDynamicSharedMemorySize, LDS_BYTES) != hipSuccess) { fprintf(stderr, "mk_launch: hipFuncSetAttribute failed\n"); grid = -1; return; }
        if (hipOccupancyMaxActiveBlocksPerMultiprocessor(&per_cu, (const void*)mk_fwd, NWAVES * 64, LDS_BYTES) != hipSuccess || per_cu < 1) fprintf(stderr, "mk_launch: occupancy query reports %d\n", per_cu);
        (void)hipGetLastError();
        grid = cus;
    }
    if (grid < 0) return;
    if (hipMemsetAsync((char*)d_ws + WS_CTL, 0, CTL_ZERO_BYTES, stream) != hipSuccess) { fprintf(stderr, "mk_launch: memset failed\n"); return; }
    Args a{};
    for (int i = 0; i < 23; ++i) a.in[i] = (const float*)d_in[i];
    a.out = d_out; a.ws = (unsigned char*)d_ws;
#if MK_PER_PHASE
    for (int ph = 0; ph < N_PHASES; ++ph) { a.ph_lo = ph; a.ph_hi = ph + 1; hipLaunchKernelGGL(mk_fwd, dim3(grid), dim3(NWAVES * 64), LDS_BYTES, stream, a); }
#else
    a.ph_lo = 0; a.ph_hi = 1 << 20;
    hipLaunchKernelGGL(mk_fwd, dim3(grid), dim3(NWAVES * 64), LDS_BYTES, stream, a);
#endif
    const hipError_t le = hipPeekAtLastError();
    if (le != hipSuccess) fprintf(stderr, "mk_launch: launch failed: %s\n", hipGetErrorName(le));
}

extern "C" void kernel_launch(void* const* d_in, const int* in_sizes, int n_in, void* d_out, int out_size, void* d_ws, size_t ws_size, hipStream_t stream) {
    if (n_in != 23 || out_size != M * DM || in_sizes[0] != M * DM || ws_size < WS_END) { fprintf(stderr, "kernel_launch: unexpected shapes n_in=%d out=%d ws=%zu\n", n_in, out_size, ws_size); return; }
    mk_launch(d_in, (float*)d_out, d_ws, stream);
}
```

```cpp
#define MK_CV18 1
#define MK_PROWT 1
#include <hip/hip_runtime.h>
#include <cstdio>
#include <cstdint>
#include <cmath>
#define MK_TID() ({ unsigned l_; asm volatile("v_mbcnt_lo_u32_b32 %0, -1, 0\n\tv_mbcnt_hi_u32_b32 %0, -1, %0" : "=v"(l_)); (int)(((unsigned)wave << 6) | l_); })
#define XB_TID ((unsigned)MK_TID())
namespace pg8 {
#define PG8_LAS __attribute__((address_space(3)))
typedef unsigned short bf16_t;
typedef short bf16x8 __attribute__((ext_vector_type(8)));
typedef float f32x4 __attribute__((ext_vector_type(4)));
typedef float f32x2 __attribute__((ext_vector_type(2)));
typedef unsigned u32x4 __attribute__((ext_vector_type(4)));
typedef unsigned u32x2 __attribute__((ext_vector_type(2)));
#ifndef MK_WGM
#define MK_WGM 4
#endif
constexpr int BM = 256, BK = 64, HALF = 128, HTB = HALF * BK * 2  , STAGE_BYTES = 8 * HTB, NXCD = 8, WGM = MK_WGM;
constexpr int EPI_LDS_OFF = STAGE_BYTES;
constexpr float RMS_EPS = 1e-6f;

__host__ __device__ __forceinline__ int lds_byte(int r, int c) { const int st = (r >> 4) * 2 + (c >> 5), rr = r & 15, cc = c & 31, ob = rr * 64 + cc * 2; return st * 1024 + (ob ^ (((ob >> 9) & 1) << 5)); }
__host__ __device__ __forceinline__ void stage_rc(int b, int& R, int& C) { const int st = b / 1024, sb = b % 1024, swz = sb ^ (((sb >> 9) & 1) << 5); R = (st >> 1) * 16 + swz / 64; C = (st & 1) * 32 + (swz % 64) / 2; }
__host__ __device__ __forceinline__ int perm32(int rho) { const int n = rho >> 4, i = rho & 15; return 8 * (i >> 2) + 4 * n + (i & 3); }

struct Unit { int pm, pn, pb; };
struct Gemm { const bf16_t* A; const bf16_t* Bt; int lda, ldb, K; };

struct StaticOrder {
    int nM, nN, nwg, G, c, lim, pbmask;
    __device__ void init(int M, int N, int G_, int c_) { asm volatile("" : "+s"(c_)); nM = M / BM; nN = N / BM; nwg = nM * nN; G = G_; c = c_; lim = nwg; pbmask = -1; }
    __device__ bool next(int i, Unit& u) const {
        const long L = (long)i * G + c; if (L >= lim) return false;
        int wgid = (int)L; { const int q = nwg / NXCD, r = nwg % NXCD, xcd = wgid % NXCD, off = wgid / NXCD; wgid = (xcd < r ? xcd * (q + 1) : r * (q + 1) + (xcd - r) * q) + off; }
        const int nig = WGM * nN, gid = wgid / nig, fm = gid * WGM, gsz = (nM - fm) < WGM ? (nM - fm) : WGM;
        u.pm = fm + ((wgid % nig) % gsz); u.pn = (wgid % nig) / gsz; u.pb = u.pn & pbmask; return true;
    }
};
struct PpOrder {
    StaticOrder s;
    __device__ void init(int G_, int c_) { s.init(4 * 8192, 2048, G_, c_); }
    __device__ bool next(int i, Unit& u) const { if (!s.next(i, u)) return false; u.pb = (u.pm >> 5) * 8 + u.pn; return true; }
};
template <int NT> struct BatchOrder {
    int G, c;
    __device__ void init(int G_, int c_) { G = G_; c = c_; }
    __device__ bool next(int i, Unit& u) const { const int L = i * G + c; if (L >= 128 * NT) return false; u.pm = L / NT; u.pn = L % NT; u.pb = L; return true; }
};

__device__ __forceinline__ unsigned cvt_pk_bf16(float lo, float hi) { unsigned r; asm volatile("v_cvt_pk_bf16_f32 %0, %1, %2" : "=v"(r) : "v"(lo), "v"(hi)); return r; }
__device__ __forceinline__ float fast_sigmoid(float x) { return __builtin_amdgcn_rcpf(1.0f + __builtin_amdgcn_exp2f(-1.4426950408889634f * x)); }
__device__ __forceinline__ float fast_silu(float x) { return x * fast_sigmoid(x); }
__device__ __forceinline__ float gelu_tanh(float v) {
    const float z = 0.7978845608028654f * (v + 0.044715f * v * v * v); return v * fast_sigmoid(2.0f * z);
}

#ifndef MK_WT
#define MK_WT 1
#endif
typedef __amdgpu_buffer_rsrc_t rsrc_t;
__device__ __forceinline__ rsrc_t out_rsrc(const void* base, unsigned nbytes) { return __builtin_amdgcn_make_buffer_rsrc((void*)base, 0, (int)nbytes, 0x00020000); }
__device__ __forceinline__ void st16(void* base, rsrc_t r, unsigned boff, u32x4 v) {
#if MK_WT
    (void)base; __builtin_amdgcn_raw_buffer_store_b128(v, r, boff, 0, 16);
#else
    (void)r; *(u32x4*)((char*)base + boff) = v;
#endif
}
typedef f32x4 Acc[2][2][4][2];

__device__ __forceinline__ void fill_rstd(const float* ssq, int np, int pm, PG8_LAS unsigned char* lds, int tid) {
    PG8_LAS float* R = (PG8_LAS float*)(lds + EPI_LDS_OFF + 4096);
#pragma unroll
    for (int h = 0; h < 2; ++h) { const int row = tid + 512 * h; const f32x4* sp = (const f32x4*)(ssq + ((size_t)(pm >> 2) * 4 * BM + row) * 16);
        f32x4 a = sp[0] + sp[1]; if (np > 8) a += sp[2] + sp[3];
        R[row] = __builtin_amdgcn_rsqf(((a[0] + a[1]) + (a[2] + a[3])) * (1.0f / 2048.0f) + RMS_EPS); }
    asm volatile("s_waitcnt lgkmcnt(0)" ::: "memory"); __builtin_amdgcn_s_barrier(); asm volatile("" ::: "memory");
}
__device__ __forceinline__ void row_rstd(int pm, int wr, int fr, float (&rs)[2][4], PG8_LAS unsigned char* lds) {
    const PG8_LAS float* R = (const PG8_LAS float*)(lds + EPI_LDS_OFF + 4096) + (pm & 3) * BM;
#pragma unroll
    for (int ai = 0; ai < 2; ++ai)
#pragma unroll
        for (int m = 0; m < 4; ++m) rs[ai][m] = R[ai * HALF + wr * 64 + m * 16 + fr];
}

struct EpiNone {
    static constexpr bool PRE = false; static constexpr bool RSTD = false; static constexpr bool PERM = true, BAR = false;
    float* sink; int never;
    __device__ __forceinline__ void operator()(const Acc& acc, const Unit& u, int wr, int wc, int fr, int fq, PG8_LAS unsigned char* lds, int tid) const {
        if (never) { f32x4 t = (f32x4){0.f, 0.f, 0.f, 0.f};
#pragma unroll
            for (int ai = 0; ai < 2; ++ai)
#pragma unroll
                for (int bj = 0; bj < 2; ++bj)
#pragma unroll
                    for (int m = 0; m < 4; ++m)
#pragma unroll
                        for (int n = 0; n < 2; ++n) t += acc[ai][bj][m][n];
            *(f32x4*)(sink + tid * 4) = t; }
    }
};
struct EpiStoreOnly {
    static constexpr bool PRE = false; static constexpr bool RSTD = false; static constexpr bool PERM = true, BAR = false;
    bf16_t* O;
    __device__ __forceinline__ void operator()(const Acc& acc, const Unit& u, int wr, int wc, int fr, int fq, PG8_LAS unsigned char* lds, int tid) const {
        const rsrc_t rs_o = out_rsrc(O, 8192u * 2048u * 4u);
#pragma unroll
        for (int ai = 0; ai < 2; ++ai)
#pragma unroll
            for (int m = 0; m < 4; ++m)
#pragma unroll
                for (int bj = 0; bj < 2; ++bj) { const f32x4 v0 = acc[ai][bj][m][0], v1 = acc[ai][bj][m][1];
                    u32x4 w; w.x = __float_as_uint(v0[0]) ^ __float_as_uint(v1[0]); w.y = __float_as_uint(v0[1]) ^ __float_as_uint(v1[1]); w.z = __float_as_uint(v0[2]) ^ __float_as_uint(v1[2]); w.w = __float_as_uint(v0[3]) ^ __float_as_uint(v1[3]);
                    st16(O, rs_o, (unsigned)((((size_t)((u.pm & 7) * BM + ai * HALF + wr * 64 + m * 16 + fr)) * 2048 + (u.pn & 7) * BM + bj * HALF + wc * 32 + 8 * fq) * 2), w); }
#if defined(MK_EXP) && MK_EXP == 9
        asm volatile("s_waitcnt vmcnt(0)" ::: "memory");
#endif
    }
};
struct EpiSwiglu {
    static constexpr bool PRE = false; static constexpr bool RSTD = true; static constexpr bool PERM = true, BAR = false;
    bf16_t* O; int ldo; const float* ssq; int np;
    __device__ __forceinline__ void operator()(const Acc& acc, const Unit& u, int wr, int wc, int fr, int fq, PG8_LAS unsigned char* lds, int tid) const {
        float rs[2][4]; row_rstd(u.pm, wr, fr, rs, lds);
        const rsrc_t rs_o = out_rsrc(O, 8192u * 5632u * 2u);
        const int col0 = u.pn * HALF + wc * 32 + 8 * fq;
#pragma unroll
        for (int ai = 0; ai < 2; ++ai)
#pragma unroll
            for (int m = 0; m < 4; ++m) { const float s = rs[ai][m]; float o[8];
#pragma unroll
                for (int n = 0; n < 2; ++n)
#pragma unroll
                    for (int i = 0; i < 4; ++i) o[n * 4 + i] = fast_silu(acc[ai][0][m][n][i] * s) * (acc[ai][1][m][n][i] * s);
                u32x4 w; w.x = cvt_pk_bf16(o[0], o[1]); w.y = cvt_pk_bf16(o[2], o[3]); w.z = cvt_pk_bf16(o[4], o[5]); w.w = cvt_pk_bf16(o[6], o[7]);
                st16(O, rs_o, (unsigned)(((size_t)(u.pm * BM + ai * HALF + wr * 64 + m * 16 + fr) * ldo + col0) * 2), w); }
    }
};
struct EpiBf16 {
    static constexpr bool PRE = false; static constexpr bool RSTD = true; static constexpr bool PERM = true, BAR = false;
    bf16_t* O; int ldo; const float* ssq; int np;
    __device__ __forceinline__ void operator()(const Acc& acc, const Unit& u, int wr, int wc, int fr, int fq, PG8_LAS unsigned char* lds, int tid) const {
        float rs[2][4];
        if (ssq) row_rstd(u.pm, wr, fr, rs, lds); else {
#pragma unroll
            for (int a = 0; a < 2; ++a)
#pragma unroll
                for (int m = 0; m < 4; ++m) rs[a][m] = 1.f; }
        const rsrc_t rs_o = out_rsrc(O, 32768u * 2048u * 2u);
        const int col0 = u.pn * BM + wc * 32 + 8 * fq;
#pragma unroll
        for (int ai = 0; ai < 2; ++ai)
#pragma unroll
            for (int m = 0; m < 4; ++m) { const float s = rs[ai][m];
#pragma unroll
                for (int bj = 0; bj < 2; ++bj) { const f32x4 v0 = acc[ai][bj][m][0] * s, v1 = acc[ai][bj][m][1] * s;
                    u32x4 w; w.x = cvt_pk_bf16(v0[0], v0[1]); w.y = cvt_pk_bf16(v0[2], v0[3]); w.z = cvt_pk_bf16(v1[0], v1[1]); w.w = cvt_pk_bf16(v1[2], v1[3]);
                    st16(O, rs_o, (unsigned)(((size_t)(u.pm * BM + ai * HALF + wr * 64 + m * 16 + fr) * ldo + col0 + bj * HALF) * 2), w); } }
    }
};
struct EpiQkv {
    static constexpr bool PRE = false; static constexpr bool RSTD = true; static constexpr bool PERM = true, BAR = false;
    bf16_t* O; const float* ssq; int np;
    __device__ __forceinline__ void operator()(const Acc& acc, const Unit& u, int wr, int wc, int fr, int fq, PG8_LAS unsigned char* lds, int tid) const {
        float rs[2][4]; row_rstd(u.pm, wr, fr, rs, lds);
        const rsrc_t rs_o = out_rsrc(O, 3u * 8192u * 2048u * 2u);
        const int which = u.pn >> 3, hd0 = (u.pn & 7) * 2, d0 = wc * 32 + 8 * fq;
#pragma unroll
        for (int ai = 0; ai < 2; ++ai)
#pragma unroll
            for (int m = 0; m < 4; ++m) { const float s = rs[ai][m]; const int r = u.pm * BM + ai * HALF + wr * 64 + m * 16 + fr, b = r >> 11, t = r & 2047;
#pragma unroll
                for (int bj = 0; bj < 2; ++bj) { const f32x4 v0 = acc[ai][bj][m][0] * s, v1 = acc[ai][bj][m][1] * s;
                    u32x4 w; w.x = cvt_pk_bf16(v0[0], v0[1]); w.y = cvt_pk_bf16(v0[2], v0[3]); w.z = cvt_pk_bf16(v1[0], v1[1]); w.w = cvt_pk_bf16(v1[2], v1[3]);
                    st16(O, rs_o, (unsigned)(((size_t)which * (8192 * 2048) + ((size_t)((b * 16 + hd0 + bj) * 2048 + t)) * 128 + d0) * 2), w); } }
    }
};
struct EpiS5U {
    static constexpr bool PRE = false; static constexpr bool RSTD = true; static constexpr bool PERM = true, BAR = false;
    bf16_t* UH; const float* ssq; int np;
    __device__ __forceinline__ void operator()(const Acc& acc, const Unit& u, int wr, int wc, int fr, int fq, PG8_LAS unsigned char* lds, int tid) const {
        const rsrc_t rs_o = out_rsrc(UH, 128u * 256u * 640u * 2u); float rs[2][4]; row_rstd(u.pm, wr, fr, rs, lds);
#pragma unroll
        for (int ai = 0; ai < 2; ++ai)
#pragma unroll
            for (int m = 0; m < 4; ++m) { const float s = rs[ai][m]; const int r = u.pm * BM + ai * HALF + wr * 64 + m * 16 + fr;
#pragma unroll
                for (int bj = 0; bj < 2; ++bj) { const int cg = u.pn * BM + bj * HALF + wc * 32 + 8 * fq, g = cg >> 4, c0 = cg & 15;
                    const f32x4 v0 = acc[ai][bj][m][0] * s, v1 = acc[ai][bj][m][1] * s;
                    u32x4 w; w.x = cvt_pk_bf16(v0[0], v0[1]); w.y = cvt_pk_bf16(v0[2], v0[3]); w.z = cvt_pk_bf16(v1[0], v1[1]); w.w = cvt_pk_bf16(v1[2], v1[3]);
                    st16(UH, rs_o, (unsigned)((((size_t)g * 256 + (r >> 5)) * 640 + (r & 31) * 16 + c0) * 2), w); } }
    }
};
struct EpiS5H {
    static constexpr bool PRE = false; static constexpr bool RSTD = false; static constexpr bool PERM = false, BAR = false;
    float* Hl;
    __device__ __forceinline__ void operator()(const Acc& acc, const Unit& u, int wr, int wc, int fr, int fq, PG8_LAS unsigned char* lds, int tid) const {
        const rsrc_t rs_o = out_rsrc(Hl, 128u * 256u * 128u * 4u);
#pragma unroll
        for (int ai = 0; ai < 2; ++ai)
#pragma unroll
            for (int m = 0; m < 4; ++m) {
#pragma unroll
                for (int n = 0; n < 2; ++n) st16(Hl, rs_o, (unsigned)((((size_t)u.pm * 256 + ai * HALF + wr * 64 + m * 16 + fr) * 128 + wc * 32 + 4 * fq + n * 16) * 4), __builtin_bit_cast(u32x4, acc[ai][0][m][n])); }
    }
};
struct EpiS5Y {
    static constexpr bool PRE = false; static constexpr bool RSTD = false; static constexpr bool PERM = true, BAR = false;
    bf16_t* Y;
    __device__ __forceinline__ void operator()(const Acc& acc, const Unit& u, int wr, int wc, int fr, int fq, PG8_LAS unsigned char* lds, int tid) const {
        const rsrc_t rs_o = out_rsrc(Y, 8192u * 2048u * 2u);
#pragma unroll
        for (int ai = 0; ai < 2; ++ai)
#pragma unroll
            for (int m = 0; m < 4; ++m) { const int crow = ai * HALF + wr * 64 + m * 16 + fr;
#pragma unroll
                for (int bj = 0; bj < 2; ++bj) { const int col = u.pn * BM + bj * HALF + wc * 32 + 8 * fq, j = col >> 4, c0 = col & 15;
                    float o[8];
#pragma unroll
                    for (int n = 0; n < 2; ++n)
#pragma unroll
                        for (int i = 0; i < 4; ++i) o[n * 4 + i] = gelu_tanh(acc[ai][bj][m][n][i]);
                    u32x4 w; w.x = cvt_pk_bf16(o[0], o[1]); w.y = cvt_pk_bf16(o[2], o[3]); w.z = cvt_pk_bf16(o[4], o[5]); w.w = cvt_pk_bf16(o[6], o[7]);
                    st16(Y, rs_o, (unsigned)((((size_t)crow * 32 + j) * 2048 + u.pm * 16 + c0) * 2), w); } }
    }
};
template <int MODE> struct EpiRes {
    static constexpr bool RSTD = (MODE == 1); static constexpr bool PERM = true, BAR = true; static constexpr bool PRE = false;
    const bf16_t* hin; const float* hin32; bf16_t* hout; float* ssq_out; float alpha; const float* ssq; int np; const bf16_t* pp;
    __device__ __forceinline__ void preload(Acc& acc, const Unit& u, int wr, int wc, int fr, int fq) const {
        const float ia = 1.0f / alpha;
#pragma unroll
        for (int ai = 0; ai < 2; ++ai)
#pragma unroll
            for (int m = 0; m < 4; ++m) { const size_t r = (size_t)u.pm * BM + ai * HALF + wr * 64 + m * 16 + fr;
#pragma unroll
                for (int bj = 0; bj < 2; ++bj) { const size_t off = r * 2048 + u.pn * BM + bj * HALF + wc * 32 + 8 * fq;
                    if (hin32) { acc[ai][bj][m][0] = *(const f32x4*)(hin32 + off) * ia; acc[ai][bj][m][1] = *(const f32x4*)(hin32 + off + 4) * ia; }
                    else { const u32x4 hw = *(const u32x4*)(hin + off);
                        acc[ai][bj][m][0] = (f32x4){__uint_as_float(hw.x << 16), __uint_as_float(hw.x & 0xffff0000u), __uint_as_float(hw.y << 16), __uint_as_float(hw.y & 0xffff0000u)} * ia;
                        acc[ai][bj][m][1] = (f32x4){__uint_as_float(hw.z << 16), __uint_as_float(hw.z & 0xffff0000u), __uint_as_float(hw.w << 16), __uint_as_float(hw.w & 0xffff0000u)} * ia; } } }
    }
    bool pre;
    __device__ __forceinline__ void operator()(const Acc& acc, const Unit& u, int wr, int wc, int fr, int fq, PG8_LAS unsigned char* lds, int tid) const {
        float rs[2][4];
        if (MODE == 1) row_rstd(u.pm, wr, fr, rs, lds);
        PG8_LAS float* P = (PG8_LAS float*)(lds + EPI_LDS_OFF);
        const rsrc_t rs_o = out_rsrc(hout, 8192u * 2048u * 2u);
        constexpr int NBJ = (MODE == 2) ? 1 : 2; constexpr int CW = (MODE == 2) ? HALF : BM;
#pragma unroll
        for (int ai = 0; ai < 2; ++ai)
#pragma unroll
            for (int m = 0; m < 4; ++m) { const int rl = ai * HALF + wr * 64 + m * 16 + fr; const size_t r = (size_t)u.pm * BM + rl; float sq = 0.f;
#pragma unroll
                for (int bj = 0; bj < NBJ; ++bj) { const int col = u.pn * CW + bj * HALF + wc * 32 + 8 * fq; const size_t off = r * 2048 + col;
                    float f[8], h[8];
                    if (MODE == 0) {
#pragma unroll
                        for (int e = 0; e < 8; ++e) f[e] = acc[ai][bj][m][e >> 2][e & 3] * alpha; }
                    else if (MODE == 1) { const u32x4 pw = *(const u32x4*)(pp + off); const float s = rs[ai][m];
#pragma unroll
                        for (int e = 0; e < 8; ++e) { const unsigned w = pw[e >> 1]; const float pv = __uint_as_float((e & 1) ? (w & 0xffff0000u) : (w << 16)); f[e] = fast_sigmoid(acc[ai][bj][m][e >> 2][e & 3] * s) * pv; } }
                    else {
#pragma unroll
                        for (int e = 0; e < 8; ++e) f[e] = acc[ai][0][m][e >> 2][e & 3] * fast_sigmoid(acc[ai][1][m][e >> 2][e & 3]); }
                    if (MODE == 0 && pre) {
#pragma unroll
                        for (int e = 0; e < 8; ++e) h[e] = 0.f; }
                    else if (hin32) { const f32x4 a = *(const f32x4*)(hin32 + off), b = *(const f32x4*)(hin32 + off + 4);
#pragma unroll
                        for (int e = 0; e < 4; ++e) { h[e] = a[e]; h[4 + e] = b[e]; } }
                    else { const u32x4 hw = *(const u32x4*)(hin + off);
#pragma unroll
                        for (int e = 0; e < 8; ++e) { const unsigned w = hw[e >> 1]; h[e] = __uint_as_float((e & 1) ? (w & 0xffff0000u) : (w << 16)); } }
                    float o[8];
#pragma unroll
                    for (int e = 0; e < 8; ++e) { o[e] = h[e] + f[e]; sq = fmaf(o[e], o[e], sq); }
                    u32x4 w; w.x = cvt_pk_bf16(o[0], o[1]); w.y = cvt_pk_bf16(o[2], o[3]); w.z = cvt_pk_bf16(o[4], o[5]); w.w = cvt_pk_bf16(o[6], o[7]);
                    st16(hout, rs_o, (unsigned)(off * 2), w); }
                sq += __shfl_xor(sq, 16); sq += __shfl_xor(sq, 32);
                if (fq == 0) P[rl * 4 + wc] = sq;
                if (m & 1) asm volatile("" ::: "memory"); }
        asm volatile("s_waitcnt lgkmcnt(0)" ::: "memory"); __builtin_amdgcn_s_barrier(); asm volatile("" ::: "memory");
        if (tid < 256) { const f32x4 p4 = *(const PG8_LAS f32x4*)(P + tid * 4); const float sv = (p4[0] + p4[1]) + (p4[2] + p4[3]);
#if MK_WT
            __hip_atomic_store(ssq_out + ((size_t)u.pm * BM + tid) * 16 + u.pn, sv, __ATOMIC_RELAXED, __HIP_MEMORY_SCOPE_AGENT);
#else
            ssq_out[((size_t)u.pm * BM + tid) * 16 + u.pn] = sv;
#endif
        }
    }
};

template <class Epi, class Sched, bool NOMMA = false, bool MMAONLY = false>
__device__ __forceinline__ void gemm_phase(PG8_LAS unsigned char* lds, const Gemm g, const Sched& S, Epi E, const int wave, unsigned* pcnt = nullptr) {
    int tid_raw_ = MK_TID(); asm volatile("" : "+v"(tid_raw_)); const int tid = tid_raw_, wid = __builtin_amdgcn_readfirstlane(tid >> 6), lane = tid & 63, wr = wid >> 2, wc = wid & 3, fr = lane & 15, fq = lane >> 4;
    int K_ = g.K; asm volatile("" : "+s"(K_)); const int K = K_, nt = K / BK;
    unsigned voffA[2], voffB[2];
#pragma unroll
    for (int i = 0; i < 2; ++i) { int R, C; stage_rc(tid * 16 + i * 8192, R, C); const int Rb = Epi::PERM ? ((R & ~31) + perm32(R & 31)) : R;
        voffA[i] = (unsigned)(R * g.lda + C) * 2u; voffB[i] = (unsigned)(Rb * g.ldb + C) * 2u; }
    const size_t kstep = (size_t)(BK * 2);
    const size_t hstepA = (size_t)HALF * g.lda * 2, hstepB = (size_t)HALF * g.ldb * 2;
    const size_t tstepA = 2 * hstepA, tstepB = 2 * hstepB;
    const unsigned ldsw = (unsigned)wid * 1024u;
    const int aoff = lds_byte(wr * 64 + fr, fq * 8), boff = lds_byte(wc * 32 + fr, fq * 8);
#define PG8_SA(b, h) (((b) * 2 + (h)) * HTB)
#define PG8_SB(b, h) ((4 + (b) * 2 + (h)) * HTB)
#ifndef MK_BNT
#define MK_BNT 0
#endif
#define PG8_STAGE_(bufoff, gbase, voff, aux) do { if (MMAONLY) break; _Pragma("unroll") for (int _i = 0; _i < 2; ++_i) \
        __builtin_amdgcn_global_load_lds((const unsigned*)((const char*)(gbase) + (voff)[_i]), (PG8_LAS unsigned*)(lds + (bufoff) + ldsw + _i * 8192), 16, 0, aux); } while (0)
#define PG8_STAGE(bufoff, gbase, voff) PG8_STAGE_(bufoff, gbase, voff, 0)
#define PG8_STAGEB(bufoff, gbase, voff) PG8_STAGE_(bufoff, gbase, voff, MK_BNT)
#define PG8_LDA(dst, b, h) do { if (MMAONLY) { asm volatile("" : "+v"(dst[0][0]), "+v"(dst[1][0]), "+v"(dst[2][0]), "+v"(dst[3][0])); break; } _Pragma("unroll") for (int m = 0; m < 4; ++m) _Pragma("unroll") for (int k = 0; k < 2; ++k) dst[m][k] = *(const PG8_LAS bf16x8*)(lds + PG8_SA(b, h) + aoff + m * 2048 + k * 1024); } while (0)
#define PG8_LDB(dst, b, h) do { if (MMAONLY) { asm volatile("" : "+v"(dst[0][0]), "+v"(dst[1][0])); break; } _Pragma("unroll") for (int n = 0; n < 2; ++n) _Pragma("unroll") for (int k = 0; k < 2; ++k) dst[n][k] = *(const PG8_LAS bf16x8*)(lds + PG8_SB(b, h) + boff + n * 2048 + k * 1024); } while (0)
#define PG8_MMA(ai, bj, At, Bt) do { if (NOMMA) { asm volatile("" :: "v"(At[0][0]), "v"(At[0][1]), "v"(At[1][0]), "v"(At[1][1]), "v"(At[2][0]), "v"(At[2][1]), "v"(At[3][0]), "v"(At[3][1]), "v"(Bt[0][0]), "v"(Bt[0][1]), "v"(Bt[1][0]), "v"(Bt[1][1])); break; } __builtin_amdgcn_s_setprio(1); _Pragma("unroll") for (int m = 0; m < 4; ++m) _Pragma("unroll") for (int n = 0; n < 2; ++n) _Pragma("unroll") for (int k = 0; k < 2; ++k) \
        acc[ai][bj][m][n] = __builtin_amdgcn_mfma_f32_16x16x32_bf16(Bt[n][k], At[m][k], acc[ai][bj][m][n], 0, 0, 0); __builtin_amdgcn_s_setprio(0); } while (0)
#define PG8_WAIT_V(n) asm volatile("s_waitcnt vmcnt(" #n ")" ::: "memory")
#define PG8_WAIT_L(n) asm volatile("s_waitcnt lgkmcnt(" #n ")" ::: "memory")
#define PG8_BAR do { if (!MMAONLY) __builtin_amdgcn_s_barrier(); } while (0)
#define PG8_SCHED __builtin_amdgcn_sched_barrier(0)
    Unit cur, nxt; int ui = 0;
    if (!S.next(0, cur)) return;
    int pm_r = -1;
    if constexpr (Epi::RSTD) { if (E.ssq) { fill_rstd(E.ssq, E.np, cur.pm, lds, tid); pm_r = cur.pm >> 2; } }
    f32x4 acc[2][2][4][2];
#pragma unroll
    for (int a = 0; a < 2; ++a)
#pragma unroll
        for (int b = 0; b < 2; ++b)
#pragma unroll
            for (int m = 0; m < 4; ++m)
#pragma unroll
                for (int n = 0; n < 2; ++n) acc[a][b][m][n] = (f32x4){0.f, 0.f, 0.f, 0.f};
    if constexpr (Epi::PRE) { int lp_ = lane; asm volatile("" : "+v"(lp_)); E.preload(acc, cur, wr, wc, lp_ & 15, lp_ >> 4); E.pre = true; }
    bf16x8 At[4][2], B0[2][2], B1[2][2];
    if (MMAONLY) {
#pragma unroll
        for (int m = 0; m < 4; ++m)
#pragma unroll
            for (int k = 0; k < 2; ++k) At[m][k] = (bf16x8){(short)(0x3f80 + lane), 0x3f00, 0x4000, 0x3e80, 0x3f80, 0x3f00, 0x4000, 0x3e80};
#pragma unroll
        for (int n = 0; n < 2; ++n)
#pragma unroll
            for (int k = 0; k < 2; ++k) { B0[n][k] = At[n][k]; B1[n][k] = At[n + 2][k]; } }
    const char* cA = (const char*)g.A + (size_t)cur.pm * tstepA; const char* cB = (const char*)g.Bt + (size_t)cur.pb * tstepB;
    PG8_STAGEB(PG8_SB(0, 0), cB, voffB); PG8_STAGEB(PG8_SB(0, 1), cB + hstepB, voffB); PG8_STAGE(PG8_SA(0, 0), cA, voffA); PG8_STAGE(PG8_SA(0, 1), cA + hstepA, voffA);
    if (wr == 1) PG8_BAR;
    PG8_WAIT_V(2); PG8_BAR;
    PG8_STAGEB(PG8_SB(1, 0), cB + kstep, voffB); PG8_STAGE(PG8_SA(1, 0), cA + kstep, voffA); PG8_STAGEB(PG8_SB(1, 1), cB + hstepB + kstep, voffB);
    PG8_WAIT_V(6); PG8_BAR;
    for (;;) {
        const bool has_next = S.next(ui + 1, nxt);
        const char* nA = has_next ? (const char*)g.A + (size_t)nxt.pm * tstepA : cA; const char* nB = has_next ? (const char*)g.Bt + (size_t)nxt.pb * tstepB : cB;
        for (int t = 0; t < nt; t += 2) {
            const bool last = (t == nt - 2);
            const char* a1 = cA + (size_t)(t + 1) * kstep;
            const char* a2 = last ? nA : cA + (size_t)(t + 2) * kstep; const char* b2 = last ? nB : cB + (size_t)(t + 2) * kstep;
            const char* a3 = a2 + kstep; const char* b3 = b2 + kstep;
            PG8_LDB(B0, 0, 0); PG8_LDB(B1, 0, 1); PG8_SCHED; PG8_LDA(At, 0, 0); PG8_STAGE(PG8_SA(1, 1), a1 + hstepA, voffA);
            PG8_WAIT_V(8); PG8_WAIT_L(0); PG8_BAR; PG8_MMA(0, 0, At, B0); PG8_MMA(0, 1, At, B1); PG8_BAR; PG8_SCHED;
            PG8_LDA(At, 0, 1); PG8_STAGEB(PG8_SB(0, 0), b2, voffB); PG8_STAGEB(PG8_SB(0, 1), b2 + hstepB, voffB); PG8_STAGE(PG8_SA(0, 0), a2, voffA);
            PG8_WAIT_V(8); PG8_WAIT_L(0); PG8_BAR; PG8_MMA(1, 0, At, B0); PG8_MMA(1, 1, At, B1); PG8_BAR; PG8_SCHED;
            PG8_LDB(B0, 1, 0); PG8_LDB(B1, 1, 1); PG8_SCHED; PG8_LDA(At, 1, 0); PG8_STAGE(PG8_SA(0, 1), a2 + hstepA, voffA);
            PG8_WAIT_V(8); PG8_WAIT_L(0); PG8_BAR; PG8_MMA(0, 0, At, B0); PG8_MMA(0, 1, At, B1); PG8_BAR; PG8_SCHED;
            PG8_LDA(At, 1, 1); PG8_STAGEB(PG8_SB(1, 0), b3, voffB); PG8_STAGEB(PG8_SB(1, 1), b3 + hstepB, voffB); PG8_STAGE(PG8_SA(1, 0), a3, voffA);
            PG8_WAIT_V(8); PG8_WAIT_L(0); PG8_BAR; PG8_MMA(1, 0, At, B0); PG8_MMA(1, 1, At, B1); PG8_BAR; PG8_SCHED;
        }
        if (wr == 0) PG8_BAR;
        if constexpr (Epi::RSTD) { if (E.ssq && (cur.pm >> 2) != pm_r) { fill_rstd(E.ssq, E.np, cur.pm, lds, tid); pm_r = cur.pm >> 2; } }
        { int le_ = lane; asm volatile("" : "+v"(le_));
          E(acc, cur, wr, wc, le_ & 15, le_ >> 4, lds, (wid << 6) | le_); }
        if (!has_next) break;
        if constexpr (Epi::PRE) E.pre = false;
#pragma unroll
        for (int a = 0; a < 2; ++a)
#pragma unroll
            for (int b = 0; b < 2; ++b)
#pragma unroll
                for (int m = 0; m < 4; ++m)
#pragma unroll
                    for (int n = 0; n < 2; ++n) acc[a][b][m][n] = (f32x4){0.f, 0.f, 0.f, 0.f};
        cur = nxt; cA = nA; cB = nB; ++ui;
        if (wr == 1) PG8_BAR;
    }
    PG8_WAIT_V(0);
    PG8_BAR;
    if (pcnt) { unsigned* pc_ = pcnt; asm volatile("" : "+s"(pc_));
        if (wave == 0 && lane == 0) __hip_atomic_fetch_add(pc_, 1u, __ATOMIC_RELAXED, __HIP_MEMORY_SCOPE_AGENT); }
#undef PG8_SA
#undef PG8_SB
#undef PG8_STAGE
#undef PG8_STAGEB
#undef PG8_STAGE_
#undef PG8_LDA
#undef PG8_LDB
#undef PG8_MMA
#undef PG8_WAIT_V
#undef PG8_WAIT_L
#undef PG8_BAR
#undef PG8_SCHED
}
}
namespace att {
typedef unsigned short bf16;
typedef short bf16x8 __attribute__((ext_vector_type(8)));
typedef short s16x4 __attribute__((ext_vector_type(4)));
typedef float f32x16 __attribute__((ext_vector_type(16)));
typedef float f32x4 __attribute__((ext_vector_type(4)));
typedef unsigned u32x4 __attribute__((ext_vector_type(4)));
constexpr int D = 128, SEQ = 2048, OS = 2048;
constexpr float SCALE = 0.08838834764831845f, THR = 8.f;
constexpr int NW = 8, QBLK = 32, KVBLK = 64, QB = NW * QBLK;
constexpr int SHM_V = KVBLK * D * 2, SHM_K = KVBLK * D * 2;
constexpr int LDS_WS = 2 * SHM_V + 2 * SHM_K;
constexpr int LDS_BIAS = LDS_WS + NW * 64 * 4;
constexpr int LDS_NEG = LDS_BIAS + SEQ * 4;
constexpr int LDS_OST = 77824, OST_WAVE = 16 * 272;
constexpr int LDS_BYTES = LDS_OST + NW * OST_WAVE;
static_assert(LDS_OST >= LDS_NEG + 256, "attention LDS map");

#define KSWZ(row, colB) ((row) * 256 + ((colB) ^ (((row) & 7) << 4)))
#define SBAR() __builtin_amdgcn_sched_barrier(0)
__device__ __forceinline__ int v_st(int k, int c) { const int kk = (k & ~0xC) | ((k & 4) << 1) | ((k & 8) >> 1); return ((kk >> 3) * 4 + (c >> 5)) * 512 + ((kk & 7) * 32 + (c & 31)) * 2; }
__device__ __forceinline__ int v_rd_base(int lane) { return ((lane & 3) << 3) | (((lane >> 2) & 3) << 6) | (((lane >> 4) & 1) << 5) | (((lane >> 5) & 1) << 8); }
constexpr int v_rd_off(int d0, int ks, int half) { return d0 * 512 + ks * 4096 + half * 2048; }
__device__ __forceinline__ int crow(int r, int hi) { return (r & 3) + 8 * (r >> 2) + 4 * hi; }
__device__ __forceinline__ unsigned cvtpk(float lo, float hi) { unsigned r; asm volatile("v_cvt_pk_bf16_f32 %0, %1, %2" : "=v"(r) : "v"(lo), "v"(hi)); return r; }
__device__ __forceinline__ bf16x8 load8(const bf16* p) { return *reinterpret_cast<const bf16x8*>(p); }
__device__ __forceinline__ void mask_tile(f32x16& p0, f32x16& p1, int dq) {
    const float NEG = -__builtin_inff();
#pragma unroll
    for (int r = 0; r < 16; ++r) {
        const int c = (r & 3) + 8 * (r >> 2);
        if (dq - c < 0) p0[r] = NEG;
        if (dq - c - 32 < 0) p1[r] = NEG;
    }
}
__device__ __forceinline__ void partialSM(f32x16& p0, f32x16& p1, float& m_reg, float& mn, float& alpha) {
    float pmax = p0[0]; for (int r = 1; r < 16; ++r) pmax = fmaxf(pmax, p0[r]); for (int r = 0; r < 16; ++r) pmax = fmaxf(pmax, p1[r]);
    { auto rr = __builtin_amdgcn_permlane32_swap(__float_as_uint(pmax), __float_as_uint(pmax), false, false);
      pmax = fmaxf(__uint_as_float(rr[0]), __uint_as_float(rr[1])); }
    constexpr float C2 = 1.4426950408889634f * SCALE;
    if (__builtin_expect(__all((pmax - m_reg) * SCALE <= THR), 1)) { mn = m_reg; alpha = 1.f; }
    else { mn = fmaxf(m_reg, pmax); alpha = __builtin_amdgcn_exp2f((m_reg - mn) * C2); m_reg = mn; }
    const float mnL = -mn * C2;
    for (int r = 0; r < 16; ++r) p0[r] = fmaf(p0[r], C2, mnL); for (int r = 0; r < 16; ++r) p1[r] = fmaf(p1[r], C2, mnL);
    for (int r = 0; r < 16; ++r) p0[r] = __builtin_amdgcn_exp2f(p0[r]);
}
__device__ __forceinline__ void finishSM(f32x16& p0, f32x16& p1, float alpha, float& l_reg, bf16x8& pa0, bf16x8& pa1, bf16x8& pa2, bf16x8& pa3) {
    for (int r = 0; r < 16; ++r) p1[r] = __builtin_amdgcn_exp2f(p1[r]);
    float ps = 0; for (int r = 0; r < 16; ++r) ps += p0[r]; for (int r = 0; r < 16; ++r) ps += p1[r];
    { auto rr = __builtin_amdgcn_permlane32_swap(__float_as_uint(ps), __float_as_uint(ps), false, false);
      ps = __uint_as_float(rr[0]) + __uint_as_float(rr[1]); }
    l_reg = l_reg * alpha + ps;
#define PK4(P, B_, OUT) do { unsigned a0 = cvtpk(P[B_+0], P[B_+1]), a1 = cvtpk(P[B_+2], P[B_+3]);                          \
        unsigned b0 = cvtpk(P[B_+4], P[B_+5]), b1 = cvtpk(P[B_+6], P[B_+7]);                                             \
        auto r0 = __builtin_amdgcn_permlane32_swap(a0, b0, false, false); auto r1 = __builtin_amdgcn_permlane32_swap(a1, b1, false, false); \
        u32x4 w = {r0[0], r1[0], r0[1], r1[1]}; OUT = *reinterpret_cast<bf16x8*>(&w); } while (0)
    PK4(p0, 0, pa0); PK4(p0, 8, pa1); PK4(p1, 0, pa2); PK4(p1, 8, pa3);
#undef PK4
}
template <int KB, bool NOBIAS = false>
__device__ __forceinline__ void qkt(f32x16& p0, f32x16& p1, const char* K_lds, int r32, int hi, const bf16x8* qr, const __attribute__((address_space(3))) char* bp) {
    if (NOBIAS) { p0 = f32x16{}; p1 = f32x16{}; } else
    { unsigned bpa = (unsigned)(uintptr_t)bp; asm volatile("" : "+v"(bpa));
      const __attribute__((address_space(3))) f32x4* b4 = (const __attribute__((address_space(3))) f32x4*)(uintptr_t)bpa;
      const f32x4 x0 = b4[0], x1 = b4[2], x2 = b4[4], x3 = b4[6], y0 = b4[8], y1 = b4[10], y2 = b4[12], y3 = b4[14];
      p0 = (f32x16){x0[0], x0[1], x0[2], x0[3], x1[0], x1[1], x1[2], x1[3], x2[0], x2[1], x2[2], x2[3], x3[0], x3[1], x3[2], x3[3]};
      p1 = (f32x16){y0[0], y0[1], y0[2], y0[3], y1[0], y1[1], y1[2], y1[3], y2[0], y2[1], y2[2], y2[3], y3[0], y3[1], y3[2], y3[3]}; }
    const char* kb[4];
#pragma unroll
    for (int dd = 0; dd < 4; ++dd) kb[dd] = K_lds + KB * SHM_K + KSWZ(r32, (dd * 16 + hi * 8) * 2);
#pragma unroll
    for (int d0 = 0; d0 < 8; ++d0) { const char* a = kb[d0 & 3] + (d0 >> 2) * 128;
        bf16x8 b0 = *reinterpret_cast<const bf16x8*>(a);
        bf16x8 b1 = *reinterpret_cast<const bf16x8*>(a + 32 * 256);
        p0 = __builtin_amdgcn_mfma_f32_32x32x16_bf16(b0, qr[d0], p0, 0, 0, 0);
        p1 = __builtin_amdgcn_mfma_f32_32x32x16_bf16(b1, qr[d0], p1, 0, 0, 0); }
}
template <int VB>
__device__ __forceinline__ void pv_tile(f32x16* o, int vb0, bf16x8 pa0, bf16x8 pa1, bf16x8 pa2, bf16x8 pa3) {
#define TRRD(dst, off) asm volatile("ds_read_b64_tr_b16 %0, %1 offset:%2" : "=&v"(dst) : "v"(vb0), "i"(off) : "memory")
#define PV_D0(d0) do { s16x4 l0, l1, l2, l3, h0, h1, h2, h3; constexpr int b_ = VB * SHM_V + v_rd_off(d0, 0, 0); \
        TRRD(l0, b_); TRRD(h0, b_ + 2048); TRRD(l1, b_ + 4096); TRRD(h1, b_ + 6144); TRRD(l2, b_ + 8192); TRRD(h2, b_ + 10240); TRRD(l3, b_ + 12288); TRRD(h3, b_ + 14336); \
        asm volatile("s_waitcnt lgkmcnt(0)" ::: "memory"); SBAR();   \
        o[d0] = __builtin_amdgcn_mfma_f32_32x32x16_bf16(pa0, (bf16x8){l0[0], l0[1], l0[2], l0[3], h0[0], h0[1], h0[2], h0[3]}, o[d0], 0, 0, 0);   \
        o[d0] = __builtin_amdgcn_mfma_f32_32x32x16_bf16(pa1, (bf16x8){l1[0], l1[1], l1[2], l1[3], h1[0], h1[1], h1[2], h1[3]}, o[d0], 0, 0, 0);   \
        o[d0] = __builtin_amdgcn_mfma_f32_32x32x16_bf16(pa2, (bf16x8){l2[0], l2[1], l2[2], l2[3], h2[0], h2[1], h2[2], h2[3]}, o[d0], 0, 0, 0);   \
        o[d0] = __builtin_amdgcn_mfma_f32_32x32x16_bf16(pa3, (bf16x8){l3[0], l3[1], l3[2], l3[3], h3[0], h3[1], h3[2], h3[3]}, o[d0], 0, 0, 0); } while (0)
    PV_D0(0); PV_D0(1); PV_D0(2); PV_D0(3);
#undef PV_D0
#undef TRRD
}

struct BlockRef { const bf16* Q; const bf16* K; const bf16* V; bf16* O; int P0; int bh; };
struct Seam { bf16x8 qr[8]; bf16x8 st_v0, st_v1, st_k0, st_k1; };
#define ROW(p, k0, rr) ((const bf16*)((const char*)((p) + (size_t)(k0) * D) + (unsigned)(((rr) * D + sc) * 2)))
#define VMW() asm volatile("s_waitcnt vmcnt(0)" ::: "memory")
#define VMWN(n) asm volatile("s_waitcnt vmcnt(%0)" :: "i"(n) : "memory")
#define SLOAD_H(Kp, Vp, k0) do { S.st_v0 = load8(ROW(Vp, k0, sr)); S.st_v1 = load8(ROW(Vp, k0, 32 + sr));              \
                         S.st_k0 = load8(ROW(Kp, k0, sr)); S.st_k1 = load8(ROW(Kp, k0, 32 + sr)); } while (0)
#define SWRITE_HK(bf) do { *(bf16x8*)(K_lds + (bf) * SHM_K + kws) = S.st_k0; *(bf16x8*)(K_lds + (bf) * SHM_K + kws + 32 * 256) = S.st_k1; } while (0)
#define SWRITE_HV(bf) do { *(bf16x8*)(V_lds + (bf) * SHM_V + vst0) = S.st_v0; *(bf16x8*)(V_lds + (bf) * SHM_V + vst1) = S.st_v1; } while (0)
#define SWRITE_H(bf) do { SWRITE_HV(bf); SWRITE_HK(bf); } while (0)
__device__ __forceinline__ void attn_prime(const BlockRef& cur, char* lds, Seam& S, const int wave) {
    int tid_raw_ = MK_TID(); asm volatile("" : "+v"(tid_raw_)); const int tid = tid_raw_, wid = __builtin_amdgcn_readfirstlane(tid >> 6), lane = tid & 63, r32 = lane & 31, hi = lane >> 5;
    const int sr = tid >> 4, sc = (tid & 15) * 8, kws = KSWZ(sr, sc * 2); char* K_lds = lds + 2 * SHM_V;
    for (int d0 = 0; d0 < 8; ++d0) S.qr[d0] = load8((const bf16*)((const char*)(cur.Q + (size_t)(wid * QBLK) * D) + (unsigned)((r32 * D + hi * 8) * 2)) + d0 * 16);
    SLOAD_H(cur.K, cur.V, 0); VMW(); SWRITE_HK(0);
    __syncthreads();
}
template <bool MOBA, bool NOBIAS = false>
__device__ __forceinline__ void attn_block(const BlockRef& cur, const BlockRef& nxt, char* lds, Seam& S, const float* __restrict__ biasG  , const unsigned* __restrict__ selG  , const int wave) {
    int tid_raw_ = MK_TID(); asm volatile("" : "+v"(tid_raw_)); const int tid = tid_raw_, wid = __builtin_amdgcn_readfirstlane(tid >> 6), lane = tid & 63, r32 = lane & 31, hi = lane >> 5;
    const int NT = (cur.P0 + QB) / KVBLK;
    const int qlo = cur.P0 + wid * QBLK, qm = qlo + r32 - 4 * hi;
    char* V_lds = lds; char* K_lds = lds + 2 * SHM_V;
    float* ws = (float*)(lds + LDS_WS) + wid * 64; float* li_l = ws, * al_l = ws + 32;
    float* biasL = (float*)(lds + LDS_BIAS); float* negL = (float*)(lds + LDS_NEG);
    unsigned selmask = 0u; const int own = cur.P0 >> 8;
    { int te = tid; asm volatile("" : "+v"(te));
      if (te < 64) negL[te] = -__builtin_inff();
      if (MOBA || NOBIAS) {
        *(f32x4*)(biasL + 4 * te) = *(const f32x4*)(biasG + (size_t)cur.bh * SEQ + 4 * te);
        if (MOBA) selmask = selG[(size_t)cur.bh * SEQ + cur.P0 + (te >> 6) * QBLK + (te & 31)];
      } else {
        f32x4 v = *(const f32x4*)(biasG + (size_t)cur.bh * SEQ + 4 * te); v[1] += v[0]; v[2] += v[1]; v[3] += v[2];
        float sc = v[3];
#pragma unroll
        for (int o = 1; o < 64; o <<= 1) { const float t = __shfl_up(sc, o); if ((te & 63) >= o) sc += t; }
        float* wsum = (float*)(lds + LDS_WS);
        if ((te & 63) == 63) wsum[te >> 6] = sc;
        __syncthreads();
        float base = sc - v[3];
#pragma unroll
        for (int w = 0; w < 7; ++w) if (w < (te >> 6)) base += wsum[w];
        const float ns = -1.0f / SCALE;
        *(f32x4*)(biasL + 4 * te) = (f32x4){(v[0] + base) * ns, (v[1] + base) * ns, (v[2] + base) * ns, (v[3] + base) * ns};
      } }
    __syncthreads();
    typedef const __attribute__((address_space(3))) char* lcp; const lcp bias_b = (lcp)((const char*)biasL) + 16 * hi; const lcp neg_b = (lcp)((const char*)negL) + 16 * hi;
    float m_reg = biasL[cur.P0 + wid * QBLK + r32], l_reg = 0; f32x16 o[4] = {};
    const int sr = tid >> 4, sc = (tid & 15) * 8, vst0 = v_st(sr, sc), vst1 = v_st(32 + sr, sc), kws = KSWZ(sr, sc * 2);
    const int vb0 = (int)(uintptr_t)V_lds + v_rd_base(lane);
    const bf16* Kh = cur.K; const bf16* Vh = cur.V;
#define RESC(a) do { if (__any((a) < 1.f)) { if (hi == 0) al_l[r32] = (a); asm volatile("s_waitcnt lgkmcnt(0)" ::: "memory");              \
                     for (int d_ = 0; d_ < 4; ++d_) for (int r = 0; r < 16; ++r) o[d_][r] *= al_l[crow(r, hi)]; } } while (0)
#define KBASE(t) ((t) * KVBLK)
#define BP(t) ((!MOBA || (KBASE(t) >> 8) >= own || ((selmask >> (KBASE(t) >> 8)) & 1u)) ? (bias_b + KBASE(t) * 4) : neg_b)
#define MASKT(P0_, P1_, t) do { const int kb_ = KBASE(t); if (kb_ + KVBLK - 1 > qlo) mask_tile(P0_, P1_, qm - kb_); } while (0)
#define SEAM_K0() do { VMWN(8); SWRITE_HK(0); SBAR(); } while (0)
    f32x16 pA0, pA1, pB0, pB1; float mnA, mnB, alA, alB; bf16x8 pa0, pa1, pa2, pa3;
    SWRITE_HV(0); SBAR();
    SLOAD_H(Kh, Vh, KBASE(1));
    SBAR(); qkt<0, NOBIAS>(pA0, pA1, K_lds, r32, hi, S.qr, BP(0));
    MASKT(pA0, pA1, 0); partialSM(pA0, pA1, m_reg, mnA, alA);
    VMW(); SWRITE_H(1);
    __syncthreads();
#define HALF_STEP(PX0, PX1, mnX, alX, PY0, PY1, alY, t, KB, VB, SB) do {                                                      \
        SBAR(); qkt<KB, NOBIAS>(PX0, PX1, K_lds, r32, hi, S.qr, BP(t));                                                               \
        finishSM(PY0, PY1, alY, l_reg, pa0, pa1, pa2, pa3); SBAR();                                                           \
        if ((t) + 1 < NT) { SLOAD_H(Kh, Vh, KBASE((t) + 1)); SBAR(); }                                                        \
        pv_tile<VB>(o, vb0, pa0, pa1, pa2, pa3); MASKT(PX0, PX1, (t)); partialSM(PX0, PX1, m_reg, mnX, alX);                  \
        __syncthreads();                                                                                                      \
        if ((t) + 1 < NT) { VMW(); SWRITE_H(SB); }                                                                            \
        RESC(alX); __syncthreads(); } while (0)
    for (int t = 1; t + 1 < NT; t += 2) {
        HALF_STEP(pB0, pB1, mnB, alB, pA0, pA1, alA, t, 1, 0, 0);
        HALF_STEP(pA0, pA1, mnA, alA, pB0, pB1, alB, t + 1, 0, 1, 1);
    }
    { SBAR(); qkt<1, NOBIAS>(pB0, pB1, K_lds, r32, hi, S.qr, BP(NT - 1)); SBAR(); }
    SLOAD_H(nxt.K, nxt.V, 0); SBAR();
    { int lq = lane; asm volatile("" : "+v"(lq));
#pragma unroll
    for (int d0 = 0; d0 < 8; ++d0) S.qr[d0] = load8((const bf16*)((const char*)(nxt.Q + (size_t)(wid * QBLK) * D) + (unsigned)(((lq & 31) * D + (lq >> 5) * 8) * 2)) + d0 * 16); }
    SBAR();
    finishSM(pA0, pA1, alA, l_reg, pa0, pa1, pa2, pa3); SBAR();
    pv_tile<0>(o, vb0, pa0, pa1, pa2, pa3);
    { MASKT(pB0, pB1, NT - 1); partialSM(pB0, pB1, m_reg, mnB, alB); __syncthreads(); RESC(alB);
      finishSM(pB0, pB1, alB, l_reg, pa0, pa1, pa2, pa3); SBAR(); pv_tile<1>(o, vb0, pa0, pa1, pa2, pa3); }
    SBAR(); SEAM_K0();
    { int le = lane; asm volatile("" : "+v"(le)); const int r32e = le & 31, hie = le >> 5;
    if (hie == 0) li_l[r32e] = l_reg; asm volatile("s_waitcnt lgkmcnt(0)" ::: "memory");
    float rli[16];
#pragma unroll
    for (int r = 0; r < 16; ++r) rli[r] = __builtin_amdgcn_rcpf(li_l[crow(r, hie)]);
    bf16* Ow = cur.O + (size_t)(wid * QBLK) * OS; char* stg = lds + LDS_OST + wid * OST_WAVE;
#pragma unroll
    for (int p = 0; p < 2; ++p) {
#pragma unroll
        for (int j = 0; j < 8; ++j) { const int r = 8 * p + j, lrow = (j & 3) + 8 * (j >> 2) + 4 * hie;
#pragma unroll
            for (int d0 = 0; d0 < 4; ++d0) { const float v = o[d0][r] * rli[r]; *(unsigned short*)(stg + lrow * 272 + (32 * d0 + r32e) * 2) = (unsigned short)cvtpk(v, v); } }
        asm volatile("s_waitcnt lgkmcnt(0)" ::: "memory");
#pragma unroll
        for (int i = 0; i < 4; ++i) { const int row = (le >> 4) + 4 * i, c = le & 15; const u32x4 w = *(const u32x4*)(stg + row * 272 + c * 16);
#if defined(MK_ASMST) && MK_ASMST == 2
            asm volatile("global_store_dwordx4 %0, %1, off\n\ts_nop 1" :: "v"(Ow + (size_t)(16 * p + row) * OS + c * 8), "v"(w) : "memory"); }
#elif !defined(MK_ASMST) || MK_ASMST
            asm volatile("global_store_dwordx4 %0, %1, off sc1\n\ts_nop 1" :: "v"(Ow + (size_t)(16 * p + row) * OS + c * 8), "v"(w) : "memory"); }
#else
            *(u32x4*)(Ow + (size_t)(16 * p + row) * OS + c * 8) = w; }
#endif
        asm volatile("s_waitcnt lgkmcnt(0)" ::: "memory");
    } }
    __syncthreads();
#undef RESC
#undef KBASE
#undef BP
#undef MASKT
#undef SEAM_K0
#undef HALF_STEP
}
#undef ROW
#undef VMW
#undef VMWN
#undef SLOAD_H
#undef SWRITE_HK
#undef SWRITE_HV
#undef SWRITE_H

template <bool MOBA, bool NOBIAS = false>
__device__ __forceinline__ void attn_phase(char* lds, const bf16* Q, const bf16* K, const bf16* V, bf16* O, const float* biasG, const unsigned* selG, const int wave) {
    const int G = gridDim.x; int idx = blockIdx.x; if (idx >= 256) return;
    auto ref = [&](int id, int pass) { const int xcd = id & 7, k = id >> 3, bh = xcd * 8 + (k >> 2), y = k & 3, qb = pass ? 7 - y : y, b = bh >> 4, h = bh & 15;
        BlockRef r; r.Q = Q + ((size_t)bh * SEQ + (size_t)qb * QB) * D; r.K = K + (size_t)bh * SEQ * D; r.V = V + (size_t)bh * SEQ * D;
        r.O = O + ((size_t)b * SEQ + (size_t)qb * QB) * OS + h * D; r.P0 = qb * QB; r.bh = bh; return r; };
    int pass = 0; BlockRef cur = ref(idx, 0);
    Seam S;
    attn_prime(cur, lds, S, wave);
    for (;;) {
        const bool more_pass = pass == 0, more_item = idx + G < 256, last = !more_pass && !more_item;
        int idn = idx, passn = pass + 1; if (!more_pass) { passn = 0; idn = more_item ? idx + G : idx; }
        const BlockRef nxt = last ? cur : ref(idn, passn);
        attn_block<MOBA, NOBIAS>(cur, nxt, lds, S, biasG, selG, wave);
        if (last) break;
        cur = nxt; idx = idn; pass = passn;
    }
}
}
constexpr int NWAVES = 8;
constexpr int BATCH = 4, SEQ = 2048, DM = 2048, M = BATCH * SEQ, FF = 5632, NH = 16, HD = 128, PLE = 256, DEPTH = 4;
constexpr size_t MiB = 1u << 20;
constexpr size_t WS_CTL = 0, CTL_ZERO_BYTES = 32768;
constexpr size_t WS_WFI = 1 * MiB;
constexpr size_t WS_WFO = WS_WFI + 352 * MiB;
constexpr size_t WS_WPG = WS_WFO + 176 * MiB;
constexpr size_t WS_WPP = WS_WPG + 32 * MiB;
constexpr size_t WS_WQKV = WS_WPP + 4 * MiB;
constexpr size_t WS_WO = WS_WQKV + 72 * MiB;
constexpr size_t WS_WS5I = WS_WO + 24 * MiB;
constexpr size_t WS_WGLU = WS_WS5I + 8 * MiB;
constexpr size_t WS_S5TV = WS_WGLU + 16 * MiB;
constexpr size_t WS_S5W = WS_S5TV + 80 * MiB;
constexpr size_t WS_WFT = WS_S5W + 32 * MiB;
constexpr size_t WS_H = WS_WFT + 1 * MiB;
constexpr size_t WS_HB = WS_H + 64 * MiB;
constexpr size_t WS_ACT = WS_HB + 32 * MiB;
constexpr size_t WS_QKV = WS_ACT + 88 * MiB;
constexpr size_t WS_OB = WS_QKV + 96 * MiB;
constexpr size_t WS_SSQ = WS_OB + 32 * MiB;
constexpr size_t WS_PP = WS_SSQ + 1 * MiB;
constexpr size_t WS_PBF = WS_PP + 128 * MiB;
constexpr size_t WS_LOGF = WS_PBF + 16 * MiB;
constexpr size_t WS_KMEAN = WS_LOGF + 1 * MiB;
constexpr size_t WS_UH = WS_KMEAN + 1 * MiB;
constexpr size_t WS_HLOC = WS_UH + 40 * MiB;
constexpr size_t WS_YB = WS_HLOC + 16 * MiB;
constexpr size_t WS_HB2 = WS_YB + 32 * MiB;
constexpr size_t WS_H2 = WS_HB2 + 32 * MiB;
constexpr size_t WS_BIAS = WS_H2 + 64 * MiB;
constexpr size_t WS_SEL = WS_BIAS + 1 * MiB;
constexpr size_t WS_END = WS_SEL + 1 * MiB;
constexpr int CW_TAIL = 3072, CW_BATCH = 3328, CW_PP = 3584, CW_S5U = 3648, CW_S5G = 3776;
constexpr int CW_BAR = 4096;
constexpr int RING_OFF = 0, RING_BYTES = 131072, EPI_OFF = 131072, LDSCTL_OFF = 139264, MISC_OFF = LDSCTL_OFF + 320, LDS_BYTES = 147456;
static_assert(att::LDS_BYTES <= RING_BYTES && pg8::EPI_LDS_OFF == EPI_OFF, "LDS map");

#define GAS __attribute__((address_space(1)))
#define LAS __attribute__((address_space(3)))
typedef unsigned short bf16;
typedef unsigned v4u __attribute__((ext_vector_type(4)));
typedef unsigned v2u __attribute__((ext_vector_type(2)));
typedef float f32x4 __attribute__((ext_vector_type(4)));
typedef float f32x2 __attribute__((ext_vector_type(2)));
typedef GAS unsigned gu32;
#define RLX_AGENT __ATOMIC_RELAXED, __HIP_MEMORY_SCOPE_AGENT
#define LDS_WAIT() asm volatile("s_waitcnt lgkmcnt(0)" ::: "memory")
#define VM_WAIT() asm volatile("s_waitcnt vmcnt(0)" ::: "memory")
__device__ __forceinline__ unsigned f2bf(float f) { unsigned u = __builtin_bit_cast(unsigned, f); return (u + 0x7fffu + ((u >> 16) & 1u)) >> 16; }
__device__ __forceinline__ unsigned pk2(float lo, float hi) { return f2bf(lo) | (f2bf(hi) << 16); }
__device__ __forceinline__ float wave_sum(float v) {
#pragma unroll
    for (int o = 1; o < 64; o <<= 1) v += __shfl_xor(v, o);
    return v;
}

#define XB_TMO      128
#define XB_XCNT(j)  (256  + 64 * (j))
#define XB_XSUB(j)  (1280 + 64 * (j))
#define XB_XGEN(j)  (2304 + 64 * (j))
#define XB_TOP      3328
#define XB_TOPGEN   3392
#define XCD_BAR_WORDS 3456
#define XB_SPIN_CAP (1u << 18)

__device__ __forceinline__ unsigned xb_ld(unsigned* p)              { return __hip_atomic_load(p, __ATOMIC_RELAXED, __HIP_MEMORY_SCOPE_AGENT); }
__device__ __forceinline__ unsigned xb_add(unsigned* p, unsigned v) { return __hip_atomic_fetch_add(p, v, __ATOMIC_RELAXED, __HIP_MEMORY_SCOPE_AGENT); }
__device__ __forceinline__ unsigned xb_xcc_id() { return (unsigned)__builtin_amdgcn_s_getreg((3 << 11) | 20) & 0xFu; }
#define XB_SPIN(cond, bar) do { unsigned _sp = 0; while (cond) { __builtin_amdgcn_s_sleep(1); \
    if ((++_sp & 255u) == 0u) { if (xb_ld(&(bar)[XB_TMO])) break; if (_sp > XB_SPIN_CAP) { atomicAdd(&(bar)[XB_TMO], 1u); break; } } } } while (0)

struct XcdBarrier {
    unsigned* bar; unsigned x;
    volatile LAS unsigned* st;
};

__device__ __forceinline__ XcdBarrier xcd_barrier_post(unsigned* bar, volatile LAS unsigned* st, int wave) {
    XcdBarrier b; b.bar = bar; b.x = xb_xcc_id(); b.st = st;
    if (XB_TID == 0) (void)xb_add(&bar[XB_XCNT(b.x)], 1u);
    return b;
}
__device__ __forceinline__ void xcd_barrier_complete(unsigned* bar, unsigned x, unsigned& nloc, unsigned& nx) {
    const unsigned G = gridDim.x * gridDim.y * gridDim.z;
    unsigned sum, cnt, mine, sp = 0u;
    for (;;) {
        sum = 0u; cnt = 0u; mine = 0u;
#pragma unroll
        for (unsigned j = 0; j < 16; ++j) { const unsigned c = xb_ld(&bar[XB_XCNT(j)]); sum += c; cnt += (c > 0u) ? 1u : 0u; mine = (j == x) ? c : mine; }
        if (sum == G) break;
        __builtin_amdgcn_s_sleep(1);
        if ((++sp & 255u) == 0u) { if (xb_ld(&bar[XB_TMO])) break; if (sp > XB_SPIN_CAP) { atomicAdd(&bar[XB_TMO], 1u); break; } }
    }
    nloc = mine > 0u ? mine : 1u; nx = cnt > 0u ? cnt : 1u;
}

__device__ __forceinline__ void xcd_barrier(const XcdBarrier& b, int wave) {
    asm volatile("s_waitcnt vmcnt(0)" ::: "memory");
    __syncthreads();
    if (XB_TID == 0) {
        unsigned* bar = b.bar;
        __builtin_amdgcn_s_waitcnt(0);
        unsigned nloc = b.st[0], nx = b.st[1];
        if (nloc == 0u) { xcd_barrier_complete(bar, b.x, nloc, nx); b.st[0] = nloc; b.st[1] = nx; }
        const unsigned old = xb_add(&bar[XB_XSUB(b.x)], 1u);
        const unsigned gen = old / nloc;
        if (old + 1u == (gen + 1u) * nloc) {
            __builtin_amdgcn_fence(__ATOMIC_RELEASE, "agent");
            asm volatile("s_waitcnt vmcnt(0)" ::: "memory");
            const unsigned og = xb_add(&bar[XB_TOP], 1u);
            const unsigned tg = og / nx;
            if (og + 1u == (tg + 1u) * nx) xb_add(&bar[XB_TOPGEN], 1u);
            else XB_SPIN(xb_ld(&bar[XB_TOPGEN]) == tg, bar);
            __builtin_amdgcn_fence(__ATOMIC_ACQUIRE, "agent");
            xb_add(&bar[XB_XGEN(b.x)], 1u);
            asm volatile("s_waitcnt vmcnt(0)" ::: "memory");
        } else {
            XB_SPIN(xb_ld(&bar[XB_XGEN(b.x)]) == gen, bar);
            __builtin_amdgcn_fence(__ATOMIC_ACQUIRE, "agent");
            asm volatile("s_waitcnt vmcnt(0)" ::: "memory");
        }
    }
    __syncthreads();
}

struct Args { const float* in[23]; float* out; unsigned char* ws; int ph_lo, ph_hi; };

__device__ __forceinline__ void panel_wait(unsigned* cnt, unsigned target, unsigned* bar, int wave) {
    asm volatile("" : "+s"(wave));
#ifndef MK_EARLYINV
#define MK_EARLYINV 0
#endif
    if (wave == 0) {
        unsigned sp = 0u;
#if MK_EARLYINV
        asm volatile("buffer_inv sc1" ::: "memory");
#endif
        while ((unsigned)__builtin_amdgcn_readfirstlane((int)__hip_atomic_load(cnt, __ATOMIC_RELAXED, __HIP_MEMORY_SCOPE_AGENT)) < target) {
            __builtin_amdgcn_s_sleep(1);
            if ((++sp & 255u) == 0u) { if (xb_ld(&bar[XB_TMO])) break; if (sp > XB_SPIN_CAP) { atomicAdd(&bar[XB_TMO], 1u); break; } }
        }
#if !MK_EARLYINV
        __builtin_amdgcn_fence(__ATOMIC_ACQUIRE, "agent");
#endif
        asm volatile("s_waitcnt vmcnt(0)" ::: "memory");
    }
    __syncthreads();
}

#ifndef MK_ASMST
#define MK_ASMST 1
#endif
#if MK_ASMST == 2
__device__ __forceinline__ void st_wt16(void* p, v4u v) { asm volatile("global_store_dwordx4 %0, %1, off\n\ts_nop 1" :: "v"(p), "v"(v) : "memory"); }
#elif MK_ASMST
__device__ __forceinline__ void st_wt16(void* p, v4u v) { asm volatile("global_store_dwordx4 %0, %1, off sc1\n\ts_nop 1" :: "v"(p), "v"(v) : "memory"); }
#else
__device__ __forceinline__ void st_wt16(void* p, v4u v) { *(v4u*)p = v; }
#endif
__device__ __forceinline__ void st_wt16_nt(void* p, v4u v) { asm volatile("global_store_dwordx4 %0, %1, off sc1 nt\n\ts_nop 1" :: "v"(p), "v"(v) : "memory"); }
__device__ __forceinline__ void st_wt4(void* p, unsigned v) { __hip_atomic_store((unsigned*)p, v, __ATOMIC_RELAXED, __HIP_MEMORY_SCOPE_AGENT); }
__device__ __forceinline__ void cnt_arrive(unsigned* cnt, int lane, int wave) {
    asm volatile("s_waitcnt vmcnt(0)" : "+s"(cnt), "+s"(wave) :: "memory");
    __syncthreads();
    if (wave == 0 && lane == 0) __hip_atomic_fetch_add(cnt, 1u, __ATOMIC_RELAXED, __HIP_MEMORY_SCOPE_AGENT);
}
struct TrD { const float* src; bf16* dst; const float* scale; int ld, K, n0, k0, drow0; };
__device__ __forceinline__ void tr_ld(const TrD& d, f32x4 (&v)[16], int lane) {
    asm volatile("" : "+v"(lane));
    const int kr = lane >> 4, n4 = lane & 15;
#pragma unroll
    for (int i = 0; i < 16; ++i) v[i] = __builtin_nontemporal_load((const f32x4*)(d.src + (size_t)(d.k0 + 4 * i + kr) * d.ld + d.n0 + 4 * n4));
}
template <bool WT>
__device__ __forceinline__ void tr_fin(const TrD& d, const f32x4 (&v)[16], LAS float* scr, int lane) {
    asm volatile("" : "+v"(lane));
    const int kr = lane >> 4, n4 = lane & 15; const int K = d.K, k0 = d.k0;
#pragma unroll
    for (int i = 0; i < 16; ++i) { LAS float* p = scr + (4 * i + kr) * 65 + 4 * n4; p[0] = v[i][0]; p[1] = v[i][1]; p[2] = v[i][2]; p[3] = v[i][3]; }
    LDS_WAIT(); asm volatile("" ::: "memory");
    const int c = lane & 7, nn = lane >> 3;
    f32x4 s0 = (f32x4){1.f, 1.f, 1.f, 1.f}, s1 = s0;
    if (d.scale) { s0 = *(const f32x4*)(d.scale + k0 + 8 * c); s1 = *(const f32x4*)(d.scale + k0 + 8 * c + 4); }
#pragma unroll
    for (int j = 0; j < 8; ++j) { const int n = nn + 8 * j; const LAS float* s = scr + (8 * c) * 65 + n;
        v4u o; o.x = pk2(s[0 * 65] * s0[0], s[1 * 65] * s0[1]); o.y = pk2(s[2 * 65] * s0[2], s[3 * 65] * s0[3]); o.z = pk2(s[4 * 65] * s1[0], s[5 * 65] * s1[1]); o.w = pk2(s[6 * 65] * s1[2], s[7 * 65] * s1[3]);
#ifndef MK_TAILFENCE
#define MK_TAILFENCE 0
#endif
        if (WT && !MK_TAILFENCE) st_wt16(d.dst + (size_t)(d.drow0 + n) * K + k0 + 8 * c, o); else __builtin_nontemporal_store(o, (v4u*)(d.dst + (size_t)(d.drow0 + n) * K + k0 + 8 * c)); }
    LDS_WAIT(); asm volatile("" ::: "memory");
}
template <bool WT>
__device__ __forceinline__ void tr_item(const float* __restrict__ src, int ld, int K, bf16* __restrict__ dst, const float* __restrict__ scale, int n0, int k0, int drow0, LAS float* scr, int lane) {
    const TrD d{src, dst, scale, ld, K, n0, k0, drow0}; f32x4 v[16]; tr_ld(d, v, lane); tr_fin<WT>(d, v, scr, lane);
}
template <bool WT = false, bool DESC = false>
__device__ __forceinline__ void tr_job(const float* src, int ld, int K, int N, bf16* dst, const float* scale, int ilv, int r, LAS float* scr, int lane, TrD* out = nullptr) {
#ifdef MK_CV18
    const int nb = N / 64, sb = r >> 3, j8 = r & 7; const bool k8 = ((K >> 6) & 7) == 0;
    const int kb = k8 ? (sb / nb) * 8 + j8 : (sb / (nb >> 1)) * 4 + (j8 >> 1), nbi = k8 ? sb % nb : (sb % (nb >> 1)) * 2 + (j8 & 1), n0 = nbi * 64;
#else
    const int nb = N / 64, sb = r >> 3, j8 = r & 7, kb = (sb / (nb >> 1)) * 4 + (j8 >> 1), nbi = (sb % (nb >> 1)) * 2 + (j8 & 1), n0 = nbi * 64;
#endif
    int drow0 = n0;
    if (ilv) { const int hsel = n0 >= ilv ? 1 : 0, nn = n0 - hsel * ilv; drow0 = (nn >> 7) * 256 + hsel * 128 + (nn & 127); }
    if (DESC) *out = TrD{src, dst, scale, ld, K, n0, kb * 64, drow0}; else tr_item<WT>(src, ld, K, dst, scale, n0, kb * 64, drow0, scr, lane);
}

__device__ __forceinline__ void s5_ops_group(const Args& a, int g, LAS float* L, int tid) {
    const float* a_re = a.in[14]; const float* a_im = a.in[15]; const float* log_dt = a.in[16]; const float* b_re = a.in[17]; const float* b_im = a.in[18];
    const float* c_re = a.in[19]; const float* c_im = a.in[20]; const float* dsk = a.in[21];
    LAS float* apr = L; LAS float* api = L + 2112; LAS float* qr = L + 4224; LAS float* qi = qr + 64; LAS float* Cr = qi + 64; LAS float* Ci = Cr + 1024;
    LAS float* Br = Ci + 1024; LAS float* Bi = Br + 1024; LAS float* Kt = Bi + 1024;
    bf16* TV = (bf16*)(a.ws + WS_S5TV) + (size_t)g * 512 * 640; bf16* W = (bf16*)(a.ws + WS_S5W) + (size_t)g * 256 * 512;
    const float dt = expf(log_dt[g]);
    for (int idx = tid; idx < 33 * 64; idx += 512) { const int tau = idx >> 6, p = idx & 63; const float ar = a_re[g * 64 + p], ai = a_im[g * 64 + p];
        const float mag = expf(ar * dt * (float)tau); float sn, cs; sincosf(ai * dt * (float)tau, &sn, &cs); apr[idx] = mag * cs; api[idx] = mag * sn; }
    if (tid < 64) { const float ar = a_re[g * 64 + tid], ai = a_im[g * 64 + tid]; const float er = expf(ar * dt); float sn, cs; sincosf(ai * dt, &sn, &cs);
        const float nr = er * cs - 1.f, ni = er * sn, den = ar * ar + ai * ai; qr[tid] = (nr * ar + ni * ai) / den; qi[tid] = (ni * ar - nr * ai) / den; }
    for (int idx = tid; idx < 1024; idx += 512) { Cr[idx] = c_re[(size_t)g * 1024 + idx]; Ci[idx] = c_im[(size_t)g * 1024 + idx]; }
    __syncthreads();
    for (int idx = tid; idx < 1024; idx += 512) { const int p = idx >> 4; const float br = b_re[(size_t)g * 1024 + idx], bi = b_im[(size_t)g * 1024 + idx];
        Br[idx] = qr[p] * br - qi[p] * bi; Bi[idx] = qr[p] * bi + qi[p] * br; }
    __syncthreads();
    for (int idx = tid; idx < 32 * 256; idx += 512) { const int tau = idx >> 8, c = (idx >> 4) & 15, cp = idx & 15; float s = 0.f;
        for (int p = 0; p < 64; ++p) { const float ar_ = apr[tau * 64 + p], ai_ = api[tau * 64 + p], br = Br[p * 16 + cp], bi = Bi[p * 16 + cp];
            const float xr = ar_ * br - ai_ * bi, xi = ar_ * bi + ai_ * br; s += Cr[c * 64 + p] * xr - Ci[c * 64 + p] * xi; }
        if (tau == 0 && c == cp) s += dsk[g * 16 + c];
        Kt[idx] = s; }
    __syncthreads();
    for (int idx = tid; idx < 512 * 80; idx += 512) { const int n = idx / 80, ch = idx % 80, j = n >> 4, c = n & 15; float o[8];
        if (ch < 64) { const int jp = ch >> 1, c0 = (ch & 1) * 8;
#pragma unroll
            for (int e = 0; e < 8; ++e) o[e] = (jp <= j) ? Kt[(j - jp) * 256 + c * 16 + c0 + e] : 0.f; }
        else { const int p0 = (ch - 64) * 4;
#pragma unroll
            for (int e = 0; e < 4; ++e) { const int p = p0 + e; const float ar_ = apr[(j + 1) * 64 + p], ai_ = api[(j + 1) * 64 + p], cr = Cr[c * 64 + p], ci = Ci[c * 64 + p];
                o[2 * e] = cr * ar_ - ci * ai_; o[2 * e + 1] = -(cr * ai_ + ci * ar_); } }
        v4u w; w.x = pk2(o[0], o[1]); w.y = pk2(o[2], o[3]); w.z = pk2(o[4], o[5]); w.w = pk2(o[6], o[7]);
        *(v4u*)(TV + (size_t)n * 640 + ch * 8) = w; }
    for (int idx = tid; idx < 128 * 64; idx += 512) { const int n = idx >> 6, ch = idx & 63, p = n >> 1, ri = n & 1, jp = ch >> 1, c0 = (ch & 1) * 8; float o[8];
        const float ar_ = apr[(31 - jp) * 64 + p], ai_ = api[(31 - jp) * 64 + p];
#pragma unroll
        for (int e = 0; e < 8; ++e) { const float br = Br[p * 16 + c0 + e], bi = Bi[p * 16 + c0 + e]; o[e] = ri ? (ar_ * bi + ai_ * br) : (ar_ * br - ai_ * bi); }
        v4u w; w.x = pk2(o[0], o[1]); w.y = pk2(o[2], o[3]); w.z = pk2(o[4], o[5]); w.w = pk2(o[6], o[7]);
        *(v4u*)(W + (size_t)n * 512 + ch * 8) = w; }
    __syncthreads();
}

namespace cv {
constexpr int I_FI = 32 * 176, I_FO = 88 * 32, I_PG = 32 * 32, I_QKV = 32 * 96, I_WO = 32 * 32, I_S5I = 32 * 32, I_GLU = 32 * 64, I_WF = 16;
constexpr int mix_items(int L) { return (L % 3 == 0) ? I_QKV + I_WO + I_WF : ((L % 3 == 1) ? I_QKV + I_WO : I_S5I + I_GLU); }
constexpr int layer_items(int L) { return 2 * I_FI + 2 * I_FO + I_PG + mix_items(L); }
constexpr int layer_start(int L) { int s = 0; for (int l = 0; l < L; ++l) s += layer_items(l); return s; }
constexpr int TOTAL = layer_start(4);
constexpr int pos_after(int L, int h) { return layer_start(L) + I_FI + (h ? I_FO + mix_items(L) + I_FI : 0); }
#ifndef MK_TAILQ
#define MK_TAILQ 7
#endif
constexpr int TAIL_WAVES = 128 * NWAVES, QTOT = MK_TAILQ * TAIL_WAVES;
constexpr int tail_b(int k) { int hi = TOTAL; for (int j = 7; j > k; --j) { const int pa = pos_after(j >> 1, j & 1); const int a = (hi - QTOT > pa) ? hi - QTOT : pa; hi = a < hi ? a : hi; } return hi; }
constexpr int tail_a(int k) { const int hi = tail_b(k), pa = pos_after(k >> 1, k & 1); const int a = (hi - QTOT > pa) ? hi - QTOT : pa; return a < hi ? a : hi; }
}
template <bool WT = false, bool DESC = false>
__device__ __forceinline__ bool cv_item(const Args& a, int idx, LAS float* scr, int lane, TrD* out = nullptr) {
    using namespace cv;
    const float* norm_g = a.in[2]; unsigned char* ws = a.ws;
    const int L = idx >= layer_start(3) ? 3 : (idx >= layer_start(2) ? 2 : (idx >= layer_start(1) ? 1 : 0));
    int r = idx - (L == 3 ? layer_start(3) : (L == 2 ? layer_start(2) : (L == 1 ? layer_start(1) : 0)));
    const int kind = L % 3, mixn = kind == 0 ? I_QKV + I_WO + I_WF : (kind == 1 ? I_QKV + I_WO : I_S5I + I_GLU);
    int half = 0;
    if (r >= I_FI + I_FO + mixn) { r -= I_FI + I_FO + mixn; half = 1; if (r >= I_FI + I_FO) {
            r -= I_FI + I_FO; tr_job<WT, DESC>(a.in[6] + (size_t)L * DM * DM, DM, DM, DM, (bf16*)(ws + WS_WPG) + (size_t)L * DM * DM, norm_g + (L * 4 + 3) * DM, 0, r, scr, lane, out); return true; } }
    else if (r >= I_FI + I_FO) { r -= I_FI + I_FO;
        if (kind < 2) { const int m = L == 0 ? 0 : (L == 1 ? 1 : 2);
            if (kind == 0) { if (r >= I_WF) r -= I_WF; else { if (DESC) return false;
                const int j = m >> 1, hd = r; const float* src = a.in[8] + (size_t)j * DM * (3 * DM + NH) + 3 * DM + hd; const float* g1 = norm_g + (L * 4 + 1) * DM;
                bf16* dst = (bf16*)(ws + WS_WFT) + (size_t)j * 2 * 16 * DM + (size_t)hd * DM;
                for (int k = 2 * lane; k < DM; k += 128) { const float w0 = g1[k] * src[(size_t)k * (3 * DM + NH)], w1 = g1[k + 1] * src[(size_t)(k + 1) * (3 * DM + NH)];
                    const unsigned h0 = f2bf(w0), h1 = f2bf(w1); const unsigned l0 = f2bf(w0 - __uint_as_float(h0 << 16)), l1 = f2bf(w1 - __uint_as_float(h1 << 16));
                    st_wt4(dst + k, h0 | (h1 << 16)); st_wt4(dst + 16 * DM + k, l0 | (l1 << 16)); }
                return true; } }
            if (r < I_QKV) { const float* src = m == 1 ? a.in[11] : a.in[8] + (size_t)(m >> 1) * DM * (3 * DM + NH); const int ld = m == 1 ? 3 * DM : 3 * DM + NH;
                tr_job<WT, DESC>(src, ld, DM, 3 * DM, (bf16*)(ws + WS_WQKV) + (size_t)m * 3 * DM * DM, norm_g + (L * 4 + 1) * DM, 0, r, scr, lane, out); return true; } r -= I_QKV;
            if (r < I_WO) { const float* src = m == 1 ? a.in[12] : a.in[10] + (size_t)(m >> 1) * DM * DM;
                tr_job<WT, DESC>(src, DM, DM, DM, (bf16*)(ws + WS_WO) + (size_t)m * DM * DM, nullptr, 0, r, scr, lane, out); return true; } }
        if (r < I_S5I) { tr_job<WT, DESC>(a.in[13], DM, DM, DM, (bf16*)(ws + WS_WS5I), norm_g + (2 * 4 + 1) * DM, 0, r, scr, lane, out); return true; } r -= I_S5I;
        tr_job<WT, DESC>(a.in[22], 2 * DM, DM, 2 * DM, (bf16*)(ws + WS_WGLU), nullptr, DM, r, scr, lane, out); return true; }
    const int m = L * 2 + half;
    if (r < I_FI) { tr_job<WT, DESC>(a.in[4] + (size_t)m * DM * 2 * FF, 2 * FF, DM, 2 * FF, (bf16*)(ws + WS_WFI) + (size_t)m * 2 * FF * DM, norm_g + (L * 4 + half * 2) * DM, FF, r, scr, lane, out); return true; }
    r -= I_FI;
    tr_job<WT, DESC>(a.in[5] + (size_t)m * FF * DM, DM, FF, DM, (bf16*)(ws + WS_WFO) + (size_t)m * DM * FF, nullptr, 0, r, scr, lane, out); return true;
}
#ifndef MK_CVPIPE
#define MK_CVPIPE 0
#endif
template <bool WT>
__device__ __forceinline__ void cv_range(const Args& a, int it, int hi, int step, LAS float* scr, int lane) {
#if MK_CVPIPE
    if (WT && MK_CVPIPE < 2) { for (; it < hi; it += step) cv_item<WT>(a, it, scr, lane); return; }
    if (it >= hi) return;
    TrD dc; f32x4 vc[16]; bool wfc = !cv_item<WT, true>(a, it, scr, lane, &dc);
    if (!wfc) tr_ld(dc, vc, lane);
    for (;;) {
        const int nx = it + step; const bool hn = nx < hi; TrD dn = dc; f32x4 vn[16]; bool wfn = false;
        if (hn) { wfn = !cv_item<WT, true>(a, nx, scr, lane, &dn); if (!wfn) tr_ld(dn, vn, lane); }
        if (wfc) cv_item<WT, false>(a, it, scr, lane); else tr_fin<WT>(dc, vc, scr, lane);
        if (!hn) break;
        dc = dn; wfc = wfn; it = nx;
#pragma unroll
        for (int i = 0; i < 16; ++i) vc[i] = vn[i];
    }
#else
    for (; it < hi; it += step) cv_item<WT>(a, it, scr, lane);
#endif
}
__device__ __forceinline__ void cv_tail(const Args& a, int k, LAS unsigned char* lds, int lane, int wave, int bx, int G) {
    if (G != 256 || bx < 128) return;
    int lo_ = 0, hi_ = 0;
    switch (k) { case 0: lo_ = cv::tail_a(0); hi_ = cv::tail_b(0); break; case 1: lo_ = cv::tail_a(1); hi_ = cv::tail_b(1); break; case 2: lo_ = cv::tail_a(2); hi_ = cv::tail_b(2); break;
                 case 3: lo_ = cv::tail_a(3); hi_ = cv::tail_b(3); break; case 4: lo_ = cv::tail_a(4); hi_ = cv::tail_b(4); break; case 5: lo_ = cv::tail_a(5); hi_ = cv::tail_b(5); break;
                 case 6: lo_ = cv::tail_a(6); hi_ = cv::tail_b(6); break; default: lo_ = cv::tail_a(7); hi_ = cv::tail_b(7); break; }
    LAS float* scr = (LAS float*)(lds + wave * 16640);
    cv_range<true>(a, lo_ + (bx - 128) * NWAVES + wave, hi_, cv::TAIL_WAVES, scr, lane);
#if MK_TAILFENCE
    { unsigned* cnt_ = (unsigned*)(a.ws + WS_CTL) + CW_TAIL + 32 * k; int w_ = wave; asm volatile("s_waitcnt vmcnt(0)" : "+s"(cnt_), "+s"(w_) :: "memory"); __syncthreads();
      if (w_ == 0) { __builtin_amdgcn_fence(__ATOMIC_RELEASE, "agent"); asm volatile("s_waitcnt vmcnt(0)" ::: "memory"); if (lane == 0) __hip_atomic_fetch_add(cnt_, 1u, __ATOMIC_RELAXED, __HIP_MEMORY_SCOPE_AGENT); } }
#else
    cnt_arrive((unsigned*)(a.ws + WS_CTL) + CW_TAIL + 32 * k, lane, wave);
#endif
}
__device__ __forceinline__ void moba_bias_phase(float* bias, int lane, int gw, int NGW) {
    for (int task = gw; task < 64 * 8; task += NGW) { const int bh = task >> 3, s0 = (task & 7) * 256 + 4 * lane;
        const float sl = exp2f(-0.5f * (float)((bh & 15) + 1)) * (1.0f / att::SCALE);
        *(f32x4*)(bias + (size_t)bh * SEQ + s0) = (f32x4){sl * (float)s0, sl * (float)(s0 + 1), sl * (float)(s0 + 2), sl * (float)(s0 + 3)}; }
}
__device__ __forceinline__ void p0_prologue(const Args& a, LAS unsigned char* lds, int tid, int lane, int wave, int vcu, int G) {
    const float* x = a.in[0]; const float* p = a.in[1];
    unsigned char* ws = a.ws;
    for (int g = vcu; g < 128; g += G) s5_ops_group(a, g, (LAS float*)lds, tid);
    moba_bias_phase((float*)(ws + WS_BIAS), lane, vcu * NWAVES + wave, G * NWAVES);
    LAS float* scr = (LAS float*)(lds + wave * 16640);
    const int gw = vcu * NWAVES + wave, NGW = G * NWAVES;
    constexpr int I_PPJ = 4 * 32, I_X = M, I_P = 4 * M * PLE / 512;
    const int n_cv = (G == 256) ? cv::tail_a(0) : cv::TOTAL;
    const int NITEMS = n_cv + 4 * I_PPJ + I_X + I_P;
#ifndef MK_PROWT
#define MK_PROWT 0
#endif
    constexpr bool PROWT = MK_PROWT != 0;
#ifndef MK_S5SKIP
#define MK_S5SKIP 3
#endif
    if (G == 256 && MK_S5SKIP > 0 && n_cv > 2048 * MK_S5SKIP) {
        if (vcu >= 128) cv_range<PROWT>(a, gw - 1024, 2048 * MK_S5SKIP, 1024, scr, lane);
        cv_range<PROWT>(a, 2048 * MK_S5SKIP + gw, n_cv, NGW, scr, lane);
    } else cv_range<PROWT>(a, gw, n_cv, NGW, scr, lane);
    for (int it = gw + ((n_cv - gw + NGW - 1) / NGW) * NGW; it < NITEMS; it += NGW) {
        int r = it - n_cv;
        if (r < 4 * I_PPJ) { const int m = r / I_PPJ;
            tr_job(a.in[7] + (size_t)m * PLE * DM, DM, PLE, DM, (bf16*)(ws + WS_WPP) + (size_t)m * DM * PLE, nullptr, 0, r % I_PPJ, scr, lane); continue; } r -= 4 * I_PPJ;
        if (r < I_X) {
            const f32x4* xr = (const f32x4*)(x + (size_t)r * DM) + lane; f32x4 v[8]; float s = 0.f;
#pragma unroll
            for (int j = 0; j < 8; ++j) { v[j] = xr[64 * j]; s += (v[j][0] * v[j][0] + v[j][1] * v[j][1]) + (v[j][2] * v[j][2] + v[j][3] * v[j][3]); }
            s = wave_sum(s);
            v2u* o = (v2u*)((bf16*)(ws + WS_HB) + (size_t)r * DM) + lane;
#pragma unroll
            for (int j = 0; j < 8; ++j) { v2u w; w.x = pk2(v[j][0], v[j][1]); w.y = pk2(v[j][2], v[j][3]); o[64 * j] = w; }
            if (lane < 4) ((f32x4*)((float*)(ws + WS_SSQ) + (size_t)r * 16))[lane] = (f32x4){lane == 0 ? s : 0.f, 0.f, 0.f, 0.f};
            continue; } r -= I_X;
        {
            const f32x4* src = (const f32x4*)(p + (size_t)r * 512) + 2 * lane; const f32x4 v0 = src[0], v1 = src[1];
            v4u w; w.x = pk2(v0[0], v0[1]); w.y = pk2(v0[2], v0[3]); w.z = pk2(v1[0], v1[1]); w.w = pk2(v1[2], v1[3]);
            ((v4u*)((bf16*)(ws + WS_PBF) + (size_t)r * 512))[lane] = w; }
    }
}

__device__ __forceinline__ void fox_gate_phase(const bf16* Hb, const bf16* WfB, const float* bfv, const float* ssq, int np, float* logf, LAS unsigned char* lds, int lane, int wave, int bx, int G) {
    typedef short bf16x8_t __attribute__((ext_vector_type(8)));
    asm volatile("" : "+s"(bx), "+s"(wave));
    const int kq = wave & 3, kg = lane >> 4;
    LAS f32x4* pl = (LAS f32x4*)lds + (wave & 4) * 64 + lane;
    for (int t = (G == 256) ? 0 : bx; t < ((G == 256) ? 1 : M / 32); t += G) {
        const int rb = (G == 256) ? (4 * (bx & 7) + ((bx >> 3) & 3)) * 16 + 2 * (bx >> 5) + (wave >> 2) : 2 * t + (wave >> 2);
        const int row = rb * 16 + (lane & 15);
        const v4u* ap = (const v4u*)(Hb + (size_t)row * DM + kq * 512 + kg * 8); const v4u* bh = (const v4u*)(WfB + (size_t)(lane & 15) * DM + kq * 512 + kg * 8); const v4u* bl = bh + 16 * DM / 8;
        f32x4 acc = (f32x4){0.f, 0.f, 0.f, 0.f};
#pragma unroll 8
        for (int s = 0; s < 16; ++s) { const v4u a = ap[4 * s], h = bh[4 * s], l = bl[4 * s];
            acc = __builtin_amdgcn_mfma_f32_16x16x32_bf16(__builtin_bit_cast(bf16x8_t, h), __builtin_bit_cast(bf16x8_t, a), acc, 0, 0, 0);
            acc = __builtin_amdgcn_mfma_f32_16x16x32_bf16(__builtin_bit_cast(bf16x8_t, l), __builtin_bit_cast(bf16x8_t, a), acc, 0, 0, 0); }
        pl[kq * 64] = acc;
        __syncthreads();
        if (kq == 0) {
            acc = (pl[0] + pl[64]) + (pl[128] + pl[192]);
            const f32x4* sp = (const f32x4*)(ssq + (size_t)row * 16); f32x4 s4 = sp[0] + sp[1]; if (np > 8) s4 += sp[2] + sp[3];
            const float rstd = 1.0f / sqrtf(((s4[0] + s4[1]) + (s4[2] + s4[3])) * (1.0f / DM) + 1e-6f);
            const int b = row >> 11, tt = row & 2047;
#pragma unroll
            for (int i = 0; i < 4; ++i) { const int hd = 4 * kg + i; const float xg = acc[i] * rstd + bfv[hd];
                st_wt4(logf + (size_t)(b * 16 + hd) * SEQ + tt, __float_as_uint(fminf(xg, 0.f) - __logf(1.0f + __expf(-fabsf(xg)))));
            }
        }
        __syncthreads();
    }
}
__device__ __forceinline__ void moba_kmean_phase(const bf16* Kh, float* km, int lane, int gw, int NGW) {
    for (int task = gw; task < 2048; task += NGW) {
        const int rg = lane >> 4, ch = lane & 15; const bf16* base = Kh + ((size_t)task * 64 + rg) * HD + ch * 8; float s[8] = {0.f, 0.f, 0.f, 0.f, 0.f, 0.f, 0.f, 0.f};
        v4u w[16];
#pragma unroll
        for (int i = 0; i < 16; ++i) w[i] = *(const v4u*)(base + (size_t)i * 4 * HD);
#pragma unroll
        for (int i = 0; i < 16; ++i) {
            s[0] += __uint_as_float(w[i].x << 16); s[1] += __uint_as_float(w[i].x & 0xffff0000u); s[2] += __uint_as_float(w[i].y << 16); s[3] += __uint_as_float(w[i].y & 0xffff0000u);
            s[4] += __uint_as_float(w[i].z << 16); s[5] += __uint_as_float(w[i].z & 0xffff0000u); s[6] += __uint_as_float(w[i].w << 16); s[7] += __uint_as_float(w[i].w & 0xffff0000u); }
#pragma unroll
        for (int e = 0; e < 8; ++e) { s[e] += __shfl_xor(s[e], 16); s[e] += __shfl_xor(s[e], 32); }
        if (rg == 0) { float* o = km + (size_t)task * HD + ch * 8;
            st_wt16(o, __builtin_bit_cast(v4u, (f32x4){s[0], s[1], s[2], s[3]} * (1.f / 256.f))); st_wt16(o + 4, __builtin_bit_cast(v4u, (f32x4){s[4], s[5], s[6], s[7]} * (1.f / 256.f))); }
    }
}
__device__ __forceinline__ void moba_select_phase(const bf16* Qh, const float* km, unsigned* sel, LAS unsigned char* lds, int lane, int wave, int gw, int NGW) {
    LAS float* kl = (LAS float*)(lds + wave * 4096);
    for (int task = gw; task < 64 * 32; task += NGW) {
        const int bh = task >> 5, t0 = (task & 31) * 64, own = t0 >> 8;
        const bf16* qrow = Qh + ((size_t)bh * SEQ + t0 + lane) * HD; const float* kmb = km + (size_t)bh * 8 * 4 * HD;
#pragma unroll
        for (int n = 0; n < 7; ++n) if (n < own) { const float* kq = kmb + (size_t)n * 4 * HD + 2 * lane;
            *(LAS f32x2*)(kl + n * HD + 2 * lane) = (*(const f32x2*)kq + *(const f32x2*)(kq + HD)) + (*(const f32x2*)(kq + 2 * HD) + *(const f32x2*)(kq + 3 * HD)); }
        LDS_WAIT(); asm volatile("" ::: "memory");
        float gt[8];
#pragma unroll
        for (int n = 0; n < 8; ++n) gt[n] = 0.f;
#pragma unroll 2
        for (int c = 0; c < 16; ++c) { const v4u w = *(const v4u*)(qrow + c * 8); float q[8];
            q[0] = __uint_as_float(w.x << 16); q[1] = __uint_as_float(w.x & 0xffff0000u); q[2] = __uint_as_float(w.y << 16); q[3] = __uint_as_float(w.y & 0xffff0000u);
            q[4] = __uint_as_float(w.z << 16); q[5] = __uint_as_float(w.z & 0xffff0000u); q[6] = __uint_as_float(w.w << 16); q[7] = __uint_as_float(w.w & 0xffff0000u);
#pragma unroll
            for (int n = 0; n < 7; ++n) if (n < own) { const f32x4 k0 = *(const LAS f32x4*)(kl + n * HD + c * 8), k1 = *(const LAS f32x4*)(kl + n * HD + c * 8 + 4);
#pragma unroll
                for (int j = 0; j < 4; ++j) { gt[n] = fmaf(q[j], k0[j], gt[n]); gt[n] = fmaf(q[4 + j], k1[j], gt[n]); } } }
        unsigned m = 0u;
#pragma unroll
        for (int r = 0; r < 3; ++r) { int best = -1; float bv = -__builtin_inff();
#pragma unroll
            for (int n = 0; n < 7; ++n) if (n < own && !((m >> n) & 1u) && gt[n] > bv) { bv = gt[n]; best = n; }
            if (best >= 0) m |= 1u << best; }
        st_wt4(sel + (size_t)bh * SEQ + t0 + lane, m);
        LDS_WAIT(); asm volatile("" ::: "memory");
    }
}
__device__ __forceinline__ void s5_scan_phase(const Args& a, int lane, int task0, int tstep) {
    const float* a_re = a.in[14]; const float* a_im = a.in[15]; const float* log_dt = a.in[16];
    const float* Hl = (const float*)(a.ws + WS_HLOC); bf16* UH = (bf16*)(a.ws + WS_UH);
    for (int task = task0; task < 512; task += tstep) {
        const int g = task >> 2, b = task & 3, p = lane; const float dt = expf(log_dt[g]);
        const float mag = expf(a_re[g * 64 + p] * dt * 32.f); float sn, cs; sincosf(a_im[g * 64 + p] * dt * 32.f, &sn, &cs); const float ar = mag * cs, ai = mag * sn;
        float hr = 0.f, hi = 0.f;
#pragma unroll 8
        for (int k = 0; k < 64; ++k) { const size_t row = (size_t)g * 256 + b * 64 + k;
            *(unsigned*)(UH + row * 640 + 512 + 2 * p) = pk2(hr, hi);
            const f32x2 hl = *(const f32x2*)(Hl + row * 128 + 2 * p);
            const float nr = ar * hr - ai * hi + hl[0], ni = ar * hi + ai * hr + hl[1]; hr = nr; hi = ni; }
    }
}
__device__ __forceinline__ void final_norm_phase(const bf16* Hb, const float* ssq, const float* fg, float* out, int lane, int r0, int rend, int rstep) {
    for (int r = r0; r < rend; r += rstep) {
        const f32x4* sp = (const f32x4*)(ssq + (size_t)r * 16); const f32x4 s4 = sp[0] + sp[1];
        const float rstd = 1.0f / sqrtf(((s4[0] + s4[1]) + (s4[2] + s4[3])) * (1.0f / DM) + 1e-6f);
        const v4u* xr = (const v4u*)(Hb + (size_t)r * DM) + lane; const f32x4* gr = (const f32x4*)fg + 2 * lane; f32x4* o = (f32x4*)(out + (size_t)r * DM) + 2 * lane;
#pragma unroll
        for (int j = 0; j < 4; ++j) { const v4u w = xr[64 * j]; const f32x4 g0 = gr[128 * j], g1 = gr[128 * j + 1];
            f32x4 a, b; a[0] = __uint_as_float(w.x << 16); a[1] = __uint_as_float(w.x & 0xffff0000u); a[2] = __uint_as_float(w.y << 16); a[3] = __uint_as_float(w.y & 0xffff0000u);
            b[0] = __uint_as_float(w.z << 16); b[1] = __uint_as_float(w.z & 0xffff0000u); b[2] = __uint_as_float(w.w << 16); b[3] = __uint_as_float(w.w & 0xffff0000u);
            o[128 * j] = a * g0 * rstd; o[128 * j + 1] = b * g1 * rstd; }
    }
}
__device__ __forceinline__ int tail_a_rt(int k) {
    switch (k) { case 0: return cv::tail_a(0); case 1: return cv::tail_a(1); case 2: return cv::tail_a(2); case 3: return cv::tail_a(3); case 4: return cv::tail_a(4); case 5: return cv::tail_a(5);
                 case 6: return cv::tail_a(6); default: return cv::tail_a(7); }
}
__global__ void __launch_bounds__(NWAVES * 64, 2) mk_fwd(Args args) {
    extern __shared__ __attribute__((aligned(16))) unsigned char lds[];
    LAS unsigned char* L = (LAS unsigned char*)lds;
    volatile LAS unsigned* MISC = (volatile LAS unsigned*)(L + MISC_OFF);
    const int wave = __builtin_amdgcn_readfirstlane((int)threadIdx.x >> 6);
    const int tid = MK_TID();
#define TIDL() ({ int t_ = MK_TID(); asm volatile("" : "+v"(t_)); t_; })
    const int G = gridDim.x; const int bx = blockIdx.x; const int vcu = (G % 8 == 0) ? (bx % 8) * (G / 8) + bx / 8 : bx;
    const int gw = vcu * NWAVES + wave, NGW = G * NWAVES;
    unsigned char* ws = args.ws;
    unsigned* ctl = (unsigned*)(ws + WS_CTL);
    for (int u = tid; u < (LDS_BYTES - LDSCTL_OFF) / 4; u += NWAVES * 64) ((LAS unsigned*)(L + LDSCTL_OFF))[u] = 0u;
    __syncthreads();
    const int lo = args.ph_lo, hi = args.ph_hi;
    const bool single = (hi - lo) > 1;
    XcdBarrier bar; bar.bar = ctl + CW_BAR; bar.x = 0; bar.st = nullptr;
    if (single) bar = xcd_barrier_post(ctl + CW_BAR, MISC + 8, wave);
    int pc = 0;
#ifndef MK_SITES
#define MK_SITES 0xffffffu
#endif
#define SITE(n) (((MK_SITES >> (n)) & 1u) != 0u)
#define RUN() (pc >= lo && pc < hi)
#ifndef MK_REP_SITE
#define MK_REP_SITE -1
#endif
#ifndef MK_REP_N
#define MK_REP_N 1
#endif
#define REP(n) for (int rep_ = 0; rep_ < ((n) == MK_REP_SITE ? MK_REP_N : 1); ++rep_)
#ifndef MK_PANEL
#define MK_PANEL 1
#endif
    const bool pan = MK_PANEL && single && (G == 256);
    unsigned* const pcw = ctl + 1024 + 64 * (4 * (bx & 7) + ((bx >> 3) & 3));
    unsigned pdone = 0u; bool pw = false;
#define PCNT() ((pan && rep_ == 0) ? pcw : (unsigned*)nullptr)
#define PSEAM() do { if (pan) { pw = true; ++pc; } else SEAM(); } while (0)
#ifdef MK_BROKEN_NOWAIT
#define PWAIT() do { pw = false; } while (0)
#else
#define PWAIT() do { if (pw) { panel_wait(pcw, 8u * pdone, ctl + CW_BAR, wave); pw = false; } } while (0)
#endif
#ifdef MK_DBLBAR
#define SEAM() do { if (pc >= lo && pc + 1 < hi) { xcd_barrier(bar, wave); xcd_barrier(bar, wave); } ++pc; } while (0)
#else
#define SEAM() do { if (pc >= lo && pc + 1 < hi) xcd_barrier(bar, wave); ++pc; } while (0)
#endif
    unsigned* const bcw = ctl + CW_BATCH + 64 * ((bx & 7) >> 1);
    unsigned bdone = 0u;
    const int blw = (bx & 1) * 32 + (bx >> 3);
#ifndef MK_BATCH
#define MK_BATCH 1
#endif
    const bool bat = MK_BATCH && pan;
#ifndef MK_S5CNT
#define MK_S5CNT 0
#endif
    const bool s5c = MK_S5CNT && bat;
#define BCNT() ((bat && rep_ == 0) ? bcw : (unsigned*)nullptr)
#define BARRIVE() do { if (bat) cnt_arrive(bcw, TIDL() & 63, wave); } while (0)
#define BSEAM() do { if (bat) { ++bdone; panel_wait(bcw, 64u * bdone, ctl + CW_BAR, wave); ++pc; } else SEAM(); } while (0)
    const bool tails = (G == 256); int tw = 0, npos = 0;
#ifdef MK_TWGRID
#define TWAIT(n) do { npos += (n); if (tails) while (tw < 8 && tail_a_rt(tw) < npos) { xcd_barrier(bar, wave); ++tw; } } while (0)
#else
#define TWAIT(n) do { npos += (n); if (tails) while (tw < 8 && tail_a_rt(tw) < npos) { panel_wait(ctl + CW_TAIL + 32 * tw, 128u, ctl + CW_BAR, wave); ++tw; } } while (0)
#endif
#define ACT ((bf16*)(ws + WS_ACT))
#define QKV ((bf16*)(ws + WS_QKV))
#define OB ((bf16*)(ws + WS_OB))
#define PP ((bf16*)(ws + WS_PP))
#define LOGF ((float*)(ws + WS_LOGF))
#define KMEAN ((float*)(ws + WS_KMEAN))
#define UH ((bf16*)(ws + WS_UH))
#define HLOC ((float*)(ws + WS_HLOC))
#define YB ((bf16*)(ws + WS_YB))

    if (SITE(0) && RUN()) REP(0) { const int t = TIDL(); p0_prologue(args, L, t, t & 63, wave, vcu, G); }
    SEAM();
    if (SITE(1) && RUN()) REP(1) { pg8::Gemm g{(const bf16*)(ws + WS_PBF), (const bf16*)(ws + WS_WPP), PLE, PLE, PLE}; pg8::PpOrder S; S.init(G, bx);
        pg8::EpiBf16 E{PP, DM, nullptr, 0}; pg8::gemm_phase(L + RING_OFF, g, S, E, wave, (pan && rep_ == 0) ? ctl + CW_PP : (unsigned*)nullptr); }
    int np = 8, sel = 0;
#define HBR ((const bf16*)(ws + (sel ? WS_HB2 : WS_HB)))
#define HBW ((bf16*)(ws + (sel ? WS_HB : WS_HB2)))
#define SSQR ((const float*)(ws + WS_SSQ) + (sel ? M * 16 : 0))
#define SSQW ((float*)(ws + WS_SSQ) + (sel ? 0 : M * 16))
    for (int layer = 0; layer < DEPTH; ++layer) {
        const int kind = layer % 3;
        for (int half = 0; half < 2; ++half) {
#if defined(MK_EXP) && (MK_EXP == 1 || MK_EXP == 2 || MK_EXP == 3 || MK_EXP == 5 || MK_EXP == 6 || MK_EXP == 8 || MK_EXP == 9)
            if (RUN()) { pg8::Gemm g{HBR, (const bf16*)(ws + WS_WFI) + (size_t)(layer * 2 + half) * 2 * FF * DM, DM, DM, DM}; pg8::StaticOrder S; S.init(M, 2 * FF, G, bx);
#if MK_EXP == 2 || MK_EXP == 5 || MK_EXP == 6 || MK_EXP == 8 || MK_EXP == 9
                S.lim = 1280;
#endif
#if MK_EXP == 5
                S.pbmask = 3;
#endif
                pg8::EpiNone E{(float*)(ws + WS_CTL), (int)(lo > 1000000)};
#if MK_EXP == 3
                S.lim = 1280; pg8::gemm_phase<pg8::EpiNone, pg8::StaticOrder, true>(L + RING_OFF, g, S, E, wave); }
#elif MK_EXP == 8 || MK_EXP == 9
                { pg8::EpiStoreOnly E2{(bf16*)(ws + WS_H)}; pg8::gemm_phase(L + RING_OFF, g, S, E2, wave); } }
#elif MK_EXP == 6
                pg8::gemm_phase<pg8::EpiNone, pg8::StaticOrder, false, true>(L + RING_OFF, g, S, E, wave); __syncthreads(); }
#else
                pg8::gemm_phase(L + RING_OFF, g, S, E, wave); }
#endif
#endif
#if defined(MK_CLKPROBE)
            unsigned long long c0_ = clock64(), r0_ = __builtin_amdgcn_s_memrealtime();
#endif
            if (SITE(2) && RUN()) REP(2) {
#ifdef MK_CVFIRST
                if (rep_ == 0) cv_tail(args, layer * 2 + half, L, TIDL() & 63, wave, bx, G);
#endif
                pg8::Gemm g{HBR, (const bf16*)(ws + WS_WFI) + (size_t)(layer * 2 + half) * 2 * FF * DM, DM, DM, DM}; pg8::StaticOrder S; S.init(M, 2 * FF, G, bx);
                pg8::EpiSwiglu E{ACT, FF, SSQR, np}; PWAIT(); if (rep_ == 0) TWAIT(cv::I_FI); pg8::gemm_phase(L + RING_OFF, g, S, E, wave, PCNT());
#ifndef MK_CVFIRST
                if (rep_ == 0) cv_tail(args, layer * 2 + half, L, TIDL() & 63, wave, bx, G);
#endif
                }
#if defined(MK_CLKPROBE)
            if (layer == 1 && half == 1 && bx == 0 && MK_TID() == 0) { const unsigned long long c1_ = clock64(), r1_ = __builtin_amdgcn_s_memrealtime();
                ((float*)(ws + WS_CTL))[1024] = floorf((float)(c1_ - c0_) / (float)(r1_ - r0_) * 0.1f * MK_CLKPROBE); }
#endif
            ++pdone; PSEAM();
            if (SITE(3) && RUN()) REP(3) { pg8::Gemm g{ACT, (const bf16*)(ws + WS_WFO) + (size_t)(layer * 2 + half) * DM * FF, FF, FF, FF}; pg8::StaticOrder S; S.init(M, DM, G, bx);
                pg8::EpiRes<0> E{HBR, (layer == 0 && half == 0) ? args.in[0] : nullptr, HBW, SSQW, 0.5f, nullptr, 0, nullptr, false}; PWAIT(); if (rep_ == 0) TWAIT(cv::I_FO); pg8::gemm_phase(L + RING_OFF, g, S, E, wave, PCNT()); }
            ++pdone; PSEAM();
            np = 8; sel ^= 1;
            if (half == 0) {
                if (kind < 2) {
                    const int wslot = layer == 0 ? 0 : (layer == 1 ? 1 : 2);
                    if (RUN()) {
                        if (SITE(4) && kind == 0) REP(4) { PWAIT(); if (rep_ == 0) TWAIT(cv::I_WF); fox_gate_phase(HBR, (const bf16*)(ws + WS_WFT) + (size_t)(layer / 3) * 2 * 16 * DM, args.in[9] + (layer / 3) * 16, SSQR, np, LOGF, L, TIDL() & 63, wave, bx, G); }
                        if (SITE(5)) REP(5) { pg8::Gemm g{HBR, (const bf16*)(ws + WS_WQKV) + (size_t)wslot * 3 * DM * DM, DM, DM, DM}; pg8::StaticOrder S; S.init(M, 3 * DM, G, bx);
                        pg8::EpiQkv E{QKV, SSQR, np}; PWAIT(); if (rep_ == 0) TWAIT(cv::I_QKV); pg8::gemm_phase(L + RING_OFF, g, S, E, wave, BCNT()); } }
                    BSEAM();
                    if (kind == 1) {
                        if (SITE(6) && RUN()) REP(6) { if (bat) moba_kmean_phase(QKV + (size_t)M * DM, KMEAN, TIDL() & 63, 512 * ((bx & 7) >> 1) + blw * NWAVES + wave, 1 << 20);
                                                       else { moba_kmean_phase(QKV + (size_t)M * DM, KMEAN, TIDL() & 63, gw, NGW); } }
                        BARRIVE(); BSEAM();
                        if (SITE(6) && RUN()) REP(6) { if (bat) moba_select_phase(QKV, KMEAN, (unsigned*)(ws + WS_SEL), L, TIDL() & 63, wave, 512 * ((bx & 7) >> 1) + blw * NWAVES + wave, 1 << 20);
                                                       else moba_select_phase(QKV, KMEAN, (unsigned*)(ws + WS_SEL), L, TIDL() & 63, wave, gw, NGW); }
                        BARRIVE(); BSEAM(); }
                    if (RUN()) {
#if defined(MK_EXP) && MK_EXP == 4
                        if (kind == 0) att::attn_phase<false, true>((char*)lds + RING_OFF, QKV, QKV + (size_t)M * DM, QKV + (size_t)2 * M * DM, OB, (const float*)(ws + WS_BIAS), nullptr, wave);
#endif
                        if (kind == 0) { if (SITE(7)) REP(7) att::attn_phase<false>((char*)lds + RING_OFF, QKV, QKV + (size_t)M * DM, QKV + (size_t)2 * M * DM, OB, LOGF, nullptr, wave); }
                        else if (SITE(8)) REP(8) att::attn_phase<true>((char*)lds + RING_OFF, QKV, QKV + (size_t)M * DM, QKV + (size_t)2 * M * DM, OB, (const float*)(ws + WS_BIAS), (const unsigned*)(ws + WS_SEL), wave); }
                    BARRIVE(); BSEAM();
                    if (SITE(9) && RUN()) REP(9) { pg8::Gemm g{OB, (const bf16*)(ws + WS_WO) + (size_t)wslot * DM * DM, DM, DM, DM}; pg8::StaticOrder S; S.init(M, DM, G, bx);
                        pg8::EpiRes<0> E{HBR, nullptr, HBW, SSQW, 1.0f, nullptr, 0, nullptr, false}; if (rep_ == 0) TWAIT(cv::I_WO); pg8::gemm_phase(L + RING_OFF, g, S, E, wave, PCNT()); }
                    ++pdone; PSEAM(); sel ^= 1;
                } else {
                    if (SITE(10) && RUN()) REP(10) { pg8::Gemm g{HBR, (const bf16*)(ws + WS_WS5I), DM, DM, DM}; pg8::StaticOrder S; S.init(M, DM, G, bx);
                        pg8::EpiS5U E{UH, SSQR, np}; PWAIT(); if (rep_ == 0) TWAIT(cv::I_S5I); pg8::gemm_phase(L + RING_OFF, g, S, E, wave, s5c ? ((rep_ == 0) ? ctl + CW_S5U + 16 * (bx >> 5) : (unsigned*)nullptr) : PCNT()); }
                    if (s5c) {
                        ++pc;
                        if (bx < 128) {
                            panel_wait(ctl + CW_S5U + 16 * (bx >> 4), 32u, ctl + CW_BAR, wave);
                            if (SITE(11) && RUN()) { pg8::Gemm g{UH, (const bf16*)(ws + WS_S5W), 640, 512, 512}; pg8::BatchOrder<1> S; S.init(G, bx);
                                pg8::EpiS5H E{HLOC}; pg8::gemm_phase(L + RING_OFF, g, S, E, wave); }
                            if (SITE(12) && RUN()) s5_scan_phase(args, TIDL() & 63, wave < 4 ? bx * 4 + wave : 512, 512);
                            cnt_arrive(ctl + CW_S5G + bx, TIDL() & 63, wave);
                        }
                        pc += 2;
                        panel_wait(ctl + CW_S5G + (bx >> 1), 1u, ctl + CW_BAR, wave);
                    } else {
                        ++pdone; SEAM();
                        if (SITE(11) && RUN()) REP(11) { pg8::Gemm g{UH, (const bf16*)(ws + WS_S5W), 640, 512, 512}; pg8::BatchOrder<1> S; S.init(G, bx);
                            pg8::EpiS5H E{HLOC}; pg8::gemm_phase(L + RING_OFF, g, S, E, wave); }
                        SEAM();
                        if (SITE(12) && RUN()) REP(12) s5_scan_phase(args, TIDL() & 63, wave * G + vcu, NWAVES * G);
                        SEAM();
                    }
                    if (SITE(13) && RUN()) REP(13) { pg8::Gemm g{UH, (const bf16*)(ws + WS_S5TV), 640, 640, 640}; pg8::BatchOrder<2> S; S.init(G, bx);
                        pg8::EpiS5Y E{YB}; pg8::gemm_phase(L + RING_OFF, g, S, E, wave); }
                    SEAM();
                    if (SITE(14) && RUN()) REP(14) { pg8::Gemm g{YB, (const bf16*)(ws + WS_WGLU), DM, DM, DM}; pg8::StaticOrder S; S.init(M, 2 * DM, G, bx);
                        pg8::EpiRes<2> E{HBR, nullptr, HBW, SSQW, 1.0f, nullptr, 0, nullptr, false}; if (rep_ == 0) TWAIT(cv::I_GLU); pg8::gemm_phase(L + RING_OFF, g, S, E, wave, PCNT()); }
                    ++pdone; PSEAM(); np = 16; sel ^= 1;
                }
            } else {
                if (SITE(15) && RUN()) REP(15) { pg8::Gemm g{HBR, (const bf16*)(ws + WS_WPG) + (size_t)layer * DM * DM, DM, DM, DM}; pg8::StaticOrder S; S.init(M, DM, G, bx);
                    pg8::EpiRes<1> E{HBR, nullptr, HBW, SSQW, 1.0f, SSQR, np, PP + (size_t)layer * M * DM, false}; PWAIT(); if (rep_ == 0) TWAIT(cv::I_PG);
                    if (pan && layer == 0 && rep_ == 0) panel_wait(ctl + CW_PP, 256u, ctl + CW_BAR, wave);
                    pg8::gemm_phase(L + RING_OFF, g, S, E, wave, PCNT()); }
                ++pdone; PSEAM(); sel ^= 1;
            }
        }
    }
#if defined(MK_CLKPROBE)
    { xcd_barrier(bar, wave); const float cv_ = __hip_atomic_load((float*)(ws + WS_CTL) + 1024, __ATOMIC_RELAXED, __HIP_MEMORY_SCOPE_AGENT);
      for (size_t i = (size_t)bx * 512 + MK_TID(); i < (size_t)M * DM; i += (size_t)G * 512) args.out[i] = cv_; return; }
#endif
    if (SITE(16) && RUN()) REP(16) { PWAIT();
        const int r0 = pan ? (4 * (bx & 7) + ((bx >> 3) & 3)) * 256 + 32 * (bx >> 5) + 4 * wave : gw;
        final_norm_phase(HBR, SSQR, args.in[3], args.out, TIDL() & 63, r0, pan ? r0 + 4 : M, pan ? 1 : NGW); }
#undef RUN
#undef SEAM
}
constexpr int N_PHASES = 1 + 4 * 5 + (4 + 5 + 4 + 5) + 1;

#ifndef MK_PER_PHASE
#define MK_PER_PHASE 0
#endif
static void mk_launch(void* const* d_in, float* d_out, void* d_ws, hipStream_t stream) {
    static int grid = 0;
    if (grid == 0) {
        int dev = 0, cus = 0, per_cu = 0;
        if (hipGetDevice(&dev) != hipSuccess || hipDeviceGetAttribute(&cus, hipDeviceAttributeMultiprocessorCount, dev) != hipSuccess) { fprintf(stderr, "mk_launch: device query failed\n"); grid = -1; return; }
        if (hipFuncSetAttribute((const void*)mk_fwd, hipFuncAttributeMaxDynamicSharedMemorySize, LDS_BYTES) != hipSuccess) { fprintf(stderr, "mk_launch: hipFuncSetAttribute failed\n"); grid = -1; return; }
        if (hipOccupancyMaxActiveBlocksPerMultiprocessor(&per_cu, (const void*)mk_fwd, NWAVES * 64, LDS_BYTES) != hipSuccess || per_cu < 1) fprintf(stderr, "mk_launch: occupancy query reports %d\n", per_cu);
        (void)hipGetLastError();
        grid = cus;
    }
    if (grid < 0) return;
    if (hipMemsetAsync((char*)d_ws + WS_CTL, 0, CTL_ZERO_BYTES, stream) != hipSuccess) { fprintf(stderr, "mk_launch: memset failed\n"); return; }
    Args a{};
    for (int i = 0; i < 23; ++i) a.in[i] = (const float*)d_in[i];
    a.out = d_out; a.ws = (unsigned char*)d_ws;
#if MK_PER_PHASE
    for (int ph = 0; ph < N_PHASES; ++ph) { a.ph_lo = ph; a.ph_hi = ph + 1; hipLaunchKernelGGL(mk_fwd, dim3(grid), dim3(NWAVES * 64), LDS_BYTES, stream, a); }
#else
    a.ph_lo = 0; a.ph_hi = 1 << 20;
    hipLaunchKernelGGL(mk_fwd, dim3(grid), dim3(NWAVES * 64), LDS_BYTES, stream, a);
#endif
    const hipError_t le = hipPeekAtLastError();
    if (le != hipSuccess) fprintf(stderr, "mk_launch: launch failed: %s\n", hipGetErrorName(le));
}

extern "C" void kernel_launch(void* const* d_in, const int* in_sizes, int n_in, void* d_out, int out_size, void* d_ws, size_t ws_size, hipStream_t stream) {
    if (n_in != 23 || out_size != M * DM || in_sizes[0] != M * DM || ws_size < WS_END) { fprintf(stderr, "kernel_launch: unexpected shapes n_in=%d out=%d ws=%zu\n", n_in, out_size, ws_size); return; }
    mk_launch(d_in, (float*)d_out, d_ws, stream);
}
```
